# Optimizing an MI355X kernel written in HIP

```python
import math
import jax, jax.numpy as jnp
from jax import lax
import numpy as np

D_MODEL = 1024
BATCH = 4
SEQ = 4096
DEPTH = 4

CHUNK = 64
Q_BLOCK = 128
N_MIXERS = 3
D_FF = 4 * D_MODEL
EPS = 1e-6

A_HEADS = 8
A_HEAD_DIM = D_MODEL // (2 * A_HEADS)
A_V_DIM = 2 * A_HEAD_DIM

POOL_WINDOWS = (2, 4, 8, 16)
POOL_GROUP = D_MODEL // len(POOL_WINDOWS)

C_HEADS = 8
C_HEAD_DIM = D_MODEL // C_HEADS
C_KV_HEADS = 2
IDX_HEADS = 8
IDX_DIM = 64
TOPK_MAX = 256
C_SPLIT_SIZES = (C_HEADS * C_HEAD_DIM, C_KV_HEADS * C_HEAD_DIM, C_KV_HEADS * C_HEAD_DIM,
                 IDX_HEADS * IDX_DIM, IDX_DIM, IDX_HEADS)
C_IN = sum(C_SPLIT_SIZES)

kernel_name = "hybrid_diffattn_pool_dsa_trunk"


def _n_layers_of(mixer):
    return len([i for i in range(DEPTH) if i % N_MIXERS == mixer])


def rms_norm(x, g):
    xf = x.astype(jnp.float32)
    y = xf * lax.rsqrt(jnp.mean(xf * xf, axis=-1, keepdims=True) + EPS)
    return (y * g.astype(jnp.float32)).astype(x.dtype)


def diff_attention(h, w_in, q_g, k_g, lq1, lk1, lq2, lk2, sub_g, w_out, lambda_init):
    B, S, _ = h.shape
    H, Dh = A_HEADS, A_HEAD_DIM
    q, k, v = jnp.split(h @ w_in, 3, axis=-1)
    q = rms_norm(q.reshape(B, S, H, 2, Dh), q_g)
    k = rms_norm(k.reshape(B, S, H, 2, Dh), k_g)
    v = v.reshape(B, S, H, A_V_DIM)
    f32 = jnp.float32
    lam = (jnp.exp(jnp.sum(lq1.astype(f32) * lk1.astype(f32)))
           - jnp.exp(jnp.sum(lq2.astype(f32) * lk2.astype(f32))) + lambda_init)
    nb = S // Q_BLOCK
    qb = q.reshape(B, nb, Q_BLOCK, H, 2, Dh).transpose(1, 0, 2, 3, 4, 5)
    key_chunk = jnp.arange(S) // CHUNK
    scale = Dh ** -0.5

    def block(args):
        qi, bi = args
        q_chunk = (bi * Q_BLOCK + jnp.arange(Q_BLOCK)) // CHUNK
        mask = key_chunk[None, :] <= q_chunk[:, None]
        s = jnp.einsum('bqhmd,bshmd->bhmqs', qi, k).astype(f32) * scale
        s = jnp.where(mask, s, -jnp.inf)
        p = jax.nn.softmax(s, axis=-1)
        pd = (p[:, :, 0] - lam * p[:, :, 1]).astype(v.dtype)
        return jnp.einsum('bhqs,bshe->bqhe', pd, v)

    o = lax.map(block, (qb, jnp.arange(nb)))
    o = o.transpose(1, 0, 2, 3, 4).reshape(B, S, H, A_V_DIM)
    o = rms_norm(o, sub_g) * (1.0 - lambda_init)
    return o.reshape(B, S, H * A_V_DIM) @ w_out


def pool_mixer(h, w_group, scale):
    B, S, D = h.shape
    hf = h.astype(jnp.float32)
    cs = jnp.pad(jnp.cumsum(hf, axis=1), ((0, 0), (1, 0), (0, 0)))
    t = jnp.arange(S)
    outs = []
    for g, w in enumerate(POOL_WINDOWS):
        c = cs[:, :, g * POOL_GROUP:(g + 1) * POOL_GROUP]
        prev = jnp.pad(c, ((0, 0), (w - 1, 0), (0, 0)))[:, :S]
        count = jnp.minimum(t + 1, w).astype(jnp.float32)
        mean = (c[:, 1:] - prev) / count[None, :, None]
        outs.append(mean - hf[:, :, g * POOL_GROUP:(g + 1) * POOL_GROUP])
    pooled = jnp.stack(outs, axis=2).astype(h.dtype)
    y = jnp.einsum('bsgc,gce->bsge', pooled, w_group).reshape(B, S, D)
    return y * scale


def dsa_attention(h, w_in, q_g, k_g, w_out):
    B, S, _ = h.shape
    H, G, Dh = C_HEADS, C_KV_HEADS, C_HEAD_DIM
    R = H // G
    f32 = jnp.float32
    offsets = list(np.cumsum(C_SPLIT_SIZES)[:-1])
    q, k, v, iq, ik, iw = jnp.split(h @ w_in, offsets, axis=-1)
    q = rms_norm(q.reshape(B, S, G, R, Dh), q_g)
    k = rms_norm(k.reshape(B, S, G, Dh), k_g)
    v = v.reshape(B, S, G, Dh)
    iq = iq.reshape(B, S, IDX_HEADS, IDX_DIM)
    iw = iw * (IDX_HEADS ** -0.5)
    topk = min(TOPK_MAX, S // 4)
    nb = S // Q_BLOCK
    qb = q.reshape(B, nb, Q_BLOCK, G, R, Dh).transpose(1, 0, 2, 3, 4, 5)
    iqb = iq.reshape(B, nb, Q_BLOCK, IDX_HEADS, IDX_DIM).transpose(1, 0, 2, 3, 4)
    iwb = iw.reshape(B, nb, Q_BLOCK, IDX_HEADS).transpose(1, 0, 2, 3)
    key_chunk = jnp.arange(S) // CHUNK

    def block(args):
        qi, iqi, iwi, bi = args
        q_chunk = (bi * Q_BLOCK + jnp.arange(Q_BLOCK)) // CHUNK
        admissible = key_chunk[None, :] <= q_chunk[:, None]
        logits = jnp.einsum('bqhd,bsd->bqhs', iqi, ik).astype(f32) * (IDX_DIM ** -0.5)
        score = jnp.einsum('bqh,bqhs->bqs', iwi.astype(f32), jax.nn.relu(logits))
        score = jnp.where(admissible[None], score, -jnp.inf)
        _, idx = lax.top_k(score, topk)
        valid = (idx // CHUNK) <= q_chunk[None, :, None]
        k_sel = jax.vmap(lambda kk, ii: kk[ii])(k, idx)
        v_sel = jax.vmap(lambda vv, ii: vv[ii])(v, idx)
        s = jnp.einsum('bqgrd,bqjgd->bqgrj', qi, k_sel).astype(f32) * (Dh ** -0.5)
        s = jnp.where(valid[:, :, None, None, :], s, -jnp.inf)
        p = jax.nn.softmax(s, axis=-1).astype(v.dtype)
        return jnp.einsum('bqgrj,bqjgd->bqgrd', p, v_sel)

    o = lax.map(block, (qb, iqb, iwb, jnp.arange(nb)))
    o = o.transpose(1, 0, 2, 3, 4, 5).reshape(B, S, H * Dh)
    return o @ w_out


def setup_inputs(seed: int = 0) -> dict:
    key = jax.random.key(seed)
    ks = jax.random.split(key, 24)
    f32 = jnp.float32
    nA, nB, nC = _n_layers_of(0), _n_layers_of(1), _n_layers_of(2)

    def w(k, shape, fan_in, gain=1.0):
        return jax.random.normal(k, shape, f32) * (gain * fan_in ** -0.5)

    def g(k, shape):
        return 1.0 + 0.02 * jax.random.normal(k, shape, f32)

    def lam(k, shape):
        return 0.1 * jax.random.normal(k, shape, f32)

    return {
        "x": jax.random.normal(ks[0], (BATCH, SEQ, D_MODEL), f32),
        "norm1_g": g(ks[1], (DEPTH, D_MODEL)),
        "norm2_g": g(ks[2], (DEPTH, D_MODEL)),
        "a_w_in": w(ks[3], (nA, D_MODEL, 3 * D_MODEL), D_MODEL),
        "a_q_norm_g": g(ks[4], (nA, A_HEAD_DIM)),
        "a_k_norm_g": g(ks[5], (nA, A_HEAD_DIM)),
        "a_lambda_q1": lam(ks[6], (nA, A_HEAD_DIM)),
        "a_lambda_k1": lam(ks[7], (nA, A_HEAD_DIM)),
        "a_lambda_q2": lam(ks[8], (nA, A_HEAD_DIM)),
        "a_lambda_k2": lam(ks[9], (nA, A_HEAD_DIM)),
        "a_subln_g": g(ks[10], (nA, A_V_DIM)),
        "a_w_out": w(ks[11], (nA, A_HEADS * A_V_DIM, D_MODEL), A_HEADS * A_V_DIM, 0.5),
        "b_w_group": w(ks[12], (nB, len(POOL_WINDOWS), POOL_GROUP, POOL_GROUP), POOL_GROUP),
        "b_scale": g(ks[13], (nB, D_MODEL)),
        "c_w_in": w(ks[14], (nC, D_MODEL, C_IN), D_MODEL),
        "c_q_norm_g": g(ks[15], (nC, C_HEAD_DIM)),
        "c_k_norm_g": g(ks[16], (nC, C_HEAD_DIM)),
        "c_w_out": w(ks[17], (nC, C_HEADS * C_HEAD_DIM, D_MODEL), C_HEADS * C_HEAD_DIM, 0.5),
        "mlp_w1": w(ks[18], (DEPTH, D_MODEL, D_FF), D_MODEL),
        "mlp_w2": w(ks[19], (DEPTH, D_FF, D_MODEL), D_FF, 0.5),
    }


def reference(x, norm1_g, norm2_g, a_w_in, a_q_norm_g, a_k_norm_g, a_lambda_q1, a_lambda_k1,
              a_lambda_q2, a_lambda_k2, a_subln_g, a_w_out, b_w_group, b_scale, c_w_in,
              c_q_norm_g, c_k_norm_g, c_w_out, mlp_w1, mlp_w2):
    h = x
    for i in range(DEPTH):
        m, j = i % N_MIXERS, i // N_MIXERS
        u = rms_norm(h, norm1_g[i])
        if m == 0:
            lambda_init = 0.8 - 0.6 * math.exp(-0.3 * i)
            y = diff_attention(u, a_w_in[j], a_q_norm_g[j], a_k_norm_g[j], a_lambda_q1[j],
                               a_lambda_k1[j], a_lambda_q2[j], a_lambda_k2[j], a_subln_g[j],
                               a_w_out[j], lambda_init)
        elif m == 1:
            y = pool_mixer(u, b_w_group[j], b_scale[j])
        else:
            y = dsa_attention(u, c_w_in[j], c_q_norm_g[j], c_k_norm_g[j], c_w_out[j])
        h = h + y
        u = rms_norm(h, norm2_g[i])
        h = h + jnp.square(jax.nn.relu(u @ mlp_w1[i])) @ mlp_w2[i]
    return h
```

```cpp
#include <hip/hip_runtime.h>
#include <hip/hip_cooperative_groups.h>
#include <cstdio>
namespace cg = cooperative_groups;

typedef unsigned short bf16_t;
typedef __attribute__((ext_vector_type(8))) short bf16x8;
typedef __attribute__((ext_vector_type(16))) float f32x16;
typedef unsigned long long u64;
typedef unsigned __attribute__((ext_vector_type(4))) u32x4;
typedef unsigned __attribute__((ext_vector_type(2))) u32x2;
typedef float __attribute__((ext_vector_type(4))) f32x4;

#define DEVI __device__ __forceinline__
#define DUP_GEMM 0
#define DUP_ATTNA 0
#define DUP_IDX 0
#define DUP_ATTNC 0
#define DUP_CONV 0

constexpr int T_TOK = 16384;
constexpr int DM = 1024;
constexpr int SEQ = 4096;
constexpr float EPS = 1e-6f;
constexpr float LOG2E = 1.4426950408889634f;
constexpr size_t MB = 1ull << 20;

constexpr size_t OFF_W1 = 0;
constexpr size_t OFF_W2 = 32 * MB;
constexpr size_t OFF_AIN = 64 * MB;
constexpr size_t OFF_AOUT = 76 * MB;
constexpr size_t OFF_BW = 80 * MB;
constexpr size_t OFF_CIN = 81 * MB;
constexpr size_t OFF_COUT = 86 * MB;
constexpr size_t OFF_HB = 88 * MB;
constexpr size_t OFF_R = 120 * MB;
constexpr size_t OFF_SSQ = 249 * MB;
constexpr size_t WS_NEED = 251 * MB;
constexpr size_t R_QK = OFF_R;
constexpr size_t R_VT = OFF_R + 64 * MB;
constexpr size_t R_AO = OFF_R + 96 * MB;
constexpr size_t R_HID = OFF_R;
constexpr size_t R_POOL = OFF_R;
constexpr size_t R_CQ = OFF_R;
constexpr size_t R_CK = OFF_R + 32 * MB;
constexpr size_t R_CVT = OFF_R + 40 * MB;
constexpr size_t R_CIQ = OFF_R + 48 * MB;
constexpr size_t R_CIK = OFF_R + 64 * MB;
constexpr size_t R_CIW = OFF_R + 66 * MB;
constexpr size_t R_MASK = OFF_R + 67 * MB;

struct Params {
  const float* x; const float* norm1_g; const float* norm2_g;
  const float* a_w_in; const float* a_q_g; const float* a_k_g;
  const float* a_lq1; const float* a_lk1; const float* a_lq2; const float* a_lk2;
  const float* a_sub_g; const float* a_w_out;
  const float* b_w; const float* b_scale;
  const float* c_w_in; const float* c_q_g; const float* c_k_g; const float* c_w_out;
  const float* w1; const float* w2;
  float* out; char* ws;
};

DEVI bf16_t f2bf(float f) {
  return __builtin_bit_cast(bf16_t, (__bf16)f);
}
typedef __bf16 bf16x2_t __attribute__((ext_vector_type(2)));
DEVI unsigned pack2(float a, float b) {
  bf16x2_t v;
  v.x = (__bf16)a; v.y = (__bf16)b;
  return __builtin_bit_cast(unsigned, v);
}
DEVI float bf_lo(unsigned p) { return __uint_as_float(p << 16); }
DEVI float bf_hi(unsigned p) { return __uint_as_float(p & 0xffff0000u); }
DEVI float fexp2(float x) { return __builtin_amdgcn_exp2f(x); }

template <int ROWB>
DEVI int lds_off(int row, int chunk) {
  if (ROWB == 128) return row * 128 + ((chunk ^ ((row >> 1) & 7)) << 4);
  else return row * 256 + ((chunk ^ (row & 15)) << 4);
}

DEVI f32x16 mfma32(bf16x8 a, bf16x8 b, f32x16 c) {
  return __builtin_amdgcn_mfma_f32_32x32x16_bf16(a, b, c, 0, 0, 0);
}

constexpr int SMEM_BYTES = 131072 + 1024 + 4096;

DEVI int otid() { int t = threadIdx.x & 255; asm volatile("" : "+v"(t)); return t; }
DEVI int otid512() { int t = threadIdx.x; asm volatile("" : "+v"(t)); return t; }
DEVI int grp_id() { return __builtin_amdgcn_readfirstlane((int)(threadIdx.x >> 8)); }
DEVI int vblk() { return (int)blockIdx.x * 2 + grp_id(); }
DEVI int nvblk() { return (int)gridDim.x * 2; }

struct Job { const float* src; bf16_t* dst; const float* gain; int K, N, NP; };

DEVI Job get_job(const Params& p, int j) {
  Job jb;
  char* ws = p.ws;
  if (j < 4) {
    jb.src = p.w1 + (size_t)j * 1024 * 4096; jb.dst = (bf16_t*)(ws + OFF_W1 + (size_t)j * 8 * MB);
    jb.gain = p.norm2_g + j * 1024; jb.K = 1024; jb.N = 4096; jb.NP = 4096;
  } else if (j < 8) {
    int i = j - 4;
    jb.src = p.w2 + (size_t)i * 1024 * 4096; jb.dst = (bf16_t*)(ws + OFF_W2 + (size_t)i * 8 * MB);
    jb.gain = nullptr; jb.K = 4096; jb.N = 1024; jb.NP = 1024;
  } else if (j < 10) {
    int i = j - 8;
    jb.src = p.a_w_in + (size_t)i * 1024 * 3072; jb.dst = (bf16_t*)(ws + OFF_AIN + (size_t)i * 6 * MB);
    jb.gain = p.norm1_g + (i == 0 ? 0 : 3) * 1024; jb.K = 1024; jb.N = 3072; jb.NP = 3072;
  } else if (j < 12) {
    int i = j - 10;
    jb.src = p.a_w_out + (size_t)i * 1024 * 1024; jb.dst = (bf16_t*)(ws + OFF_AOUT + (size_t)i * 2 * MB);
    jb.gain = nullptr; jb.K = 1024; jb.N = 1024; jb.NP = 1024;
  } else if (j < 16) {
    int g = j - 12;
    jb.src = p.b_w + (size_t)g * 65536; jb.dst = (bf16_t*)(ws + OFF_BW) + (size_t)g * 65536;
    jb.gain = p.norm1_g + 1024 + g * 256; jb.K = 256; jb.N = 256; jb.NP = 256;
  } else if (j == 16) {
    jb.src = p.c_w_in; jb.dst = (bf16_t*)(ws + OFF_CIN);
    jb.gain = p.norm1_g + 2 * 1024; jb.K = 1024; jb.N = 2120; jb.NP = 2304;
  } else {
    jb.src = p.c_w_out; jb.dst = (bf16_t*)(ws + OFF_COUT);
    jb.gain = nullptr; jb.K = 1024; jb.N = 1024; jb.NP = 1024;
  }
  return jb;
}
constexpr int NJOBS = 18;

DEVI void convert_phase(const Params& p, char* smem) {
  const int tid = otid();
  float* t = (float*)smem;
  int total = 0;
  for (int j = 0; j < NJOBS; j++) { Job jb = get_job(p, j); total += (jb.K / 64) * (jb.NP / 64); }
  const int vb = vblk(), nvb = nvblk();
  for (int base = 0; base < total; base += nvb) {
    const int tile = base + vb;
    const bool act = tile < total;
    int rem = act ? tile : 0, j = 0;
    Job jb = get_job(p, 0);
    for (;;) {
      int nt = (jb.K / 64) * (jb.NP / 64);
      if (rem < nt) break;
      rem -= nt; j++; jb = get_job(p, j);
    }
    const int ntn = jb.NP / 64;
    const int k0 = (rem / ntn) * 64, n0 = (rem % ntn) * 64;
    if (act) {
#pragma unroll
      for (int i = 0; i < 4; i++) {
        int kk = (tid >> 4) + 16 * i, nn = (tid & 15) * 4, n = n0 + nn;
        f32x4 v = f32x4{0.f, 0.f, 0.f, 0.f};
        if (n < jb.N) v = *(const f32x4*)(jb.src + (size_t)(k0 + kk) * jb.N + n);
        t[kk * 65 + nn + 0] = v.x; t[kk * 65 + nn + 1] = v.y; t[kk * 65 + nn + 2] = v.z; t[kk * 65 + nn + 3] = v.w;
      }
    }
    __syncthreads();
    if (act) {
      const int nl = tid >> 2, kq = tid & 3;
      unsigned pk[8];
#pragma unroll
      for (int i = 0; i < 8; i++) {
        int k = kq * 16 + 2 * i;
        float a = t[k * 65 + nl], b = t[(k + 1) * 65 + nl];
        if (jb.gain) { a *= jb.gain[k0 + k]; b *= jb.gain[k0 + k + 1]; }
        pk[i] = pack2(a, b);
      }
      u32x4* d = (u32x4*)(jb.dst + (size_t)(n0 + nl) * jb.K + k0 + kq * 16);
      d[0] = u32x4{pk[0], pk[1], pk[2], pk[3]};
      d[1] = u32x4{pk[4], pk[5], pk[6], pk[7]};
    }
    __syncthreads();
  }
  bf16_t* hb = (bf16_t*)(p.ws + OFF_HB);
  float* ssqp = (float*)(p.ws + OFF_SSQ);
  {
    const int lane = tid & 63, wv = tid >> 6;
    for (int row = vb * 4 + wv; row < T_TOK; row += nvb * 4) {
      const float* xr = p.x + (size_t)row * DM;
      float ssum = 0.f;
#pragma unroll
      for (int i = 0; i < 2; i++) {
        const int c = i * 512 + lane * 8;
        f32x4 a = *(const f32x4*)(xr + c), b = *(const f32x4*)(xr + c + 4);
        ssum += a.x * a.x + a.y * a.y + a.z * a.z + a.w * a.w + b.x * b.x + b.y * b.y + b.z * b.z + b.w * b.w;
        *(u32x4*)(hb + (size_t)row * DM + c) = u32x4{pack2(a.x, a.y), pack2(a.z, a.w), pack2(b.x, b.y), pack2(b.z, b.w)};
      }
#pragma unroll
      for (int o = 32; o >= 1; o >>= 1) ssum += __shfl_xor(ssum, o);
      if (lane < 16) ssqp[(size_t)row * 16 + lane] = (lane == 0) ? ssum : 0.f;
    }
  }
}

DEVI void wave_put_bf16(char* wbuf, const int ml, const int nt, const int q4, const int lh, const u32x2 v) {
  const int chunk = nt * 4 + q4;
  *(u32x2*)(wbuf + ml * 128 + ((chunk ^ (ml & 7)) << 4) + 8 * lh) = v;
}
DEVI void wave_flush_bf16(char* wbuf, bf16_t* dst, const int stride, const int lane) {
  const int c = lane & 7;
#pragma unroll
  for (int i = 0; i < 8; i++) {
    const int row = i * 8 + (lane >> 3);
    const u32x4 v = *(const u32x4*)(wbuf + row * 128 + ((c ^ (row & 7)) << 4));
    *(u32x4*)(dst + (size_t)row * stride + c * 8) = v;
  }
}

enum { M_AQKV = 0, M_CIN = 1, M_RESID = 2, M_MLP1 = 3, M_POOL = 4 };

struct GemmArgs {
  const bf16_t* A; int lda; const bf16_t* Bt; int K; int NT;
  void* o0; void* o1; void* o2; void* o3; void* o4; void* o5;
  const float* g0; const float* g1; const float* resid; float* ssq;
};

template <int MODE, int KC>
DEVI void gemm_phase(const GemmArgs& ga, char* smem) {
  constexpr bool NORM = (MODE == M_AQKV || MODE == M_CIN || MODE == M_MLP1);
  const int tid = otid512(), lane = tid & 63, w = tid >> 6;
  const int wn = w & 3, wm = w >> 2;
  const int l31 = lane & 31, lh = lane >> 5;
  float* rs_lds = (float*)(smem + 131072);
  float* xch = (float*)(smem + 131072 + 1024);
  constexpr int K = KC;
  constexpr int KT = K / 64;
  const int NT256 = ga.NT;
  const int ntiles = (T_TOK / 256) * NT256;
  for (int tile = blockIdx.x; tile < ntiles; tile += gridDim.x) {
    const int tn256 = tile % NT256, tm = tile / NT256;
    const int m0 = tm * 256;
    const bf16_t* Ab = ga.A + (size_t)m0 * ga.lda + (MODE == M_POOL ? tn256 * 256 : 0);
    const bf16_t* Bb = ga.Bt + (size_t)tn256 * 256 * K;
    f32x16 acc[2][4];
#pragma unroll
    for (int a = 0; a < 2; a++)
#pragma unroll
      for (int b = 0; b < 4; b++)
#pragma unroll
        for (int r = 0; r < 16; r++) acc[a][b][r] = 0.f;
    u32x4 rw0[4], rx0[4];
    int ttid = tid;
    asm volatile("" : "+v"(ttid));
    const int ldsb = lds_off<128>(ttid >> 3, ttid & 7);
    const unsigned woff0 = (unsigned)((ttid >> 3) * K + (ttid & 7) * 8) * 2u;
    const unsigned xoff0 = (unsigned)((ttid >> 3) * ga.lda + (ttid & 7) * 8) * 2u;
#define G_LOAD(RW, RX, KTI)                                                              \
  _Pragma("unroll") for (int j = 0; j < 4; j++) {                                        \
    RW[j] = *(const u32x4*)((const char*)Bb + (size_t)(KTI) * 128 + (size_t)j * 64 * K * 2 + woff0);            \
    RX[j] = *(const u32x4*)((const char*)Ab + (size_t)(KTI) * 128 + (size_t)j * 64 * ga.lda * 2 + xoff0);      \
  }
#define G_STORE(RW, RX, S)                                                               \
  _Pragma("unroll") for (int j = 0; j < 4; j++) {                                        \
    *(u32x4*)(smem + (S) * 32768 + ldsb + j * 8192) = RW[j];            \
    *(u32x4*)(smem + 65536 + (S) * 32768 + ldsb + j * 8192) = RX[j];                     \
  }
#define G_COMPUTE_KS(S, KS0, KS1)                                                        \
  _Pragma("unroll") for (int ks = KS0; ks < KS1; ks++) {                                 \
    bf16x8 wf[2], xf[4];                                                                 \
    _Pragma("unroll") for (int nt = 0; nt < 2; nt++)                                     \
      wf[nt] = *(const bf16x8*)(smem + (S) * 32768 + lds_off<128>(wn * 64 + nt * 32 + l31, 2 * ks + lh)); \
    _Pragma("unroll") for (int mt = 0; mt < 4; mt++)                                     \
      xf[mt] = *(const bf16x8*)(smem + 65536 + (S) * 32768 + lds_off<128>(wm * 128 + mt * 32 + l31, 2 * ks + lh)); \
    _Pragma("unroll") for (int nt = 0; nt < 2; nt++)                                     \
      _Pragma("unroll") for (int mt = 0; mt < 4; mt++) acc[nt][mt] = mfma32(wf[nt], xf[mt], acc[nt][mt]); \
  }
    G_LOAD(rw0, rx0, 0)
    G_STORE(rw0, rx0, 0)
    __syncthreads();
    if (NORM) {
      if (tid < 256) {
        const f32x4* sp = (const f32x4*)(ga.ssq + (size_t)(m0 + tid) * 16);
        const f32x4 a = sp[0], b = sp[1], c = sp[2], d = sp[3];
        const float tot = (a.x + a.y + a.z + a.w) + (b.x + b.y + b.z + b.w) + (c.x + c.y + c.z + c.w) + (d.x + d.y + d.z + d.w);
        rs_lds[tid] = rsqrtf(tot * (1.f / 1024.f) + EPS);
      }
    }
#pragma unroll 1
    for (int kt = 0; kt < KT; kt += 2) {
      const bool more = (kt + 2 < KT);
      G_LOAD(rw0, rx0, kt + 1)
      asm volatile("" ::: "memory");
      G_COMPUTE_KS(0, 0, 2)
      G_STORE(rw0, rx0, 1)
      G_COMPUTE_KS(0, 2, 4)
      __syncthreads();
      if (more) { G_LOAD(rw0, rx0, kt + 2) }
      asm volatile("" ::: "memory");
      G_COMPUTE_KS(1, 0, 2)
      if (more) { G_STORE(rw0, rx0, 0) }
      G_COMPUTE_KS(1, 2, 4)
      __syncthreads();
    }
#undef G_LOAD
#undef G_STORE
#undef G_COMPUTE_KS
    float rstd[4] = {1.f, 1.f, 1.f, 1.f};
    if (NORM) {
#pragma unroll
      for (int mt = 0; mt < 4; mt++) rstd[mt] = rs_lds[wm * 128 + mt * 32 + l31];
    }
    int el31 = l31, elh = lh, ewn = wn & 1, ewm = wm, elane = lane, ewq = wn >> 1, eww = w;
    asm volatile("" : "+v"(el31), "+v"(elh), "+v"(ewn), "+v"(ewm), "+v"(elane), "+v"(ewq), "+v"(eww));
    const int tn = tn256 * 2 + __builtin_amdgcn_readfirstlane(ewq);
    const int n0 = tn * 128;
    char* wbuf = smem + eww * 16384;
    const int mw0 = m0 + ewm * 128;
    if (MODE == M_AQKV) {
      const int nw = n0 + ewn * 64;
      if (n0 < 2048) {
        const float* g = (n0 < 1024) ? ga.g0 : ga.g1;
        const float post = (n0 < 1024) ? (0.125f * LOG2E) : 1.f;
#pragma unroll
        for (int h = 0; h < 2; h++) {
#pragma unroll
          for (int mh = 0; mh < 2; mh++) {
            const int mt = 2 * h + mh;
            float s = 0.f;
#pragma unroll
            for (int nt = 0; nt < 2; nt++)
#pragma unroll
              for (int r = 0; r < 16; r++) { float v = acc[nt][mt][r] * rstd[mt]; acc[nt][mt][r] = v; s += v * v; }
            s += __shfl_xor(s, 32);
            const float hn = rsqrtf(s * (1.f / 64.f) + EPS) * post;
#pragma unroll
            for (int nt = 0; nt < 2; nt++)
#pragma unroll
              for (int q4 = 0; q4 < 4; q4++) {
                const int d = nt * 32 + 8 * q4 + 4 * elh;
                const f32x4 gv = *(const f32x4*)(g + d);
                { u32x2 pv; pv.x = pack2(acc[nt][mt][4 * q4 + 0] * hn * gv.x, acc[nt][mt][4 * q4 + 1] * hn * gv.y); pv.y = pack2(acc[nt][mt][4 * q4 + 2] * hn * gv.z, acc[nt][mt][4 * q4 + 3] * hn * gv.w); wave_put_bf16(wbuf, mh * 32 + el31, nt, q4, elh, pv); }
              }
          }
          wave_flush_bf16(wbuf, (bf16_t*)ga.o0 + (size_t)(mw0 + h * 64) * 2048 + nw, 2048, elane);
        }
      } else {
        bf16_t* vt = (bf16_t*)ga.o1;
        const int nn = nw - 2048, head = nn >> 7, e0 = nn & 127;
#pragma unroll
        for (int mt = 0; mt < 4; mt++) {
          const int m = mw0 + mt * 32 + el31;
          const int b = m >> 12, s = m & 4095;
          bf16_t* vp = vt + ((size_t)(b * 8 + head) * 128 + e0 + 4 * elh) * 4096 + s;
          asm volatile("" : "+v"(vp));
#pragma unroll
          for (int nt = 0; nt < 2; nt++)
#pragma unroll
            for (int r = 0; r < 16; r++)
              vp[(size_t)(nt * 32 + (r & 3) + 8 * (r >> 2)) * 4096] = f2bf(acc[nt][mt][r] * rstd[mt]);
        }
      }
    } else if (MODE == M_CIN) {
      if (tn < 10) {
#pragma unroll
        for (int mt = 0; mt < 4; mt++) {
          float s = 0.f;
#pragma unroll
          for (int nt = 0; nt < 2; nt++)
#pragma unroll
            for (int r = 0; r < 16; r++) { float v = acc[nt][mt][r] * rstd[mt]; acc[nt][mt][r] = v; s += v * v; }
          s += __shfl_xor(s, 32);
          if (elh == 0) xch[(ewq * 2 + ewn) * 256 + ewm * 128 + mt * 32 + el31] = s;
        }
        __syncthreads();
        const float* g = (tn < 8) ? ga.g0 : ga.g1;
        const float post = (tn < 8) ? (0.08838834764831845f * LOG2E) : 1.f;
#pragma unroll
        for (int h = 0; h < 2; h++) {
#pragma unroll
          for (int mh = 0; mh < 2; mh++) {
            const int mt = 2 * h + mh;
            const int ml = ewm * 128 + mt * 32 + el31;
            const float tot = xch[(ewq * 2) * 256 + ml] + xch[(ewq * 2 + 1) * 256 + ml];
            const float hn = rsqrtf(tot * (1.f / 128.f) + EPS) * post;
#pragma unroll
            for (int nt = 0; nt < 2; nt++)
#pragma unroll
              for (int q4 = 0; q4 < 4; q4++) {
                const int d = ewn * 64 + nt * 32 + 8 * q4 + 4 * elh;
                const f32x4 gv = *(const f32x4*)(g + d);
                { u32x2 pv; pv.x = pack2(acc[nt][mt][4 * q4 + 0] * hn * gv.x, acc[nt][mt][4 * q4 + 1] * hn * gv.y); pv.y = pack2(acc[nt][mt][4 * q4 + 2] * hn * gv.z, acc[nt][mt][4 * q4 + 3] * hn * gv.w); wave_put_bf16(wbuf, mh * 32 + el31, nt, q4, elh, pv); }
              }
          }
          if (tn < 8) wave_flush_bf16(wbuf, (bf16_t*)ga.o0 + (size_t)(mw0 + h * 64) * 1024 + tn * 128 + ewn * 64, 1024, elane);
          else wave_flush_bf16(wbuf, (bf16_t*)ga.o1 + (size_t)(mw0 + h * 64) * 256 + (tn - 8) * 128 + ewn * 64, 256, elane);
        }
      } else if (tn < 12) {
        bf16_t* vt = (bf16_t*)ga.o2;
        const int g = tn - 10;
#pragma unroll
        for (int mt = 0; mt < 4; mt++) {
          const int m = mw0 + mt * 32 + el31;
          const int b = m >> 12, s = m & 4095;
          bf16_t* vp = vt + ((size_t)(b * 2 + g) * 128 + ewn * 64 + 4 * elh) * 4096 + s;
          asm volatile("" : "+v"(vp));
#pragma unroll
          for (int nt = 0; nt < 2; nt++)
#pragma unroll
            for (int r = 0; r < 16; r++)
              vp[(size_t)(nt * 32 + (r & 3) + 8 * (r >> 2)) * 4096] = f2bf(acc[nt][mt][r] * rstd[mt]);
        }
      } else {
        if (tn < 16 || (tn == 16 && ewn == 0)) {
#pragma unroll
          for (int h = 0; h < 2; h++) {
  #pragma unroll
            for (int mh = 0; mh < 2; mh++) {
              const int mt = 2 * h + mh;
#pragma unroll
              for (int nt = 0; nt < 2; nt++)
#pragma unroll
                for (int q4 = 0; q4 < 4; q4++) {
                  { u32x2 pv; pv.x = pack2(acc[nt][mt][4 * q4 + 0] * rstd[mt], acc[nt][mt][4 * q4 + 1] * rstd[mt]); pv.y = pack2(acc[nt][mt][4 * q4 + 2] * rstd[mt], acc[nt][mt][4 * q4 + 3] * rstd[mt]); wave_put_bf16(wbuf, mh * 32 + el31, nt, q4, elh, pv); }
                }
            }
            if (tn < 16) wave_flush_bf16(wbuf, (bf16_t*)ga.o3 + (size_t)(mw0 + h * 64) * 512 + (tn - 12) * 128 + ewn * 64, 512, elane);
            else wave_flush_bf16(wbuf, (bf16_t*)ga.o4 + (size_t)(mw0 + h * 64) * 64, 64, elane);
          }
        } else if (tn == 16) {
          float* iw = (float*)ga.o5;
          const float sc = 0.35355339059327373f * 0.125f;
#pragma unroll
          for (int mt = 0; mt < 4; mt++) {
            const int m = mw0 + mt * 32 + el31;
            f32x4 o;
            o.x = acc[0][mt][0] * rstd[mt] * sc; o.y = acc[0][mt][1] * rstd[mt] * sc;
            o.z = acc[0][mt][2] * rstd[mt] * sc; o.w = acc[0][mt][3] * rstd[mt] * sc;
            *(f32x4*)(iw + (size_t)m * 8 + 4 * elh) = o;
          }
        }
      }
    } else if (MODE == M_RESID || MODE == M_POOL) {
      float* ho = (float*)ga.o0;
      bf16_t* hb = (bf16_t*)ga.o1;
      const int cch = elane & 15;
      const int n = n0 + ewn * 64 + cch * 4;
      f32x4 cs = f32x4{1.f, 1.f, 1.f, 1.f};
      if (MODE == M_POOL) cs = *(const f32x4*)(ga.g0 + n);
#pragma unroll
      for (int h = 0; h < 2; h++) {
#pragma unroll
        for (int mh = 0; mh < 2; mh++) {
          const int mt = 2 * h + mh;
          const int ml = mh * 32 + el31;
#pragma unroll
          for (int nt = 0; nt < 2; nt++)
#pragma unroll
            for (int q4 = 0; q4 < 4; q4++) {
              const int chunk = nt * 8 + 2 * q4 + elh;
              f32x4 v; v.x = acc[nt][mt][4 * q4 + 0]; v.y = acc[nt][mt][4 * q4 + 1]; v.z = acc[nt][mt][4 * q4 + 2]; v.w = acc[nt][mt][4 * q4 + 3];
              *(f32x4*)(wbuf + ml * 256 + ((chunk ^ (ml & 15)) << 4)) = v;
            }
        }
#pragma unroll 4
        for (int i = 0; i < 16; i++) {
          const int row = i * 4 + (elane >> 4);
          const int m = mw0 + h * 64 + row;
          const f32x4 a = *(const f32x4*)(wbuf + row * 256 + ((cch ^ (row & 15)) << 4));
          const f32x4 rv = *(const f32x4*)(ga.resid + (size_t)m * 1024 + n);
          f32x4 o;
          o.x = rv.x + a.x * cs.x; o.y = rv.y + a.y * cs.y; o.z = rv.z + a.z * cs.z; o.w = rv.w + a.w * cs.w;
          *(f32x4*)(ho + (size_t)m * 1024 + n) = o;
          u32x2 ob; ob.x = pack2(o.x, o.y); ob.y = pack2(o.z, o.w);
          *(u32x2*)(hb + (size_t)m * 1024 + n) = ob;
          float sq = o.x * o.x + o.y * o.y + o.z * o.z + o.w * o.w;
          sq += __shfl_xor(sq, 1); sq += __shfl_xor(sq, 2); sq += __shfl_xor(sq, 4); sq += __shfl_xor(sq, 8);
          if (cch == 0) ga.ssq[(size_t)m * 16 + tn * 2 + ewn] = sq;
        }
      }
    } else if (MODE == M_MLP1) {
#pragma unroll
      for (int h = 0; h < 2; h++) {
#pragma unroll
        for (int mh = 0; mh < 2; mh++) {
          const int mt = 2 * h + mh;
#pragma unroll
          for (int nt = 0; nt < 2; nt++)
#pragma unroll
            for (int q4 = 0; q4 < 4; q4++) {
              const float v0 = fmaxf(acc[nt][mt][4 * q4 + 0] * rstd[mt], 0.f), v1 = fmaxf(acc[nt][mt][4 * q4 + 1] * rstd[mt], 0.f);
              const float v2 = fmaxf(acc[nt][mt][4 * q4 + 2] * rstd[mt], 0.f), v3 = fmaxf(acc[nt][mt][4 * q4 + 3] * rstd[mt], 0.f);
              { u32x2 pv; pv.x = pack2(v0 * v0, v1 * v1); pv.y = pack2(v2 * v2, v3 * v3); wave_put_bf16(wbuf, mh * 32 + el31, nt, q4, elh, pv); }
            }
        }
        wave_flush_bf16(wbuf, (bf16_t*)ga.o0 + (size_t)(mw0 + h * 64) * 4096 + n0 + ewn * 64, 4096, elane);
      }
    }
    __syncthreads();
  }
}

DEVI void grp_barrier(volatile __attribute__((address_space(3))) unsigned* ctr, unsigned& target, const int lane) {
  asm volatile("s_waitcnt vmcnt(0) lgkmcnt(0)" ::: "memory");
  target += 4u;
  if (lane == 0) __hip_atomic_fetch_add((__attribute__((address_space(3))) unsigned*)ctr, 1u, __ATOMIC_RELAXED, __HIP_MEMORY_SCOPE_WORKGROUP);
  while (__hip_atomic_load((__attribute__((address_space(3))) unsigned*)ctr, __ATOMIC_RELAXED, __HIP_MEMORY_SCOPE_WORKGROUP) < target) __builtin_amdgcn_s_sleep(1);
  asm volatile("" ::: "memory");
}

template <int DQK, bool MASKED>
DEVI void flash_qtile(const bf16_t* __restrict__ qrow, const bf16_t* __restrict__ Kb, const int kstride,
                      const bf16_t* __restrict__ Vt, const u64* __restrict__ mrow, const int qt,
                      char* smem, f32x16 (&O)[4], const float negc0,
                      volatile __attribute__((address_space(3))) unsigned* gctr, unsigned& gtarget) {
  constexpr int KROWB = DQK * 2;
  constexpr int KS = DQK / 16;
  constexpr int KBYTES = 64 * KROWB;
  constexpr int STAGE = KBYTES + 16384;
  constexpr int KI = KBYTES / 4096;
  const int tid = otid(), lane = tid & 63, w = tid >> 6;
  const int l31 = lane & 31, lh = lane >> 5;
  unsigned kgo[KI], vgo[4];
#pragma unroll
  for (int i = 0; i < KI; i++) {
    const int blk = i * 4 + w;
    int row, kc;
    if (DQK == 64) { row = blk * 8 + (lane >> 3); kc = (lane & 7) ^ ((row >> 1) & 7); }
    else { row = blk * 4 + (lane >> 4); kc = (lane & 15) ^ (row & 15); }
    kgo[i] = (unsigned)(row * kstride + kc * 8) * 2u;
  }
#pragma unroll
  for (int i = 0; i < 4; i++) {
    const int blk = i * 4 + w;
    const int row = blk * 8 + (lane >> 3);
    const int kc = (lane & 7) ^ ((row >> 1) & 7);
    vgo[i] = (unsigned)(row * 4096 + kc * 8) * 2u;
  }
  bf16x8 qf[KS];
#pragma unroll
  for (int ks = 0; ks < KS; ks++) qf[ks] = *(const bf16x8*)(qrow + 16 * ks + 8 * lh);
#pragma unroll
  for (int eb = 0; eb < 4; eb++)
#pragma unroll
    for (int r = 0; r < 16; r++) O[eb][r] = 0.f;
  float lsum = 0.f;
  const int ntile = 2 * qt + 2;
  const int mylast = 2 * qt + (w >> 1);
  u64 mw_next = 0ull;
  if (MASKED) mw_next = mrow[0];
  grp_barrier(gctr, gtarget, lane);
  {
    const char* kt = (const char*)Kb;
    const char* vtp = (const char*)Vt;
#pragma unroll
    for (int i = 0; i < KI; i++)
      __builtin_amdgcn_global_load_lds((const unsigned*)(kt + kgo[i]), (__attribute__((address_space(3))) unsigned*)(smem + (i * 4 + w) * 1024), 16, 0, 0);
#pragma unroll
    for (int i = 0; i < 4; i++)
      __builtin_amdgcn_global_load_lds((const unsigned*)(vtp + vgo[i]), (__attribute__((address_space(3))) unsigned*)(smem + KBYTES + (i * 4 + w) * 1024), 16, 0, 0);
  }
  grp_barrier(gctr, gtarget, lane);
  for (int j = 0; j < ntile; j++) {
    const char* st = smem + (j & 1) * STAGE;
    const bool more = (j + 1 < ntile);
    if (more) {
      const char* kt = (const char*)Kb + (size_t)(j + 1) * 64 * kstride * 2;
      const char* vtp = (const char*)Vt + (size_t)(j + 1) * 64 * 2;
      char* sn = smem + ((j + 1) & 1) * STAGE;
#pragma unroll
      for (int i = 0; i < KI; i++) {
        unsigned off = kgo[i];
        asm volatile("" : "+v"(off));
        __builtin_amdgcn_global_load_lds((const unsigned*)(kt + off), (__attribute__((address_space(3))) unsigned*)(sn + (i * 4 + w) * 1024), 16, 0, 0);
      }
#pragma unroll
      for (int i = 0; i < 4; i++) {
        unsigned off = vgo[i];
        asm volatile("" : "+v"(off));
        __builtin_amdgcn_global_load_lds((const unsigned*)(vtp + off), (__attribute__((address_space(3))) unsigned*)(sn + KBYTES + (i * 4 + w) * 1024), 16, 0, 0);
      }
    }
    const u64 mw = mw_next;
    if (MASKED && more) mw_next = mrow[j + 1];
    if (j <= mylast) {
      f32x16 S[2];
#pragma unroll
      for (int mt = 0; mt < 2; mt++)
#pragma unroll
        for (int r = 0; r < 16; r++) S[mt][r] = negc0;
#pragma unroll
      for (int ks = 0; ks < KS; ks++)
#pragma unroll
        for (int mt = 0; mt < 2; mt++) {
          bf16x8 kf = *(const bf16x8*)(st + lds_off<KROWB>(mt * 32 + l31, 2 * ks + lh));
          S[mt] = mfma32(kf, qf[ks], S[mt]);
        }
      unsigned wlo = 0xffffffffu, whi = 0xffffffffu;
      if (MASKED) {
        wlo = ((unsigned)mw) >> (4 * lh);
        whi = ((unsigned)(mw >> 32)) >> (4 * lh);
      }
      float ps = 0.f;
#pragma unroll
      for (int mt = 0; mt < 2; mt++)
#pragma unroll
        for (int r = 0; r < 16; r++) {
          float pv = fexp2(S[mt][r]);
          if (MASKED) {
            const unsigned wd = mt ? whi : wlo;
            pv = ((wd >> ((r & 3) + 8 * (r >> 2))) & 1u) ? pv : 0.f;
          }
          S[mt][r] = pv;
          ps += pv;
        }
      lsum += ps;
#pragma unroll
      for (int kb = 0; kb < 2; kb++)
#pragma unroll
        for (int s = 0; s < 2; s++) {
          u32x4 pfu;
          pfu.x = pack2(S[kb][8 * s + 0], S[kb][8 * s + 1]);
          pfu.y = pack2(S[kb][8 * s + 2], S[kb][8 * s + 3]);
          pfu.z = pack2(S[kb][8 * s + 4], S[kb][8 * s + 5]);
          pfu.w = pack2(S[kb][8 * s + 6], S[kb][8 * s + 7]);
          const bf16x8 pfv = __builtin_bit_cast(bf16x8, pfu);
#pragma unroll
          for (int eb = 0; eb < 4; eb++) {
            const int row = eb * 32 + l31;
            const u32x2 h0 = *(const u32x2*)(st + KBYTES + lds_off<128>(row, 4 * kb + 2 * s) + 8 * lh);
            const u32x2 h1 = *(const u32x2*)(st + KBYTES + lds_off<128>(row, 4 * kb + 2 * s + 1) + 8 * lh);
            const u32x4 vfu = u32x4{h0.x, h0.y, h1.x, h1.y};
            O[eb] = mfma32(__builtin_bit_cast(bf16x8, vfu), pfv, O[eb]);
          }
        }
    }
    grp_barrier(gctr, gtarget, lane);
  }
  float lt = lsum + __shfl_xor(lsum, 32);
  const float inv = 1.f / lt;
#pragma unroll
  for (int eb = 0; eb < 4; eb++)
#pragma unroll
    for (int r = 0; r < 16; r++) O[eb][r] *= inv;
}

DEVI void flash_qtile_pipe(const bf16_t* __restrict__ qrow, const bf16_t* __restrict__ Kb, const int kstride,
                           const bf16_t* __restrict__ Vt, const int qt,
                           char* smem, f32x16 (&O)[4], const float negc0,
                           volatile __attribute__((address_space(3))) unsigned* gctr, unsigned& gtarget) {
  constexpr int KBYTES = 64 * 128;
  constexpr int STAGE = KBYTES + 16384;
  const int tid = otid(), lane = tid & 63, w = tid >> 6;
  const int l31 = lane & 31, lh = lane >> 5;
  unsigned kgo[2], vgo[4];
#pragma unroll
  for (int i = 0; i < 2; i++) {
    const int blk = i * 4 + w;
    const int row = blk * 8 + (lane >> 3);
    const int kc = (lane & 7) ^ ((row >> 1) & 7);
    kgo[i] = (unsigned)(row * kstride + kc * 8) * 2u;
  }
#pragma unroll
  for (int i = 0; i < 4; i++) {
    const int blk = i * 4 + w;
    const int row = blk * 8 + (lane >> 3);
    const int kc = (lane & 7) ^ ((row >> 1) & 7);
    vgo[i] = (unsigned)(row * 4096 + kc * 8) * 2u;
  }
  bf16x8 qf[4];
#pragma unroll
  for (int ks = 0; ks < 4; ks++) qf[ks] = *(const bf16x8*)(qrow + 16 * ks + 8 * lh);
#pragma unroll
  for (int eb = 0; eb < 4; eb++)
#pragma unroll
    for (int r = 0; r < 16; r++) O[eb][r] = 0.f;
  float lsum = 0.f;
  const int ntile = 2 * qt + 2;
  const int mylast = 2 * qt + (w >> 1);
#define FP_DMA_K(T, STG)                                                                              \
  { const char* kt = (const char*)Kb + (size_t)(T) * 64 * kstride * 2;                                \
    _Pragma("unroll") for (int i = 0; i < 2; i++) {                                                   \
      unsigned off = kgo[i]; asm volatile("" : "+v"(off));                                            \
      __builtin_amdgcn_global_load_lds((const unsigned*)(kt + off), (__attribute__((address_space(3))) unsigned*)(smem + (STG) * STAGE + (i * 4 + w) * 1024), 16, 0, 0); } }
#define FP_DMA_V(T, STG)                                                                              \
  { const char* vtp = (const char*)Vt + (size_t)(T) * 64 * 2;                                         \
    _Pragma("unroll") for (int i = 0; i < 4; i++) {                                                   \
      unsigned off = vgo[i]; asm volatile("" : "+v"(off));                                            \
      __builtin_amdgcn_global_load_lds((const unsigned*)(vtp + off), (__attribute__((address_space(3))) unsigned*)(smem + (STG) * STAGE + KBYTES + (i * 4 + w) * 1024), 16, 0, 0); } }
#define FP_QK(SX, STG)                                                                                \
  { _Pragma("unroll") for (int mt = 0; mt < 2; mt++)                                                  \
      _Pragma("unroll") for (int r = 0; r < 16; r++) SX[mt][r] = negc0;                               \
    _Pragma("unroll") for (int ks = 0; ks < 4; ks++)                                                  \
      _Pragma("unroll") for (int mt = 0; mt < 2; mt++) {                                              \
        bf16x8 kf = *(const bf16x8*)(smem + (STG) * STAGE + lds_off<128>(mt * 32 + l31, 2 * ks + lh)); \
        SX[mt] = mfma32(kf, qf[ks], SX[mt]); } }
#define FP_SMPV(SX, STG)                                                                              \
  { float ps = 0.f;                                                                                   \
    _Pragma("unroll") for (int mt = 0; mt < 2; mt++)                                                  \
      _Pragma("unroll") for (int r = 0; r < 16; r++) { const float pv = fexp2(SX[mt][r]); SX[mt][r] = pv; ps += pv; } \
    lsum += ps;                                                                                       \
    _Pragma("unroll") for (int kb = 0; kb < 2; kb++)                                                  \
      _Pragma("unroll") for (int s = 0; s < 2; s++) {                                                 \
        u32x4 pfu;                                                                                    \
        pfu.x = pack2(SX[kb][8 * s + 0], SX[kb][8 * s + 1]);                                          \
        pfu.y = pack2(SX[kb][8 * s + 2], SX[kb][8 * s + 3]);                                          \
        pfu.z = pack2(SX[kb][8 * s + 4], SX[kb][8 * s + 5]);                                          \
        pfu.w = pack2(SX[kb][8 * s + 6], SX[kb][8 * s + 7]);                                          \
        const bf16x8 pfv = __builtin_bit_cast(bf16x8, pfu);                                           \
        _Pragma("unroll") for (int eb = 0; eb < 4; eb++) {                                            \
          const int row = eb * 32 + l31;                                                              \
          const u32x2 h0 = *(const u32x2*)(smem + (STG) * STAGE + KBYTES + lds_off<128>(row, 4 * kb + 2 * s) + 8 * lh);     \
          const u32x2 h1 = *(const u32x2*)(smem + (STG) * STAGE + KBYTES + lds_off<128>(row, 4 * kb + 2 * s + 1) + 8 * lh); \
          const u32x4 vfu = u32x4{h0.x, h0.y, h1.x, h1.y};                                            \
          O[eb] = mfma32(__builtin_bit_cast(bf16x8, vfu), pfv, O[eb]); } } }
#define FP_STEP(J, SCUR, SNEXT, STG)                                                                  \
  { if ((J) + 2 < ntile) FP_DMA_K((J) + 2, STG)                                                       \
    if ((J) + 1 < ntile) FP_DMA_V((J) + 1, (STG) ^ 1)                                                 \
    if ((J) + 1 <= mylast) FP_QK(SNEXT, (STG) ^ 1)                                                    \
    if ((J) <= mylast) FP_SMPV(SCUR, STG)                                                             \
    grp_barrier(gctr, gtarget, lane); }
  f32x16 SA[2], SB[2];
  grp_barrier(gctr, gtarget, lane);
  FP_DMA_K(0, 0)
  FP_DMA_V(0, 0)
  FP_DMA_K(1, 1)
  grp_barrier(gctr, gtarget, lane);
  FP_QK(SA, 0)
  grp_barrier(gctr, gtarget, lane);
#pragma unroll
  for (int mt = 0; mt < 2; mt++)
#pragma unroll
    for (int r = 0; r < 16; r++) SB[mt][r] = 0.f;
  for (int j = 0; j < ntile; j += 2) {
    FP_STEP(j, SA, SB, 0)
    FP_STEP(j + 1, SB, SA, 1)
  }
#undef FP_DMA_K
#undef FP_DMA_V
#undef FP_QK
#undef FP_SMPV
#undef FP_STEP
  float lt = lsum + __shfl_xor(lsum, 32);
  const float inv = 1.f / lt;
#pragma unroll
  for (int eb = 0; eb < 4; eb++)
#pragma unroll
    for (int r = 0; r < 16; r++) O[eb][r] *= inv;
}

DEVI void attnA_phase(const Params& p, int jl, float lambda_init, char* smem,
                        volatile __attribute__((address_space(3))) unsigned* gctr, unsigned& gtarget) {
  const int tid = otid(), lane = tid & 63, w = tid >> 6;
  const int l31 = lane & 31, lh = lane >> 5;
  const bf16_t* qk = (const bf16_t*)(p.ws + R_QK);
  const bf16_t* vt = (const bf16_t*)(p.ws + R_VT);
  bf16_t* ao = (bf16_t*)(p.ws + R_AO);
  float s1 = p.a_lq1[jl * 64 + lane] * p.a_lk1[jl * 64 + lane];
  float s2 = p.a_lq2[jl * 64 + lane] * p.a_lk2[jl * 64 + lane];
#pragma unroll
  for (int o = 32; o >= 1; o >>= 1) { s1 += __shfl_xor(s1, o); s2 += __shfl_xor(s2, o); }
  const float lam = expf(s1) - expf(s2) + lambda_init;
  float gq = fabsf(p.a_q_g[jl * 64 + lane]), gk = fabsf(p.a_k_g[jl * 64 + lane]);
#pragma unroll
  for (int o = 32; o >= 1; o >>= 1) { gq = fmaxf(gq, __shfl_xor(gq, o)); gk = fmaxf(gk, __shfl_xor(gk, o)); }
  const float negc0 = -(8.0f * gq * gk * LOG2E * 1.01f);
  const float* subg = p.a_sub_g + jl * 128;
  for (int item = vblk(); item < 512; item += nvblk()) {
    const int pr = item & 15, h = (item >> 4) & 7, b = item >> 7;
    for (int qi = 0; qi < 2; qi++) {
      const int qt = qi ? pr : (31 - pr);
      const int t = b * SEQ + qt * 128 + w * 32 + l31;
      f32x16 O[4];
      flash_qtile_pipe(qk + (size_t)t * 2048 + h * 128, qk + (size_t)b * SEQ * 2048 + 1024 + h * 128, 2048,
                             vt + (size_t)(b * 8 + h) * 128 * 4096, qt, smem, O, negc0, gctr, gtarget);
#pragma unroll
      for (int eb = 0; eb < 4; eb++)
#pragma unroll
        for (int q4 = 0; q4 < 4; q4++) {
          const int e = eb * 32 + 8 * q4 + 4 * lh;
          u32x2 o;
          o.x = pack2(O[eb][4 * q4 + 0], O[eb][4 * q4 + 1]);
          o.y = pack2(O[eb][4 * q4 + 2], O[eb][4 * q4 + 3]);
          *(u32x2*)(ao + (size_t)t * 1024 + h * 128 + e) = o;
        }
      flash_qtile_pipe(qk + (size_t)t * 2048 + h * 128 + 64, qk + (size_t)b * SEQ * 2048 + 1024 + h * 128 + 64, 2048,
                             vt + (size_t)(b * 8 + h) * 128 * 4096, qt, smem, O, negc0, gctr, gtarget);
      float ssq = 0.f;
#pragma unroll
      for (int eb = 0; eb < 4; eb++)
#pragma unroll
        for (int q4 = 0; q4 < 4; q4++) {
          const int e = eb * 32 + 8 * q4 + 4 * lh;
          const u32x2 o1 = *(const u32x2*)(ao + (size_t)t * 1024 + h * 128 + e);
          const float a0 = bf_lo(o1.x) - lam * O[eb][4 * q4 + 0];
          const float a1 = bf_hi(o1.x) - lam * O[eb][4 * q4 + 1];
          const float a2 = bf_lo(o1.y) - lam * O[eb][4 * q4 + 2];
          const float a3 = bf_hi(o1.y) - lam * O[eb][4 * q4 + 3];
          O[eb][4 * q4 + 0] = a0; O[eb][4 * q4 + 1] = a1; O[eb][4 * q4 + 2] = a2; O[eb][4 * q4 + 3] = a3;
          ssq += a0 * a0 + a1 * a1 + a2 * a2 + a3 * a3;
        }
      ssq += __shfl_xor(ssq, 32);
      const float rn = rsqrtf(ssq * (1.f / 128.f) + EPS) * (1.f - lambda_init);
#pragma unroll
      for (int eb = 0; eb < 4; eb++)
#pragma unroll
        for (int q4 = 0; q4 < 4; q4++) {
          const int e = eb * 32 + 8 * q4 + 4 * lh;
          const f32x4 gv = *(const f32x4*)(subg + e);
          u32x2 o;
          o.x = pack2(O[eb][4 * q4 + 0] * rn * gv.x, O[eb][4 * q4 + 1] * rn * gv.y);
          o.y = pack2(O[eb][4 * q4 + 2] * rn * gv.z, O[eb][4 * q4 + 3] * rn * gv.w);
          *(u32x2*)(ao + (size_t)t * 1024 + h * 128 + e) = o;
        }
    }
  }
}

DEVI void attnC_phase(const Params& p, char* smem, volatile __attribute__((address_space(3))) unsigned* gctr, unsigned& gtarget) {
  const int tid = otid(), lane = tid & 63, w = tid >> 6;
  const int l31 = lane & 31, lh = lane >> 5;
  const bf16_t* cq = (const bf16_t*)(p.ws + R_CQ);
  const bf16_t* ck = (const bf16_t*)(p.ws + R_CK);
  const bf16_t* cvt = (const bf16_t*)(p.ws + R_CVT);
  const u64* mask = (const u64*)(p.ws + R_MASK);
  bf16_t* ao = (bf16_t*)(p.ws + R_AO);
  float gq = fmaxf(fabsf(p.c_q_g[lane]), fabsf(p.c_q_g[64 + lane])), gk = fmaxf(fabsf(p.c_k_g[lane]), fabsf(p.c_k_g[64 + lane]));
#pragma unroll
  for (int o = 32; o >= 1; o >>= 1) { gq = fmaxf(gq, __shfl_xor(gq, o)); gk = fmaxf(gk, __shfl_xor(gk, o)); }
  const float negc0 = -(11.313708498984761f * gq * gk * LOG2E * 1.01f);
  for (int item = vblk(); item < 512; item += nvblk()) {
    const int pr = item & 15, hh = (item >> 4) & 7, b = item >> 7;
    const int g = hh >> 2;
    for (int qi = 0; qi < 2; qi++) {
      const int qt = qi ? pr : (31 - pr);
      const int t = b * SEQ + qt * 128 + w * 32 + l31;
      f32x16 O[4];
      flash_qtile<128, true>(cq + (size_t)t * 1024 + hh * 128, ck + (size_t)b * SEQ * 256 + g * 128, 256,
                             cvt + (size_t)(b * 2 + g) * 128 * 4096, mask + (size_t)t * 64, qt, smem, O, negc0, gctr, gtarget);
#pragma unroll
      for (int eb = 0; eb < 4; eb++)
#pragma unroll
        for (int q4 = 0; q4 < 4; q4++) {
          const int e = eb * 32 + 8 * q4 + 4 * lh;
          u32x2 o;
          o.x = pack2(O[eb][4 * q4 + 0], O[eb][4 * q4 + 1]);
          o.y = pack2(O[eb][4 * q4 + 2], O[eb][4 * q4 + 3]);
          *(u32x2*)(ao + (size_t)t * 1024 + hh * 128 + e) = o;
        }
    }
  }
}

DEVI void pool_phase(const Params& p, char* smem) {
  const int tid = otid(), lane = tid & 63, w = tid >> 6;
  float* rs = (float*)smem;
  const float* h = p.out;
  bf16_t* pooled = (bf16_t*)(p.ws + R_POOL);
  for (int tile = vblk(); tile < T_TOK / 32; tile += nvblk()) {
    const int t0 = tile * 32;
    const int pos0 = t0 & (SEQ - 1);
    __syncthreads();
    for (int r = w; r < 47; r += 4) {
      const int pos = pos0 - 15 + r;
      if (pos >= 0) {
        const float* row = h + (size_t)(t0 - 15 + r) * 1024;
        float s = 0.f;
#pragma unroll
        for (int i = 0; i < 4; i++) {
          f32x4 v = *(const f32x4*)(row + i * 256 + lane * 4);
          s += v.x * v.x + v.y * v.y + v.z * v.z + v.w * v.w;
        }
#pragma unroll
        for (int o = 32; o >= 1; o >>= 1) s += __shfl_xor(s, o);
        if (lane == 0) rs[r] = rsqrtf(s * (1.f / 1024.f) + EPS);
      }
    }
    __syncthreads();
    const int c = tid * 4;
    const int grp = c >> 8;
    const int win = 2 << grp;
    f32x4 sum = f32x4{0.f, 0.f, 0.f, 0.f};
    for (int r = -(win - 1); r < 0; r++) {
      if (pos0 + r >= 0) {
        f32x4 v = *(const f32x4*)(h + (size_t)(t0 + r) * 1024 + c);
        const float s = rs[r + 15];
        sum.x += v.x * s; sum.y += v.y * s; sum.z += v.z * s; sum.w += v.w * s;
      }
    }
    for (int r = 0; r < 32; r++) {
      f32x4 v = *(const f32x4*)(h + (size_t)(t0 + r) * 1024 + c);
      const float s = rs[r + 15];
      v.x *= s; v.y *= s; v.z *= s; v.w *= s;
      sum.x += v.x; sum.y += v.y; sum.z += v.z; sum.w += v.w;
      const int pos = pos0 + r;
      const float ic = 1.f / (float)min(pos + 1, win);
      u32x2 o;
      o.x = pack2(sum.x * ic - v.x, sum.y * ic - v.y);
      o.y = pack2(sum.z * ic - v.z, sum.w * ic - v.w);
      *(u32x2*)(pooled + (size_t)(t0 + r) * 1024 + c) = o;
      const int ro = r - win + 1;
      if (pos0 + ro >= 0) {
        f32x4 u = *(const f32x4*)(h + (size_t)(t0 + ro) * 1024 + c);
        const float so = rs[ro + 15];
        sum.x -= u.x * so; sum.y -= u.y * so; sum.z -= u.z * so; sum.w -= u.w * so;
      }
    }
  }
}

DEVI unsigned fkey(float f) {
  unsigned u = __float_as_uint(f);
  return (u & 0x80000000u) ? ~u : (u | 0x80000000u);
}

template <int NR>
DEVI void select_topk(const float* srow, const int c, const int lane, u64* mrow) {
  unsigned kreg[NR];
#pragma unroll
  for (int j = 0; j < NR; j++) {
    const unsigned k = fkey(srow[j * 64 + lane]);
    kreg[j] = (j <= c) ? k : 0u;
  }
  unsigned T = 0u;
  bool exact = false;
#pragma unroll 1
  for (int bit = 31; bit >= 0; bit--) {
    const unsigned cand = T | (1u << bit);
    int cnt = 0;
#pragma unroll
    for (int j = 0; j < NR; j++) cnt += __popcll(__ballot(kreg[j] >= cand));
    if (cnt >= 256) T = cand;
    if (cnt == 256) { exact = true; break; }
  }
  asm volatile("" : "+v"(T));
  if (exact) {
#pragma unroll
    for (int j = 0; j < NR; j++) {
      const u64 bm = __ballot(kreg[j] >= T);
      if (lane == 0) mrow[j] = bm;
    }
  } else {
    int cgt = 0;
#pragma unroll
    for (int j = 0; j < NR; j++) cgt += __popcll(__ballot(kreg[j] > T));
    int need = 256 - cgt;
#pragma unroll
    for (int j = 0; j < NR; j++) {
      const u64 gt = __ballot(kreg[j] > T);
      const u64 eq = __ballot(kreg[j] == T);
      const int rank = __popcll(eq & ((1ull << lane) - 1ull));
      const u64 tk = __ballot((kreg[j] == T) && (rank < need));
      need -= __popcll(eq);
      const u64 bm = gt | tk;
      if (lane == 0) mrow[j] = bm;
    }
  }
}

DEVI void index_unit(const Params& p, int unit, char* smem, volatile __attribute__((address_space(3))) unsigned* gctr, unsigned& gtarget) {
  const int tid = otid(), lane = tid & 63, w = tid >> 6;
  const int l31 = lane & 31, lh = lane >> 5;
  const int c = unit >> 4, b = (unit >> 2) & 3, qr = unit & 3;
  const int t0 = b * SEQ + c * 64 + qr * 16;
  u64* mask = (u64*)(p.ws + R_MASK);
  if (c < 4) {
    if (tid < 16 * (c + 1)) {
      const int q = tid / (c + 1), j = tid % (c + 1);
      u64 ones = ~0ull;
      asm volatile("" : "+v"(ones));
      mask[(size_t)(t0 + q) * 64 + j] = ones;
    }
    return;
  }
  const bf16_t* ciq = (const bf16_t*)(p.ws + R_CIQ);
  const bf16_t* cik = (const bf16_t*)(p.ws + R_CIK);
  const float* ciw = (const float*)(p.ws + R_CIW);
  float* sc = (float*)smem;
  const int nkb = 2 * (c + 1);
  for (int grp = 0; grp < 4; grp++) {
    const int tq = t0 + grp * 4;
    {
      const int a = l31 >> 3, gg = (l31 >> 2) & 1, bq = l31 & 3;
      const int qloc = 2 * gg + (a >> 1), head = (a & 1) * 4 + bq;
      bf16x8 af[4];
#pragma unroll
      for (int ks = 0; ks < 4; ks++) af[ks] = *(const bf16x8*)(ciq + (size_t)(tq + qloc) * 512 + head * 64 + 16 * ks + 8 * lh);
      float wq0[8], wq1[8];
      {
        const f32x4 a0 = *(const f32x4*)(ciw + (size_t)(tq + 2 * lh) * 8), a1 = *(const f32x4*)(ciw + (size_t)(tq + 2 * lh) * 8 + 4);
        const f32x4 b0 = *(const f32x4*)(ciw + (size_t)(tq + 2 * lh + 1) * 8), b1 = *(const f32x4*)(ciw + (size_t)(tq + 2 * lh + 1) * 8 + 4);
        wq0[0] = a0.x; wq0[1] = a0.y; wq0[2] = a0.z; wq0[3] = a0.w; wq0[4] = a1.x; wq0[5] = a1.y; wq0[6] = a1.z; wq0[7] = a1.w;
        wq1[0] = b0.x; wq1[1] = b0.y; wq1[2] = b0.z; wq1[3] = b0.w; wq1[4] = b1.x; wq1[5] = b1.y; wq1[6] = b1.z; wq1[7] = b1.w;
      }
      const int nit = (nkb - w + 3) >> 2;
      const bf16_t* ikb = cik + (size_t)b * SEQ * 64 + 8 * lh;
      bf16x8 nb[4][4];
#pragma unroll
      for (int u = 0; u < 4; u++) {
        const int kb = min(w + 4 * u, nkb - 1);
#pragma unroll
        for (int ks = 0; ks < 4; ks++) nb[u][ks] = *(const bf16x8*)(ikb + (size_t)(kb * 32 + l31) * 64 + 16 * ks);
      }
      for (int it0 = 0; it0 < nit; it0 += 4) {
        bf16x8 cb[4][4];
#pragma unroll
        for (int u = 0; u < 4; u++)
#pragma unroll
          for (int ks = 0; ks < 4; ks++) cb[u][ks] = nb[u][ks];
        if (it0 + 4 < nit) {
#pragma unroll
          for (int u = 0; u < 4; u++) {
            const int kb = min(w + 4 * (it0 + 4 + u), nkb - 1);
#pragma unroll
            for (int ks = 0; ks < 4; ks++) nb[u][ks] = *(const bf16x8*)(ikb + (size_t)(kb * 32 + l31) * 64 + 16 * ks);
          }
        }
#pragma unroll
        for (int u = 0; u < 4; u++) {
          const int kb = w + 4 * (it0 + u);
          f32x16 acc;
#pragma unroll
          for (int r = 0; r < 16; r++) acc[r] = 0.f;
#pragma unroll
          for (int ks = 0; ks < 4; ks++) acc = mfma32(af[ks], cb[u][ks], acc);
          float s0 = 0.f, s1 = 0.f;
#pragma unroll
          for (int r = 0; r < 8; r++) s0 += wq0[r] * fmaxf(acc[r], 0.f);
#pragma unroll
          for (int r = 0; r < 8; r++) s1 += wq1[r] * fmaxf(acc[8 + r], 0.f);
          if (s0 == 0.f) s0 = 0.f;
          if (s1 == 0.f) s1 = 0.f;
          if (kb < nkb) {
            const int key = kb * 32 + l31;
            sc[(2 * lh) * 4096 + key] = s0;
            sc[(2 * lh + 1) * 4096 + key] = s1;
          }
        }
      }
    }
    grp_barrier(gctr, gtarget, lane);
    {
      u64* mrow = mask + (size_t)(tq + w) * 64;
      const float* srow = sc + w * 4096;
      if (c < 16) select_topk<16>(srow, c, lane, mrow);
      else if (c < 32) select_topk<32>(srow, c, lane, mrow);
      else if (c < 48) select_topk<48>(srow, c, lane, mrow);
      else select_topk<64>(srow, c, lane, mrow);
    }
    grp_barrier(gctr, gtarget, lane);
  }
}

DEVI void index_phase(const Params& p, char* smem, volatile __attribute__((address_space(3))) unsigned* gctr, unsigned& gtarget) {
  for (int it2 = vblk() * 2; it2 < 1024; it2 += nvblk() * 2) {
    for (int k = 0; k < 2; k++) {
      const int item = it2 >> 1;
      index_unit(p, k ? item : (1023 - item), smem, gctr, gtarget);
    }
  }
}


#define XB_TMO      128
#define XB_XCNT(j)  (256  + 64 * (j))
#define XB_XSUB(j)  (1280 + 64 * (j))
#define XB_XGEN(j)  (2304 + 64 * (j))
#define XB_TOP      3328
#define XB_TOPGEN   3392
#define XCD_BAR_WORDS 3456
#define XB_SPIN_CAP (1u << 22)
#define LAS __attribute__((address_space(3)))
constexpr size_t OFF_BAR = 250 * MB;

DEVI unsigned xb_ld(unsigned* p)              { return __hip_atomic_load(p, __ATOMIC_RELAXED, __HIP_MEMORY_SCOPE_AGENT); }
DEVI unsigned xb_add(unsigned* p, unsigned v) { return __hip_atomic_fetch_add(p, v, __ATOMIC_RELAXED, __HIP_MEMORY_SCOPE_AGENT); }
DEVI unsigned xb_xcc_id() { return (unsigned)__builtin_amdgcn_s_getreg((3 << 11) | 20) & 0xFu; }
#define XB_SPIN(cond, bar) do { unsigned _sp = 0; while (cond) { __builtin_amdgcn_s_sleep(1); \
    if ((++_sp & 255u) == 0u) { if (xb_ld(&(bar)[XB_TMO])) break; if (_sp > XB_SPIN_CAP) { atomicAdd(&(bar)[XB_TMO], 1u); break; } } } } while (0)

struct XcdBarrier { unsigned* bar; volatile LAS unsigned* st; };

DEVI XcdBarrier xcd_barrier_post(unsigned* bar, volatile LAS unsigned* st) {
  XcdBarrier b; b.bar = bar; b.st = st;
  if (threadIdx.x == 0) (void)xb_add(&bar[XB_XCNT(xb_xcc_id())], 1u);
  return b;
}
DEVI void xcd_barrier_complete(unsigned* bar, unsigned x, unsigned& nloc, unsigned& nx) {
  const unsigned G = gridDim.x * gridDim.y * gridDim.z;
  unsigned sum, cnt, mine, sp = 0u;
  for (;;) {
    sum = 0u; cnt = 0u; mine = 0u;
#pragma unroll
    for (unsigned j = 0; j < 16; ++j) { const unsigned c = xb_ld(&bar[XB_XCNT(j)]); sum += c; cnt += (c > 0u) ? 1u : 0u; mine = (j == x) ? c : mine; }
    if (sum == G) break;
    __builtin_amdgcn_s_sleep(1);
    if ((++sp & 255u) == 0u) { if (xb_ld(&bar[XB_TMO])) break; if (sp > XB_SPIN_CAP) { atomicAdd(&bar[XB_TMO], 1u); break; } }
  }
  nloc = mine > 0u ? mine : 1u; nx = cnt > 0u ? cnt : 1u;
}
DEVI void xcd_barrier(const XcdBarrier& b) {
  asm volatile("s_waitcnt vmcnt(0)" ::: "memory");
  __syncthreads();
  if (threadIdx.x == 0) {
    unsigned* bar = b.bar;
    const unsigned bx = xb_xcc_id();
    __builtin_amdgcn_s_waitcnt(0);
    unsigned nloc = b.st[0], nx = b.st[1];
    if (nloc == 0u) { xcd_barrier_complete(bar, bx, nloc, nx); b.st[0] = nloc; b.st[1] = nx; }
    const unsigned old = xb_add(&bar[XB_XSUB(bx)], 1u);
    const unsigned gen = old / nloc;
    if (old + 1u == (gen + 1u) * nloc) {
      __builtin_amdgcn_fence(__ATOMIC_RELEASE, "agent");
      asm volatile("s_waitcnt vmcnt(0)" ::: "memory");
      const unsigned og = xb_add(&bar[XB_TOP], 1u);
      const unsigned tg = og / nx;
      if (og + 1u == (tg + 1u) * nx) xb_add(&bar[XB_TOPGEN], 1u);
      else XB_SPIN(xb_ld(&bar[XB_TOPGEN]) == tg, bar);
      __builtin_amdgcn_fence(__ATOMIC_ACQUIRE, "agent");
      xb_add(&bar[XB_XGEN(bx)], 1u);
      asm volatile("s_waitcnt vmcnt(0)" ::: "memory");
    } else {
      XB_SPIN(xb_ld(&bar[XB_XGEN(bx)]) == gen, bar);
      __builtin_amdgcn_fence(__ATOMIC_ACQUIRE, "agent");
      asm volatile("s_waitcnt vmcnt(0)" ::: "memory");
    }
  }
  __syncthreads();
}

__global__ void __launch_bounds__(512, 2) fwd_megakernel(Params p) {
  __shared__ __attribute__((aligned(16))) char smem[SMEM_BYTES];
  cg::grid_group grid = cg::this_grid();
  char* gs = smem + grp_id() * 65536;
  char* ws = p.ws;
  __shared__ __attribute__((aligned(16))) unsigned xb_words[4];
  if (threadIdx.x == 0) { xb_words[0] = 0u; xb_words[1] = 0u; xb_words[2] = 0u; xb_words[3] = 0u; }
  __syncthreads();
  volatile LAS unsigned* gctr = (volatile LAS unsigned*)&xb_words[2 + grp_id()];
  unsigned gtarget = 0u;
  const XcdBarrier xb = xcd_barrier_post((unsigned*)(ws + OFF_BAR), (volatile LAS unsigned*)xb_words);
  if (gridDim.y == 0x7fffffffu) grid.sync();
  bf16_t* hb = (bf16_t*)(ws + OFF_HB);

  for (int rep = 0; rep <= DUP_CONV; rep++) convert_phase(p, gs);
  xcd_barrier(xb);

  for (int layer = 0; layer < 4; layer++) {
    const int mixer = layer % 3, jl = layer / 3;
    const float* resid_src = (layer == 0) ? p.x : p.out;
    if (mixer == 0) {
      const float lambda_init = (layer == 0) ? 0.2f : 0.5560582041564594f;
      {
        GemmArgs ga{};
      ga.ssq = (float*)(ws + OFF_SSQ);
        ga.ssq = (float*)(ws + OFF_SSQ);
        ga.A = hb; ga.lda = 1024; ga.Bt = (const bf16_t*)(ws + OFF_AIN + (size_t)jl * 6 * MB); ga.K = 1024; ga.NT = 12;
        ga.o0 = ws + R_QK; ga.o1 = ws + R_VT; ga.g0 = p.a_q_g + jl * 64; ga.g1 = p.a_k_g + jl * 64;
        for (int rep = 0; rep <= DUP_GEMM; rep++) gemm_phase<M_AQKV, 1024>(ga, smem);
      }
      xcd_barrier(xb);
      if (grp_id() == 1) __builtin_amdgcn_s_setprio(1);
      for (int rep = 0; rep <= DUP_ATTNA; rep++) attnA_phase(p, jl, lambda_init, gs, gctr, gtarget);
      __builtin_amdgcn_s_setprio(0);
      xcd_barrier(xb);
      {
        GemmArgs ga{};
      ga.ssq = (float*)(ws + OFF_SSQ);
        ga.ssq = (float*)(ws + OFF_SSQ);
        ga.A = (const bf16_t*)(ws + R_AO); ga.lda = 1024; ga.Bt = (const bf16_t*)(ws + OFF_AOUT + (size_t)jl * 2 * MB); ga.K = 1024; ga.NT = 4;
        ga.o0 = p.out; ga.o1 = hb; ga.resid = resid_src;
        gemm_phase<M_RESID, 1024>(ga, smem);
      }
      xcd_barrier(xb);
    } else if (mixer == 1) {
      pool_phase(p, gs);
      xcd_barrier(xb);
      {
        GemmArgs ga{};
      ga.ssq = (float*)(ws + OFF_SSQ);
        ga.ssq = (float*)(ws + OFF_SSQ);
        ga.A = (const bf16_t*)(ws + R_POOL); ga.lda = 1024; ga.Bt = (const bf16_t*)(ws + OFF_BW); ga.K = 256; ga.NT = 4;
        ga.o0 = p.out; ga.o1 = hb; ga.resid = resid_src; ga.g0 = p.b_scale;
        gemm_phase<M_POOL, 256>(ga, smem);
      }
      xcd_barrier(xb);
    } else {
      {
        GemmArgs ga{};
      ga.ssq = (float*)(ws + OFF_SSQ);
        ga.ssq = (float*)(ws + OFF_SSQ);
        ga.A = hb; ga.lda = 1024; ga.Bt = (const bf16_t*)(ws + OFF_CIN); ga.K = 1024; ga.NT = 9;
        ga.o0 = ws + R_CQ; ga.o1 = ws + R_CK; ga.o2 = ws + R_CVT; ga.o3 = ws + R_CIQ; ga.o4 = ws + R_CIK; ga.o5 = ws + R_CIW;
        ga.g0 = p.c_q_g; ga.g1 = p.c_k_g;
        for (int rep = 0; rep <= DUP_GEMM; rep++) gemm_phase<M_CIN, 1024>(ga, smem);
      }
      xcd_barrier(xb);
      for (int rep = 0; rep <= DUP_IDX; rep++) index_phase(p, gs, gctr, gtarget);
      xcd_barrier(xb);
      if (grp_id() == 1) __builtin_amdgcn_s_setprio(1);
      for (int rep = 0; rep <= DUP_ATTNC; rep++) attnC_phase(p, gs, gctr, gtarget);
      __builtin_amdgcn_s_setprio(0);
      xcd_barrier(xb);
      {
        GemmArgs ga{};
      ga.ssq = (float*)(ws + OFF_SSQ);
        ga.ssq = (float*)(ws + OFF_SSQ);
        ga.A = (const bf16_t*)(ws + R_AO); ga.lda = 1024; ga.Bt = (const bf16_t*)(ws + OFF_COUT); ga.K = 1024; ga.NT = 4;
        ga.o0 = p.out; ga.o1 = hb; ga.resid = resid_src;
        gemm_phase<M_RESID, 1024>(ga, smem);
      }
      xcd_barrier(xb);
    }
    {
      GemmArgs ga{};
      ga.ssq = (float*)(ws + OFF_SSQ);
      ga.A = hb; ga.lda = 1024; ga.Bt = (const bf16_t*)(ws + OFF_W1 + (size_t)layer * 8 * MB); ga.K = 1024; ga.NT = 16;
      ga.o0 = ws + R_HID;
      for (int rep = 0; rep <= DUP_GEMM; rep++) gemm_phase<M_MLP1, 1024>(ga, smem);
    }
    xcd_barrier(xb);
    {
      GemmArgs ga{};
      ga.ssq = (float*)(ws + OFF_SSQ);
      ga.A = (const bf16_t*)(ws + R_HID); ga.lda = 4096; ga.Bt = (const bf16_t*)(ws + OFF_W2 + (size_t)layer * 8 * MB); ga.K = 4096; ga.NT = 4;
      ga.o0 = p.out; ga.o1 = hb; ga.resid = p.out;
      gemm_phase<M_RESID, 4096>(ga, smem);
    }
    if (layer < 3) xcd_barrier(xb);
  }
}

extern "C" void kernel_launch(void* const* d_in, const int* in_sizes, int n_in, void* d_out, int out_size,
                              void* d_ws, size_t ws_size, hipStream_t stream) {
  static int grid_blocks = 0;
  if (!grid_blocks) {
    int dev = 0, cus = 0, per_cu = 0;
    hipGetDevice(&dev);
    hipDeviceGetAttribute(&cus, hipDeviceAttributeMultiprocessorCount, dev);
    hipOccupancyMaxActiveBlocksPerMultiprocessor(&per_cu, fwd_megakernel, 512, 0);
    if (per_cu > 1) per_cu = 1;
    if (per_cu < 1) per_cu = 1;
    grid_blocks = cus * per_cu;
  }
  if (ws_size < WS_NEED) { fprintf(stderr, "workspace too small: %zu < %zu\n", ws_size, (size_t)WS_NEED); return; }
  Params p{};
  p.x = (const float*)d_in[0]; p.norm1_g = (const float*)d_in[1]; p.norm2_g = (const float*)d_in[2];
  p.a_w_in = (const float*)d_in[3]; p.a_q_g = (const float*)d_in[4]; p.a_k_g = (const float*)d_in[5];
  p.a_lq1 = (const float*)d_in[6]; p.a_lk1 = (const float*)d_in[7]; p.a_lq2 = (const float*)d_in[8]; p.a_lk2 = (const float*)d_in[9];
  p.a_sub_g = (const float*)d_in[10]; p.a_w_out = (const float*)d_in[11];
  p.b_w = (const float*)d_in[12]; p.b_scale = (const float*)d_in[13];
  p.c_w_in = (const float*)d_in[14]; p.c_q_g = (const float*)d_in[15]; p.c_k_g = (const float*)d_in[16]; p.c_w_out = (const float*)d_in[17];
  p.w1 = (const float*)d_in[18]; p.w2 = (const float*)d_in[19];
  p.out = (float*)d_out; p.ws = (char*)d_ws;
  hipMemsetAsync((char*)d_ws + OFF_BAR, 0, XCD_BAR_WORDS * sizeof(unsigned), stream);
  void* args[] = {&p};
  hipError_t e = hipLaunchCooperativeKernel((void*)fwd_megakernel, dim3(grid_blocks), dim3(512), args, 0, stream);
  if (e != hipSuccess) fprintf(stderr, "cooperative launch failed: %s (grid %d)\n", hipGetErrorString(e), grid_blocks);
}
```

```cpp
#include <hip/hip_runtime.h>
#include <hip/hip_cooperative_groups.h>
#include <cstdio>
namespace cg = cooperative_groups;

typedef unsigned short bf16_t;
typedef __attribute__((ext_vector_type(8))) short bf16x8;
typedef __attribute__((ext_vector_type(16))) float f32x16;
typedef unsigned long long u64;
typedef unsigned __attribute__((ext_vector_type(4))) u32x4;
typedef unsigned __attribute__((ext_vector_type(2))) u32x2;
typedef float __attribute__((ext_vector_type(4))) f32x4;

#define DEVI __device__ __forceinline__
#define DUP_GEMM 0
#define DUP_ATTNA 0
#define DUP_IDX 0
#define DUP_ATTNC 0
#define DUP_CONV 0

constexpr int T_TOK = 16384;
constexpr int DM = 1024;
constexpr int SEQ = 4096;
constexpr float EPS = 1e-6f;
constexpr float LOG2E = 1.4426950408889634f;
constexpr size_t MB = 1ull << 20;

constexpr size_t OFF_W1 = 0;
constexpr size_t OFF_W2 = 32 * MB;
constexpr size_t OFF_AIN = 64 * MB;
constexpr size_t OFF_AOUT = 76 * MB;
constexpr size_t OFF_BW = 80 * MB;
constexpr size_t OFF_CIN = 81 * MB;
constexpr size_t OFF_COUT = 86 * MB;
constexpr size_t OFF_HB = 88 * MB;
constexpr size_t OFF_R = 120 * MB;
constexpr size_t OFF_SSQ = 249 * MB;
constexpr size_t WS_NEED = 251 * MB;
constexpr size_t R_QK = OFF_R;
constexpr size_t R_VT = OFF_R + 64 * MB;
constexpr size_t R_AO = OFF_R + 96 * MB;
constexpr size_t R_HID = OFF_R;
constexpr size_t R_POOL = OFF_R;
constexpr size_t R_CQ = OFF_R;
constexpr size_t R_CK = OFF_R + 32 * MB;
constexpr size_t R_CVT = OFF_R + 40 * MB;
constexpr size_t R_CIQ = OFF_R + 48 * MB;
constexpr size_t R_CIK = OFF_R + 64 * MB;
constexpr size_t R_CIW = OFF_R + 66 * MB;
constexpr size_t R_MASK = OFF_R + 67 * MB;

struct Params {
  const float* x; const float* norm1_g; const float* norm2_g;
  const float* a_w_in; const float* a_q_g; const float* a_k_g;
  const float* a_lq1; const float* a_lk1; const float* a_lq2; const float* a_lk2;
  const float* a_sub_g; const float* a_w_out;
  const float* b_w; const float* b_scale;
  const float* c_w_in; const float* c_q_g; const float* c_k_g; const float* c_w_out;
  const float* w1; const float* w2;
  float* out; char* ws;
};

DEVI bf16_t f2bf(float f) {
  return __builtin_bit_cast(bf16_t, (__bf16)f);
}
typedef __bf16 bf16x2_t __attribute__((ext_vector_type(2)));
DEVI unsigned pack2(float a, float b) {
  bf16x2_t v;
  v.x = (__bf16)a; v.y = (__bf16)b;
  return __builtin_bit_cast(unsigned, v);
}
DEVI float bf_lo(unsigned p) { return __uint_as_float(p << 16); }
DEVI float bf_hi(unsigned p) { return __uint_as_float(p & 0xffff0000u); }
DEVI float fexp2(float x) { return __builtin_amdgcn_exp2f(x); }

template <int ROWB>
DEVI int lds_off(int row, int chunk) {
  if (ROWB == 128) return row * 128 + ((chunk ^ ((row >> 1) & 7)) << 4);
  else return row * 256 + ((chunk ^ (row & 15)) << 4);
}

DEVI f32x16 mfma32(bf16x8 a, bf16x8 b, f32x16 c) {
  return __builtin_amdgcn_mfma_f32_32x32x16_bf16(a, b, c, 0, 0, 0);
}

constexpr int SMEM_BYTES = 131072 + 1024 + 4096;

DEVI int otid() { int t = threadIdx.x & 255; asm volatile("" : "+v"(t)); return t; }
DEVI int otid512() { int t = threadIdx.x; asm volatile("" : "+v"(t)); return t; }
DEVI int grp_id() { return __builtin_amdgcn_readfirstlane((int)(threadIdx.x >> 8)); }
DEVI int vblk() { return (int)blockIdx.x * 2 + grp_id(); }
DEVI int nvblk() { return (int)gridDim.x * 2; }

struct Job { const float* src; bf16_t* dst; const float* gain; int K, N, NP; };

DEVI Job get_job(const Params& p, int j) {
  Job jb;
  char* ws = p.ws;
  if (j < 4) {
    jb.src = p.w1 + (size_t)j * 1024 * 4096; jb.dst = (bf16_t*)(ws + OFF_W1 + (size_t)j * 8 * MB);
    jb.gain = p.norm2_g + j * 1024; jb.K = 1024; jb.N = 4096; jb.NP = 4096;
  } else if (j < 8) {
    int i = j - 4;
    jb.src = p.w2 + (size_t)i * 1024 * 4096; jb.dst = (bf16_t*)(ws + OFF_W2 + (size_t)i * 8 * MB);
    jb.gain = nullptr; jb.K = 4096; jb.N = 1024; jb.NP = 1024;
  } else if (j < 10) {
    int i = j - 8;
    jb.src = p.a_w_in + (size_t)i * 1024 * 3072; jb.dst = (bf16_t*)(ws + OFF_AIN + (size_t)i * 6 * MB);
    jb.gain = p.norm1_g + (i == 0 ? 0 : 3) * 1024; jb.K = 1024; jb.N = 3072; jb.NP = 3072;
  } else if (j < 12) {
    int i = j - 10;
    jb.src = p.a_w_out + (size_t)i * 1024 * 1024; jb.dst = (bf16_t*)(ws + OFF_AOUT + (size_t)i * 2 * MB);
    jb.gain = nullptr; jb.K = 1024; jb.N = 1024; jb.NP = 1024;
  } else if (j < 16) {
    int g = j - 12;
    jb.src = p.b_w + (size_t)g * 65536; jb.dst = (bf16_t*)(ws + OFF_BW) + (size_t)g * 65536;
    jb.gain = p.norm1_g + 1024 + g * 256; jb.K = 256; jb.N = 256; jb.NP = 256;
  } else if (j == 16) {
    jb.src = p.c_w_in; jb.dst = (bf16_t*)(ws + OFF_CIN);
    jb.gain = p.norm1_g + 2 * 1024; jb.K = 1024; jb.N = 2120; jb.NP = 2304;
  } else {
    jb.src = p.c_w_out; jb.dst = (bf16_t*)(ws + OFF_COUT);
    jb.gain = nullptr; jb.K = 1024; jb.N = 1024; jb.NP = 1024;
  }
  return jb;
}
constexpr int NJOBS = 18;

DEVI void convert_phase(const Params& p, char* smem) {
  const int tid = otid();
  float* t = (float*)smem;
  int total = 0;
  for (int j = 0; j < NJOBS; j++) { Job jb = get_job(p, j); total += (jb.K / 64) * (jb.NP / 64); }
  const int vb = vblk(), nvb = nvblk();
  Job jb; int k0 = 0, n0 = 0; bool act;
  f32x4 vc[4], vn[4];
#define CV_LOCATE(TILE, JB, K0, N0, ACT)                                                 \
  { ACT = (TILE) < total;                                              \
    int rem = ACT ? (TILE) : 0, j = 0;                                                   \
    JB = get_job(p, 0);                                                                  \
    for (;;) { int nt = (JB.K / 64) * (JB.NP / 64); if (rem < nt) break; rem -= nt; j++; JB = get_job(p, j); } \
    const int ntn = JB.NP / 64;                                                          \
    K0 = (rem / ntn) * 64; N0 = (rem % ntn) * 64; }
#define CV_LOAD(V, JB, K0, N0, ACT)                                                      \
  _Pragma("unroll") for (int i = 0; i < 4; i++) {                                        \
    const int kk = (tid >> 4) + 16 * i, n = (N0) + (tid & 15) * 4;                       \
    V[i] = f32x4{0.f, 0.f, 0.f, 0.f};                                                    \
    if ((ACT) && n < JB.N) V[i] = *(const f32x4*)(JB.src + (size_t)((K0) + kk) * JB.N + n); }
  CV_LOCATE(vb, jb, k0, n0, act)
  CV_LOAD(vc, jb, k0, n0, act)
  for (int base = 0; base < total; base += nvb) {
    if (act) {
#pragma unroll
      for (int i = 0; i < 4; i++) {
        const int kk = (tid >> 4) + 16 * i, nn = (tid & 15) * 4;
        t[kk * 65 + nn + 0] = vc[i].x; t[kk * 65 + nn + 1] = vc[i].y; t[kk * 65 + nn + 2] = vc[i].z; t[kk * 65 + nn + 3] = vc[i].w;
      }
    }
    Job jbn; int k0n = 0, n0n = 0; bool actn;
    CV_LOCATE(base + nvb + vb, jbn, k0n, n0n, actn)
    CV_LOAD(vn, jbn, k0n, n0n, actn)
    __syncthreads();
    if (act) {
      const int nl = tid >> 2, kq = tid & 3;
      unsigned pk[8];
#pragma unroll
      for (int i = 0; i < 8; i++) {
        int k = kq * 16 + 2 * i;
        float a = t[k * 65 + nl], b = t[(k + 1) * 65 + nl];
        if (jb.gain) { a *= jb.gain[k0 + k]; b *= jb.gain[k0 + k + 1]; }
        pk[i] = pack2(a, b);
      }
      u32x4* d = (u32x4*)(jb.dst + (size_t)(n0 + nl) * jb.K + k0 + kq * 16);
      d[0] = u32x4{pk[0], pk[1], pk[2], pk[3]};
      d[1] = u32x4{pk[4], pk[5], pk[6], pk[7]};
    }
    __syncthreads();
    jb = jbn; k0 = k0n; n0 = n0n; act = actn;
#pragma unroll
    for (int i = 0; i < 4; i++) vc[i] = vn[i];
  }
#undef CV_LOCATE
#undef CV_LOAD
  bf16_t* hb = (bf16_t*)(p.ws + OFF_HB);
  float* ssqp = (float*)(p.ws + OFF_SSQ);
  {
    const int lane = tid & 63, wv = tid >> 6;
    for (int row = vb * 4 + wv; row < T_TOK; row += nvb * 4) {
      const float* xr = p.x + (size_t)row * DM;
      float ssum = 0.f;
#pragma unroll
      for (int i = 0; i < 2; i++) {
        const int c = i * 512 + lane * 8;
        f32x4 a = *(const f32x4*)(xr + c), b = *(const f32x4*)(xr + c + 4);
        ssum += a.x * a.x + a.y * a.y + a.z * a.z + a.w * a.w + b.x * b.x + b.y * b.y + b.z * b.z + b.w * b.w;
        *(u32x4*)(hb + (size_t)row * DM + c) = u32x4{pack2(a.x, a.y), pack2(a.z, a.w), pack2(b.x, b.y), pack2(b.z, b.w)};
      }
#pragma unroll
      for (int o = 32; o >= 1; o >>= 1) ssum += __shfl_xor(ssum, o);
      if (lane < 16) ssqp[(size_t)row * 16 + lane] = (lane == 0) ? ssum : 0.f;
    }
  }
}

DEVI void wave_put_bf16(char* wbuf, const int ml, const int nt, const int q4, const int lh, const u32x2 v) {
  const int chunk = nt * 4 + q4;
  *(u32x2*)(wbuf + ml * 128 + ((chunk ^ (ml & 7)) << 4) + 8 * lh) = v;
}
DEVI void wave_flush_bf16(char* wbuf, bf16_t* dst, const int stride, const int lane) {
  const int c = lane & 7;
#pragma unroll
  for (int i = 0; i < 8; i++) {
    const int row = i * 8 + (lane >> 3);
    const u32x4 v = *(const u32x4*)(wbuf + row * 128 + ((c ^ (row & 7)) << 4));
    *(u32x4*)(dst + (size_t)row * stride + c * 8) = v;
  }
}

enum { M_AQKV = 0, M_CIN = 1, M_RESID = 2, M_MLP1 = 3, M_POOL = 4 };

struct GemmArgs {
  const bf16_t* A; int lda; const bf16_t* Bt; int K; int NT;
  void* o0; void* o1; void* o2; void* o3; void* o4; void* o5;
  const float* g0; const float* g1; const float* resid; float* ssq;
};

template <int MODE, int KC>
DEVI void gemm_phase(const GemmArgs& ga, char* smem) {
  constexpr bool NORM = (MODE == M_AQKV || MODE == M_CIN || MODE == M_MLP1);
  const int tid = otid512(), lane = tid & 63, w = tid >> 6;
  const int wn = w & 3, wm = w >> 2;
  const int l31 = lane & 31, lh = lane >> 5;
  float* rs_lds = (float*)(smem + 131072);
  float* xch = (float*)(smem + 131072 + 1024);
  constexpr int K = KC;
  constexpr int KT = K / 64;
  const int NT256 = ga.NT;
  const int ntiles = (T_TOK / 256) * NT256;
  for (int tile = blockIdx.x; tile < ntiles; tile += gridDim.x) {
    const int tn256 = tile % NT256, tm = tile / NT256;
    const int m0 = tm * 256;
    const bf16_t* Ab = ga.A + (size_t)m0 * ga.lda + (MODE == M_POOL ? tn256 * 256 : 0);
    const bf16_t* Bb = ga.Bt + (size_t)tn256 * 256 * K;
    f32x16 acc[2][4];
#pragma unroll
    for (int a = 0; a < 2; a++)
#pragma unroll
      for (int b = 0; b < 4; b++)
#pragma unroll
        for (int r = 0; r < 16; r++) acc[a][b][r] = 0.f;
    u32x4 rw0[4], rx0[4];
    int ttid = tid;
    asm volatile("" : "+v"(ttid));
    const int ldsb = lds_off<128>(ttid >> 3, ttid & 7);
    const unsigned woff0 = (unsigned)((ttid >> 3) * K + (ttid & 7) * 8) * 2u;
    const unsigned xoff0 = (unsigned)((ttid >> 3) * ga.lda + (ttid & 7) * 8) * 2u;
#define G_LOAD(RW, RX, KTI)                                                              \
  _Pragma("unroll") for (int j = 0; j < 4; j++) {                                        \
    RW[j] = *(const u32x4*)((const char*)Bb + (size_t)(KTI) * 128 + (size_t)j * 64 * K * 2 + woff0);            \
    RX[j] = *(const u32x4*)((const char*)Ab + (size_t)(KTI) * 128 + (size_t)j * 64 * ga.lda * 2 + xoff0);      \
  }
#define G_STORE(RW, RX, S)                                                               \
  _Pragma("unroll") for (int j = 0; j < 4; j++) {                                        \
    *(u32x4*)(smem + (S) * 32768 + ldsb + j * 8192) = RW[j];            \
    *(u32x4*)(smem + 65536 + (S) * 32768 + ldsb + j * 8192) = RX[j];                     \
  }
#define G_COMPUTE_KS(S, KS0, KS1)                                                        \
  _Pragma("unroll") for (int ks = KS0; ks < KS1; ks++) {                                 \
    bf16x8 wf[2], xf[4];                                                                 \
    _Pragma("unroll") for (int nt = 0; nt < 2; nt++)                                     \
      wf[nt] = *(const bf16x8*)(smem + (S) * 32768 + lds_off<128>(wn * 64 + nt * 32 + l31, 2 * ks + lh)); \
    _Pragma("unroll") for (int mt = 0; mt < 4; mt++)                                     \
      xf[mt] = *(const bf16x8*)(smem + 65536 + (S) * 32768 + lds_off<128>(wm * 128 + mt * 32 + l31, 2 * ks + lh)); \
    _Pragma("unroll") for (int nt = 0; nt < 2; nt++)                                     \
      _Pragma("unroll") for (int mt = 0; mt < 4; mt++) acc[nt][mt] = mfma32(wf[nt], xf[mt], acc[nt][mt]); \
  }
    G_LOAD(rw0, rx0, 0)
    G_STORE(rw0, rx0, 0)
    __syncthreads();
    if (NORM) {
      if (tid < 256) {
        const f32x4* sp = (const f32x4*)(ga.ssq + (size_t)(m0 + tid) * 16);
        const f32x4 a = sp[0], b = sp[1], c = sp[2], d = sp[3];
        const float tot = (a.x + a.y + a.z + a.w) + (b.x + b.y + b.z + b.w) + (c.x + c.y + c.z + c.w) + (d.x + d.y + d.z + d.w);
        rs_lds[tid] = rsqrtf(tot * (1.f / 1024.f) + EPS);
      }
    }
#pragma unroll 1
    for (int kt = 0; kt < KT; kt += 2) {
      const bool more = (kt + 2 < KT);
      G_LOAD(rw0, rx0, kt + 1)
      asm volatile("" ::: "memory");
      G_COMPUTE_KS(0, 0, 2)
      G_STORE(rw0, rx0, 1)
      G_COMPUTE_KS(0, 2, 4)
      __syncthreads();
      if (more) { G_LOAD(rw0, rx0, kt + 2) }
      asm volatile("" ::: "memory");
      G_COMPUTE_KS(1, 0, 2)
      if (more) { G_STORE(rw0, rx0, 0) }
      G_COMPUTE_KS(1, 2, 4)
      __syncthreads();
    }
#undef G_LOAD
#undef G_STORE
#undef G_COMPUTE_KS
    float rstd[4] = {1.f, 1.f, 1.f, 1.f};
    if (NORM) {
#pragma unroll
      for (int mt = 0; mt < 4; mt++) rstd[mt] = rs_lds[wm * 128 + mt * 32 + l31];
    }
    int el31 = l31, elh = lh, ewn = wn & 1, ewm = wm, elane = lane, ewq = wn >> 1, eww = w;
    asm volatile("" : "+v"(el31), "+v"(elh), "+v"(ewn), "+v"(ewm), "+v"(elane), "+v"(ewq), "+v"(eww));
    const int tn = tn256 * 2 + __builtin_amdgcn_readfirstlane(ewq);
    const int n0 = tn * 128;
    char* wbuf = smem + eww * 16384;
    const int mw0 = m0 + ewm * 128;
    if (MODE == M_AQKV) {
      const int nw = n0 + ewn * 64;
      if (n0 < 2048) {
        const float* g = (n0 < 1024) ? ga.g0 : ga.g1;
        const float post = (n0 < 1024) ? (0.125f * LOG2E) : 1.f;
#pragma unroll
        for (int h = 0; h < 2; h++) {
#pragma unroll
          for (int mh = 0; mh < 2; mh++) {
            const int mt = 2 * h + mh;
            float s = 0.f;
#pragma unroll
            for (int nt = 0; nt < 2; nt++)
#pragma unroll
              for (int r = 0; r < 16; r++) { float v = acc[nt][mt][r] * rstd[mt]; acc[nt][mt][r] = v; s += v * v; }
            s += __shfl_xor(s, 32);
            const float hn = rsqrtf(s * (1.f / 64.f) + EPS) * post;
#pragma unroll
            for (int nt = 0; nt < 2; nt++)
#pragma unroll
              for (int q4 = 0; q4 < 4; q4++) {
                const int d = nt * 32 + 8 * q4 + 4 * elh;
                const f32x4 gv = *(const f32x4*)(g + d);
                { u32x2 pv; pv.x = pack2(acc[nt][mt][4 * q4 + 0] * hn * gv.x, acc[nt][mt][4 * q4 + 1] * hn * gv.y); pv.y = pack2(acc[nt][mt][4 * q4 + 2] * hn * gv.z, acc[nt][mt][4 * q4 + 3] * hn * gv.w); wave_put_bf16(wbuf, mh * 32 + el31, nt, q4, elh, pv); }
              }
          }
          wave_flush_bf16(wbuf, (bf16_t*)ga.o0 + (size_t)(mw0 + h * 64) * 2048 + nw, 2048, elane);
        }
      } else {
        bf16_t* vt = (bf16_t*)ga.o1;
        const int nn = nw - 2048, head = nn >> 7, e0 = nn & 127;
#pragma unroll
        for (int mt = 0; mt < 4; mt++) {
          const int m = mw0 + mt * 32 + el31;
          const int b = m >> 12, s = m & 4095;
          bf16_t* vp = vt + ((size_t)(b * 8 + head) * 128 + e0 + 4 * elh) * 4096 + s;
          asm volatile("" : "+v"(vp));
#pragma unroll
          for (int nt = 0; nt < 2; nt++)
#pragma unroll
            for (int r = 0; r < 16; r++)
              vp[(size_t)(nt * 32 + (r & 3) + 8 * (r >> 2)) * 4096] = f2bf(acc[nt][mt][r] * rstd[mt]);
        }
      }
    } else if (MODE == M_CIN) {
      if (tn < 10) {
#pragma unroll
        for (int mt = 0; mt < 4; mt++) {
          float s = 0.f;
#pragma unroll
          for (int nt = 0; nt < 2; nt++)
#pragma unroll
            for (int r = 0; r < 16; r++) { float v = acc[nt][mt][r] * rstd[mt]; acc[nt][mt][r] = v; s += v * v; }
          s += __shfl_xor(s, 32);
          if (elh == 0) xch[(ewq * 2 + ewn) * 256 + ewm * 128 + mt * 32 + el31] = s;
        }
        __syncthreads();
        const float* g = (tn < 8) ? ga.g0 : ga.g1;
        const float post = (tn < 8) ? (0.08838834764831845f * LOG2E) : 1.f;
#pragma unroll
        for (int h = 0; h < 2; h++) {
#pragma unroll
          for (int mh = 0; mh < 2; mh++) {
            const int mt = 2 * h + mh;
            const int ml = ewm * 128 + mt * 32 + el31;
            const float tot = xch[(ewq * 2) * 256 + ml] + xch[(ewq * 2 + 1) * 256 + ml];
            const float hn = rsqrtf(tot * (1.f / 128.f) + EPS) * post;
#pragma unroll
            for (int nt = 0; nt < 2; nt++)
#pragma unroll
              for (int q4 = 0; q4 < 4; q4++) {
                const int d = ewn * 64 + nt * 32 + 8 * q4 + 4 * elh;
                const f32x4 gv = *(const f32x4*)(g + d);
                { u32x2 pv; pv.x = pack2(acc[nt][mt][4 * q4 + 0] * hn * gv.x, acc[nt][mt][4 * q4 + 1] * hn * gv.y); pv.y = pack2(acc[nt][mt][4 * q4 + 2] * hn * gv.z, acc[nt][mt][4 * q4 + 3] * hn * gv.w); wave_put_bf16(wbuf, mh * 32 + el31, nt, q4, elh, pv); }
              }
          }
          if (tn < 8) wave_flush_bf16(wbuf, (bf16_t*)ga.o0 + (size_t)(mw0 + h * 64) * 1024 + tn * 128 + ewn * 64, 1024, elane);
          else wave_flush_bf16(wbuf, (bf16_t*)ga.o1 + (size_t)(mw0 + h * 64) * 256 + (tn - 8) * 128 + ewn * 64, 256, elane);
        }
      } else if (tn < 12) {
        bf16_t* vt = (bf16_t*)ga.o2;
        const int g = tn - 10;
#pragma unroll
        for (int mt = 0; mt < 4; mt++) {
          const int m = mw0 + mt * 32 + el31;
          const int b = m >> 12, s = m & 4095;
          bf16_t* vp = vt + ((size_t)(b * 2 + g) * 128 + ewn * 64 + 4 * elh) * 4096 + s;
          asm volatile("" : "+v"(vp));
#pragma unroll
          for (int nt = 0; nt < 2; nt++)
#pragma unroll
            for (int r = 0; r < 16; r++)
              vp[(size_t)(nt * 32 + (r & 3) + 8 * (r >> 2)) * 4096] = f2bf(acc[nt][mt][r] * rstd[mt]);
        }
      } else {
        if (tn < 16 || (tn == 16 && ewn == 0)) {
#pragma unroll
          for (int h = 0; h < 2; h++) {
  #pragma unroll
            for (int mh = 0; mh < 2; mh++) {
              const int mt = 2 * h + mh;
#pragma unroll
              for (int nt = 0; nt < 2; nt++)
#pragma unroll
                for (int q4 = 0; q4 < 4; q4++) {
                  { u32x2 pv; pv.x = pack2(acc[nt][mt][4 * q4 + 0] * rstd[mt], acc[nt][mt][4 * q4 + 1] * rstd[mt]); pv.y = pack2(acc[nt][mt][4 * q4 + 2] * rstd[mt], acc[nt][mt][4 * q4 + 3] * rstd[mt]); wave_put_bf16(wbuf, mh * 32 + el31, nt, q4, elh, pv); }
                }
            }
            if (tn < 16) wave_flush_bf16(wbuf, (bf16_t*)ga.o3 + (size_t)(mw0 + h * 64) * 512 + (tn - 12) * 128 + ewn * 64, 512, elane);
            else wave_flush_bf16(wbuf, (bf16_t*)ga.o4 + (size_t)(mw0 + h * 64) * 64, 64, elane);
          }
        } else if (tn == 16) {
          float* iw = (float*)ga.o5;
          const float sc = 0.35355339059327373f * 0.125f;
#pragma unroll
          for (int mt = 0; mt < 4; mt++) {
            const int m = mw0 + mt * 32 + el31;
            f32x4 o;
            o.x = acc[0][mt][0] * rstd[mt] * sc; o.y = acc[0][mt][1] * rstd[mt] * sc;
            o.z = acc[0][mt][2] * rstd[mt] * sc; o.w = acc[0][mt][3] * rstd[mt] * sc;
            *(f32x4*)(iw + (size_t)m * 8 + 4 * elh) = o;
          }
        }
      }
    } else if (MODE == M_RESID || MODE == M_POOL) {
      float* ho = (float*)ga.o0;
      bf16_t* hb = (bf16_t*)ga.o1;
      const int cch = elane & 15;
      const int n = n0 + ewn * 64 + cch * 4;
      f32x4 cs = f32x4{1.f, 1.f, 1.f, 1.f};
      if (MODE == M_POOL) cs = *(const f32x4*)(ga.g0 + n);
#pragma unroll
      for (int h = 0; h < 2; h++) {
#pragma unroll
        for (int mh = 0; mh < 2; mh++) {
          const int mt = 2 * h + mh;
          const int ml = mh * 32 + el31;
#pragma unroll
          for (int nt = 0; nt < 2; nt++)
#pragma unroll
            for (int q4 = 0; q4 < 4; q4++) {
              const int chunk = nt * 8 + 2 * q4 + elh;
              f32x4 v; v.x = acc[nt][mt][4 * q4 + 0]; v.y = acc[nt][mt][4 * q4 + 1]; v.z = acc[nt][mt][4 * q4 + 2]; v.w = acc[nt][mt][4 * q4 + 3];
              *(f32x4*)(wbuf + ml * 256 + ((chunk ^ (ml & 15)) << 4)) = v;
            }
        }
#pragma unroll 4
        for (int i = 0; i < 16; i++) {
          const int row = i * 4 + (elane >> 4);
          const int m = mw0 + h * 64 + row;
          const f32x4 a = *(const f32x4*)(wbuf + row * 256 + ((cch ^ (row & 15)) << 4));
          const f32x4 rv = *(const f32x4*)(ga.resid + (size_t)m * 1024 + n);
          f32x4 o;
          o.x = rv.x + a.x * cs.x; o.y = rv.y + a.y * cs.y; o.z = rv.z + a.z * cs.z; o.w = rv.w + a.w * cs.w;
          *(f32x4*)(ho + (size_t)m * 1024 + n) = o;
          u32x2 ob; ob.x = pack2(o.x, o.y); ob.y = pack2(o.z, o.w);
          *(u32x2*)(hb + (size_t)m * 1024 + n) = ob;
          float sq = o.x * o.x + o.y * o.y + o.z * o.z + o.w * o.w;
          sq += __shfl_xor(sq, 1); sq += __shfl_xor(sq, 2); sq += __shfl_xor(sq, 4); sq += __shfl_xor(sq, 8);
          if (cch == 0) ga.ssq[(size_t)m * 16 + tn * 2 + ewn] = sq;
        }
      }
    } else if (MODE == M_MLP1) {
#pragma unroll
      for (int h = 0; h < 2; h++) {
#pragma unroll
        for (int mh = 0; mh < 2; mh++) {
          const int mt = 2 * h + mh;
#pragma unroll
          for (int nt = 0; nt < 2; nt++)
#pragma unroll
            for (int q4 = 0; q4 < 4; q4++) {
              const float v0 = fmaxf(acc[nt][mt][4 * q4 + 0] * rstd[mt], 0.f), v1 = fmaxf(acc[nt][mt][4 * q4 + 1] * rstd[mt], 0.f);
              const float v2 = fmaxf(acc[nt][mt][4 * q4 + 2] * rstd[mt], 0.f), v3 = fmaxf(acc[nt][mt][4 * q4 + 3] * rstd[mt], 0.f);
              { u32x2 pv; pv.x = pack2(v0 * v0, v1 * v1); pv.y = pack2(v2 * v2, v3 * v3); wave_put_bf16(wbuf, mh * 32 + el31, nt, q4, elh, pv); }
            }
        }
        wave_flush_bf16(wbuf, (bf16_t*)ga.o0 + (size_t)(mw0 + h * 64) * 4096 + n0 + ewn * 64, 4096, elane);
      }
    }
    __syncthreads();
  }
}

DEVI void grp_barrier(volatile __attribute__((address_space(3))) unsigned* ctr, unsigned& target, const int lane) {
  asm volatile("s_waitcnt vmcnt(0) lgkmcnt(0)" ::: "memory");
  target += 4u;
  if (lane == 0) __hip_atomic_fetch_add((__attribute__((address_space(3))) unsigned*)ctr, 1u, __ATOMIC_RELAXED, __HIP_MEMORY_SCOPE_WORKGROUP);
  while (__hip_atomic_load((__attribute__((address_space(3))) unsigned*)ctr, __ATOMIC_RELAXED, __HIP_MEMORY_SCOPE_WORKGROUP) < target) __builtin_amdgcn_s_sleep(1);
  asm volatile("" ::: "memory");
}

template <int DQK, bool MASKED>
DEVI void flash_qtile(const bf16_t* __restrict__ qrow, const bf16_t* __restrict__ Kb, const int kstride,
                      const bf16_t* __restrict__ Vt, const u64* __restrict__ mrow, const int qt,
                      char* smem, f32x16 (&O)[4], const float negc0,
                      volatile __attribute__((address_space(3))) unsigned* gctr, unsigned& gtarget) {
  constexpr int KROWB = DQK * 2;
  constexpr int KS = DQK / 16;
  constexpr int KBYTES = 64 * KROWB;
  constexpr int STAGE = KBYTES + 16384;
  constexpr int KI = KBYTES / 4096;
  const int tid = otid(), lane = tid & 63, w = tid >> 6;
  const int l31 = lane & 31, lh = lane >> 5;
  unsigned kgo[KI], vgo[4];
#pragma unroll
  for (int i = 0; i < KI; i++) {
    const int blk = i * 4 + w;
    int row, kc;
    if (DQK == 64) { row = blk * 8 + (lane >> 3); kc = (lane & 7) ^ ((row >> 1) & 7); }
    else { row = blk * 4 + (lane >> 4); kc = (lane & 15) ^ (row & 15); }
    kgo[i] = (unsigned)(row * kstride + kc * 8) * 2u;
  }
#pragma unroll
  for (int i = 0; i < 4; i++) {
    const int blk = i * 4 + w;
    const int row = blk * 8 + (lane >> 3);
    const int kc = (lane & 7) ^ ((row >> 1) & 7);
    vgo[i] = (unsigned)(row * 4096 + kc * 8) * 2u;
  }
  bf16x8 qf[KS];
#pragma unroll
  for (int ks = 0; ks < KS; ks++) qf[ks] = *(const bf16x8*)(qrow + 16 * ks + 8 * lh);
#pragma unroll
  for (int eb = 0; eb < 4; eb++)
#pragma unroll
    for (int r = 0; r < 16; r++) O[eb][r] = 0.f;
  float lsum = 0.f;
  const int ntile = 2 * qt + 2;
  const int mylast = 2 * qt + (w >> 1);
  u64 mw_next = 0ull;
  if (MASKED) mw_next = mrow[0];
  grp_barrier(gctr, gtarget, lane);
  {
    const char* kt = (const char*)Kb;
    const char* vtp = (const char*)Vt;
#pragma unroll
    for (int i = 0; i < KI; i++)
      __builtin_amdgcn_global_load_lds((const unsigned*)(kt + kgo[i]), (__attribute__((address_space(3))) unsigned*)(smem + (i * 4 + w) * 1024), 16, 0, 0);
#pragma unroll
    for (int i = 0; i < 4; i++)
      __builtin_amdgcn_global_load_lds((const unsigned*)(vtp + vgo[i]), (__attribute__((address_space(3))) unsigned*)(smem + KBYTES + (i * 4 + w) * 1024), 16, 0, 0);
  }
  grp_barrier(gctr, gtarget, lane);
  for (int j = 0; j < ntile; j++) {
    const char* st = smem + (j & 1) * STAGE;
    const bool more = (j + 1 < ntile);
    if (more) {
      const char* kt = (const char*)Kb + (size_t)(j + 1) * 64 * kstride * 2;
      const char* vtp = (const char*)Vt + (size_t)(j + 1) * 64 * 2;
      char* sn = smem + ((j + 1) & 1) * STAGE;
#pragma unroll
      for (int i = 0; i < KI; i++) {
        unsigned off = kgo[i];
        asm volatile("" : "+v"(off));
        __builtin_amdgcn_global_load_lds((const unsigned*)(kt + off), (__attribute__((address_space(3))) unsigned*)(sn + (i * 4 + w) * 1024), 16, 0, 0);
      }
#pragma unroll
      for (int i = 0; i < 4; i++) {
        unsigned off = vgo[i];
        asm volatile("" : "+v"(off));
        __builtin_amdgcn_global_load_lds((const unsigned*)(vtp + off), (__attribute__((address_space(3))) unsigned*)(sn + KBYTES + (i * 4 + w) * 1024), 16, 0, 0);
      }
    }
    const u64 mw = mw_next;
    if (MASKED && more) mw_next = mrow[j + 1];
    if (j <= mylast) {
      f32x16 S[2];
#pragma unroll
      for (int mt = 0; mt < 2; mt++)
#pragma unroll
        for (int r = 0; r < 16; r++) S[mt][r] = negc0;
#pragma unroll
      for (int ks = 0; ks < KS; ks++)
#pragma unroll
        for (int mt = 0; mt < 2; mt++) {
          bf16x8 kf = *(const bf16x8*)(st + lds_off<KROWB>(mt * 32 + l31, 2 * ks + lh));
          S[mt] = mfma32(kf, qf[ks], S[mt]);
        }
      unsigned wlo = 0xffffffffu, whi = 0xffffffffu;
      if (MASKED) {
        wlo = ((unsigned)mw) >> (4 * lh);
        whi = ((unsigned)(mw >> 32)) >> (4 * lh);
      }
      float ps = 0.f;
#pragma unroll
      for (int mt = 0; mt < 2; mt++)
#pragma unroll
        for (int r = 0; r < 16; r++) {
          float pv = fexp2(S[mt][r]);
          if (MASKED) {
            const unsigned wd = mt ? whi : wlo;
            pv = ((wd >> ((r & 3) + 8 * (r >> 2))) & 1u) ? pv : 0.f;
          }
          S[mt][r] = pv;
          ps += pv;
        }
      lsum += ps;
#pragma unroll
      for (int kb = 0; kb < 2; kb++)
#pragma unroll
        for (int s = 0; s < 2; s++) {
          u32x4 pfu;
          pfu.x = pack2(S[kb][8 * s + 0], S[kb][8 * s + 1]);
          pfu.y = pack2(S[kb][8 * s + 2], S[kb][8 * s + 3]);
          pfu.z = pack2(S[kb][8 * s + 4], S[kb][8 * s + 5]);
          pfu.w = pack2(S[kb][8 * s + 6], S[kb][8 * s + 7]);
          const bf16x8 pfv = __builtin_bit_cast(bf16x8, pfu);
#pragma unroll
          for (int eb = 0; eb < 4; eb++) {
            const int row = eb * 32 + l31;
            const u32x2 h0 = *(const u32x2*)(st + KBYTES + lds_off<128>(row, 4 * kb + 2 * s) + 8 * lh);
            const u32x2 h1 = *(const u32x2*)(st + KBYTES + lds_off<128>(row, 4 * kb + 2 * s + 1) + 8 * lh);
            const u32x4 vfu = u32x4{h0.x, h0.y, h1.x, h1.y};
            O[eb] = mfma32(__builtin_bit_cast(bf16x8, vfu), pfv, O[eb]);
          }
        }
    }
    grp_barrier(gctr, gtarget, lane);
  }
  float lt = lsum + __shfl_xor(lsum, 32);
  const float inv = 1.f / lt;
#pragma unroll
  for (int eb = 0; eb < 4; eb++)
#pragma unroll
    for (int r = 0; r < 16; r++) O[eb][r] *= inv;
}

DEVI void flash_qtile_pipe(const bf16_t* __restrict__ qrow, const bf16_t* __restrict__ Kb, const int kstride,
                           const bf16_t* __restrict__ Vt, const int qt,
                           char* smem, f32x16 (&O)[4], const float negc0,
                           volatile __attribute__((address_space(3))) unsigned* gctr, unsigned& gtarget) {
  constexpr int KBYTES = 64 * 128;
  constexpr int STAGE = KBYTES + 16384;
  const int tid = otid(), lane = tid & 63, w = tid >> 6;
  const int l31 = lane & 31, lh = lane >> 5;
  unsigned kgo[2], vgo[4];
#pragma unroll
  for (int i = 0; i < 2; i++) {
    const int blk = i * 4 + w;
    const int row = blk * 8 + (lane >> 3);
    const int kc = (lane & 7) ^ ((row >> 1) & 7);
    kgo[i] = (unsigned)(row * kstride + kc * 8) * 2u;
  }
#pragma unroll
  for (int i = 0; i < 4; i++) {
    const int blk = i * 4 + w;
    const int row = blk * 8 + (lane >> 3);
    const int kc = (lane & 7) ^ ((row >> 1) & 7);
    vgo[i] = (unsigned)(row * 4096 + kc * 8) * 2u;
  }
  bf16x8 qf[4];
#pragma unroll
  for (int ks = 0; ks < 4; ks++) qf[ks] = *(const bf16x8*)(qrow + 16 * ks + 8 * lh);
#pragma unroll
  for (int eb = 0; eb < 4; eb++)
#pragma unroll
    for (int r = 0; r < 16; r++) O[eb][r] = 0.f;
  float lsum = 0.f;
  const int ntile = 2 * qt + 2;
  const int mylast = 2 * qt + (w >> 1);
#define FP_DMA_K(T, STG)                                                                              \
  { const char* kt = (const char*)Kb + (size_t)(T) * 64 * kstride * 2;                                \
    _Pragma("unroll") for (int i = 0; i < 2; i++) {                                                   \
      unsigned off = kgo[i]; asm volatile("" : "+v"(off));                                            \
      __builtin_amdgcn_global_load_lds((const unsigned*)(kt + off), (__attribute__((address_space(3))) unsigned*)(smem + (STG) * STAGE + (i * 4 + w) * 1024), 16, 0, 0); } }
#define FP_DMA_V(T, STG)                                                                              \
  { const char* vtp = (const char*)Vt + (size_t)(T) * 64 * 2;                                         \
    _Pragma("unroll") for (int i = 0; i < 4; i++) {                                                   \
      unsigned off = vgo[i]; asm volatile("" : "+v"(off));                                            \
      __builtin_amdgcn_global_load_lds((const unsigned*)(vtp + off), (__attribute__((address_space(3))) unsigned*)(smem + (STG) * STAGE + KBYTES + (i * 4 + w) * 1024), 16, 0, 0); } }
#define FP_QK(SX, STG)                                                                                \
  { _Pragma("unroll") for (int mt = 0; mt < 2; mt++)                                                  \
      _Pragma("unroll") for (int r = 0; r < 16; r++) SX[mt][r] = negc0;                               \
    _Pragma("unroll") for (int ks = 0; ks < 4; ks++)                                                  \
      _Pragma("unroll") for (int mt = 0; mt < 2; mt++) {                                              \
        bf16x8 kf = *(const bf16x8*)(smem + (STG) * STAGE + lds_off<128>(mt * 32 + l31, 2 * ks + lh)); \
        SX[mt] = mfma32(kf, qf[ks], SX[mt]); } }
#define FP_SMPV(SX, STG)                                                                              \
  { float ps = 0.f;                                                                                   \
    _Pragma("unroll") for (int mt = 0; mt < 2; mt++)                                                  \
      _Pragma("unroll") for (int r = 0; r < 16; r++) { const float pv = fexp2(SX[mt][r]); SX[mt][r] = pv; ps += pv; } \
    lsum += ps;                                                                                       \
    _Pragma("unroll") for (int kb = 0; kb < 2; kb++)                                                  \
      _Pragma("unroll") for (int s = 0; s < 2; s++) {                                                 \
        u32x4 pfu;                                                                                    \
        pfu.x = pack2(SX[kb][8 * s + 0], SX[kb][8 * s + 1]);                                          \
        pfu.y = pack2(SX[kb][8 * s + 2], SX[kb][8 * s + 3]);                                          \
        pfu.z = pack2(SX[kb][8 * s + 4], SX[kb][8 * s + 5]);                                          \
        pfu.w = pack2(SX[kb][8 * s + 6], SX[kb][8 * s + 7]);                                          \
        const bf16x8 pfv = __builtin_bit_cast(bf16x8, pfu);                                           \
        _Pragma("unroll") for (int eb = 0; eb < 4; eb++) {                                            \
          const int row = eb * 32 + l31;                                                              \
          const u32x2 h0 = *(const u32x2*)(smem + (STG) * STAGE + KBYTES + lds_off<128>(row, 4 * kb + 2 * s) + 8 * lh);     \
          const u32x2 h1 = *(const u32x2*)(smem + (STG) * STAGE + KBYTES + lds_off<128>(row, 4 * kb + 2 * s + 1) + 8 * lh); \
          const u32x4 vfu = u32x4{h0.x, h0.y, h1.x, h1.y};                                            \
          O[eb] = mfma32(__builtin_bit_cast(bf16x8, vfu), pfv, O[eb]); } } }
#define FP_STEP(J, SCUR, SNEXT, STG)                                                                  \
  { if ((J) + 2 < ntile) FP_DMA_K((J) + 2, STG)                                                       \
    if ((J) + 1 < ntile) FP_DMA_V((J) + 1, (STG) ^ 1)                                                 \
    if ((J) + 1 <= mylast) FP_QK(SNEXT, (STG) ^ 1)                                                    \
    if ((J) <= mylast) FP_SMPV(SCUR, STG)                                                             \
    grp_barrier(gctr, gtarget, lane); }
  f32x16 SA[2], SB[2];
  grp_barrier(gctr, gtarget, lane);
  FP_DMA_K(0, 0)
  FP_DMA_V(0, 0)
  FP_DMA_K(1, 1)
  grp_barrier(gctr, gtarget, lane);
  FP_QK(SA, 0)
  grp_barrier(gctr, gtarget, lane);
#pragma unroll
  for (int mt = 0; mt < 2; mt++)
#pragma unroll
    for (int r = 0; r < 16; r++) SB[mt][r] = 0.f;
  for (int j = 0; j < ntile; j += 2) {
    FP_STEP(j, SA, SB, 0)
    FP_STEP(j + 1, SB, SA, 1)
  }
#undef FP_DMA_K
#undef FP_DMA_V
#undef FP_QK
#undef FP_SMPV
#undef FP_STEP
  float lt = lsum + __shfl_xor(lsum, 32);
  const float inv = 1.f / lt;
#pragma unroll
  for (int eb = 0; eb < 4; eb++)
#pragma unroll
    for (int r = 0; r < 16; r++) O[eb][r] *= inv;
}

DEVI void attnA_phase(const Params& p, int jl, float lambda_init, char* smem,
                        volatile __attribute__((address_space(3))) unsigned* gctr, unsigned& gtarget) {
  const int tid = otid(), lane = tid & 63, w = tid >> 6;
  const int l31 = lane & 31, lh = lane >> 5;
  const bf16_t* qk = (const bf16_t*)(p.ws + R_QK);
  const bf16_t* vt = (const bf16_t*)(p.ws + R_VT);
  bf16_t* ao = (bf16_t*)(p.ws + R_AO);
  float s1 = p.a_lq1[jl * 64 + lane] * p.a_lk1[jl * 64 + lane];
  float s2 = p.a_lq2[jl * 64 + lane] * p.a_lk2[jl * 64 + lane];
#pragma unroll
  for (int o = 32; o >= 1; o >>= 1) { s1 += __shfl_xor(s1, o); s2 += __shfl_xor(s2, o); }
  const float lam = expf(s1) - expf(s2) + lambda_init;
  float gq = fabsf(p.a_q_g[jl * 64 + lane]), gk = fabsf(p.a_k_g[jl * 64 + lane]);
#pragma unroll
  for (int o = 32; o >= 1; o >>= 1) { gq = fmaxf(gq, __shfl_xor(gq, o)); gk = fmaxf(gk, __shfl_xor(gk, o)); }
  const float negc0 = -(8.0f * gq * gk * LOG2E * 1.01f);
  const float* subg = p.a_sub_g + jl * 128;
  for (int item = vblk(); item < 512; item += nvblk()) {
    const int pr = item & 15, h = (item >> 4) & 7, b = item >> 7;
    for (int qi = 0; qi < 2; qi++) {
      const int qt = qi ? pr : (31 - pr);
      const int t = b * SEQ + qt * 128 + w * 32 + l31;
      f32x16 O[4];
      flash_qtile_pipe(qk + (size_t)t * 2048 + h * 128, qk + (size_t)b * SEQ * 2048 + 1024 + h * 128, 2048,
                             vt + (size_t)(b * 8 + h) * 128 * 4096, qt, smem, O, negc0, gctr, gtarget);
#pragma unroll
      for (int eb = 0; eb < 4; eb++)
#pragma unroll
        for (int q4 = 0; q4 < 4; q4++) {
          const int e = eb * 32 + 8 * q4 + 4 * lh;
          u32x2 o;
          o.x = pack2(O[eb][4 * q4 + 0], O[eb][4 * q4 + 1]);
          o.y = pack2(O[eb][4 * q4 + 2], O[eb][4 * q4 + 3]);
          *(u32x2*)(ao + (size_t)t * 1024 + h * 128 + e) = o;
        }
      flash_qtile_pipe(qk + (size_t)t * 2048 + h * 128 + 64, qk + (size_t)b * SEQ * 2048 + 1024 + h * 128 + 64, 2048,
                             vt + (size_t)(b * 8 + h) * 128 * 4096, qt, smem, O, negc0, gctr, gtarget);
      float ssq = 0.f;
#pragma unroll
      for (int eb = 0; eb < 4; eb++)
#pragma unroll
        for (int q4 = 0; q4 < 4; q4++) {
          const int e = eb * 32 + 8 * q4 + 4 * lh;
          const u32x2 o1 = *(const u32x2*)(ao + (size_t)t * 1024 + h * 128 + e);
          const float a0 = bf_lo(o1.x) - lam * O[eb][4 * q4 + 0];
          const float a1 = bf_hi(o1.x) - lam * O[eb][4 * q4 + 1];
          const float a2 = bf_lo(o1.y) - lam * O[eb][4 * q4 + 2];
          const float a3 = bf_hi(o1.y) - lam * O[eb][4 * q4 + 3];
          O[eb][4 * q4 + 0] = a0; O[eb][4 * q4 + 1] = a1; O[eb][4 * q4 + 2] = a2; O[eb][4 * q4 + 3] = a3;
          ssq += a0 * a0 + a1 * a1 + a2 * a2 + a3 * a3;
        }
      ssq += __shfl_xor(ssq, 32);
      const float rn = rsqrtf(ssq * (1.f / 128.f) + EPS) * (1.f - lambda_init);
#pragma unroll
      for (int eb = 0; eb < 4; eb++)
#pragma unroll
        for (int q4 = 0; q4 < 4; q4++) {
          const int e = eb * 32 + 8 * q4 + 4 * lh;
          const f32x4 gv = *(const f32x4*)(subg + e);
          u32x2 o;
          o.x = pack2(O[eb][4 * q4 + 0] * rn * gv.x, O[eb][4 * q4 + 1] * rn * gv.y);
          o.y = pack2(O[eb][4 * q4 + 2] * rn * gv.z, O[eb][4 * q4 + 3] * rn * gv.w);
          *(u32x2*)(ao + (size_t)t * 1024 + h * 128 + e) = o;
        }
    }
  }
}

DEVI void attnC_phase(const Params& p, char* smem, volatile __attribute__((address_space(3))) unsigned* gctr, unsigned& gtarget) {
  const int tid = otid(), lane = tid & 63, w = tid >> 6;
  const int l31 = lane & 31, lh = lane >> 5;
  const bf16_t* cq = (const bf16_t*)(p.ws + R_CQ);
  const bf16_t* ck = (const bf16_t*)(p.ws + R_CK);
  const bf16_t* cvt = (const bf16_t*)(p.ws + R_CVT);
  const u64* mask = (const u64*)(p.ws + R_MASK);
  bf16_t* ao = (bf16_t*)(p.ws + R_AO);
  float gq = fmaxf(fabsf(p.c_q_g[lane]), fabsf(p.c_q_g[64 + lane])), gk = fmaxf(fabsf(p.c_k_g[lane]), fabsf(p.c_k_g[64 + lane]));
#pragma unroll
  for (int o = 32; o >= 1; o >>= 1) { gq = fmaxf(gq, __shfl_xor(gq, o)); gk = fmaxf(gk, __shfl_xor(gk, o)); }
  const float negc0 = -(11.313708498984761f * gq * gk * LOG2E * 1.01f);
  for (int item = vblk(); item < 512; item += nvblk()) {
    const int pr = item & 15, hh = (item >> 4) & 7, b = item >> 7;
    const int g = hh >> 2;
    for (int qi = 0; qi < 2; qi++) {
      const int qt = qi ? pr : (31 - pr);
      const int t = b * SEQ + qt * 128 + w * 32 + l31;
      f32x16 O[4];
      flash_qtile<128, true>(cq + (size_t)t * 1024 + hh * 128, ck + (size_t)b * SEQ * 256 + g * 128, 256,
                             cvt + (size_t)(b * 2 + g) * 128 * 4096, mask + (size_t)t * 64, qt, smem, O, negc0, gctr, gtarget);
#pragma unroll
      for (int eb = 0; eb < 4; eb++)
#pragma unroll
        for (int q4 = 0; q4 < 4; q4++) {
          const int e = eb * 32 + 8 * q4 + 4 * lh;
          u32x2 o;
          o.x = pack2(O[eb][4 * q4 + 0], O[eb][4 * q4 + 1]);
          o.y = pack2(O[eb][4 * q4 + 2], O[eb][4 * q4 + 3]);
          *(u32x2*)(ao + (size_t)t * 1024 + hh * 128 + e) = o;
        }
    }
  }
}

DEVI void pool_phase(const Params& p, char* smem) {
  const int tid = otid(), lane = tid & 63, w = tid >> 6;
  float* rs = (float*)smem;
  const float* h = p.out;
  bf16_t* pooled = (bf16_t*)(p.ws + R_POOL);
  for (int tile = vblk(); tile < T_TOK / 32; tile += nvblk()) {
    const int t0 = tile * 32;
    const int pos0 = t0 & (SEQ - 1);
    __syncthreads();
    for (int r = w; r < 47; r += 4) {
      const int pos = pos0 - 15 + r;
      if (pos >= 0) {
        const float* row = h + (size_t)(t0 - 15 + r) * 1024;
        float s = 0.f;
#pragma unroll
        for (int i = 0; i < 4; i++) {
          f32x4 v = *(const f32x4*)(row + i * 256 + lane * 4);
          s += v.x * v.x + v.y * v.y + v.z * v.z + v.w * v.w;
        }
#pragma unroll
        for (int o = 32; o >= 1; o >>= 1) s += __shfl_xor(s, o);
        if (lane == 0) rs[r] = rsqrtf(s * (1.f / 1024.f) + EPS);
      }
    }
    __syncthreads();
    const int c = tid * 4;
    const int grp = c >> 8;
    const int win = 2 << grp;
    f32x4 sum = f32x4{0.f, 0.f, 0.f, 0.f};
    for (int r = -(win - 1); r < 0; r++) {
      if (pos0 + r >= 0) {
        f32x4 v = *(const f32x4*)(h + (size_t)(t0 + r) * 1024 + c);
        const float s = rs[r + 15];
        sum.x += v.x * s; sum.y += v.y * s; sum.z += v.z * s; sum.w += v.w * s;
      }
    }
    for (int r = 0; r < 32; r++) {
      f32x4 v = *(const f32x4*)(h + (size_t)(t0 + r) * 1024 + c);
      const float s = rs[r + 15];
      v.x *= s; v.y *= s; v.z *= s; v.w *= s;
      sum.x += v.x; sum.y += v.y; sum.z += v.z; sum.w += v.w;
      const int pos = pos0 + r;
      const float ic = 1.f / (float)min(pos + 1, win);
      u32x2 o;
      o.x = pack2(sum.x * ic - v.x, sum.y * ic - v.y);
      o.y = pack2(sum.z * ic - v.z, sum.w * ic - v.w);
      *(u32x2*)(pooled + (size_t)(t0 + r) * 1024 + c) = o;
      const int ro = r - win + 1;
      if (pos0 + ro >= 0) {
        f32x4 u = *(const f32x4*)(h + (size_t)(t0 + ro) * 1024 + c);
        const float so = rs[ro + 15];
        sum.x -= u.x * so; sum.y -= u.y * so; sum.z -= u.z * so; sum.w -= u.w * so;
      }
    }
  }
}

DEVI unsigned fkey(float f) {
  unsigned u = __float_as_uint(f);
  return (u & 0x80000000u) ? ~u : (u | 0x80000000u);
}

template <int NR>
DEVI void select_topk(const float* srow, const int c, const int lane, u64* mrow) {
  unsigned kreg[NR];
#pragma unroll
  for (int j = 0; j < NR; j++) {
    const unsigned k = fkey(srow[j * 64 + lane]);
    kreg[j] = (j <= c) ? k : 0u;
  }
  unsigned T = 0u;
  bool exact = false;
#pragma unroll 1
  for (int bit = 31; bit >= 0; bit--) {
    const unsigned cand = T | (1u << bit);
    int cnt = 0;
#pragma unroll
    for (int j = 0; j < NR; j++) cnt += __popcll(__ballot(kreg[j] >= cand));
    if (cnt >= 256) T = cand;
    if (cnt == 256) { exact = true; break; }
  }
  asm volatile("" : "+v"(T));
  if (exact) {
#pragma unroll
    for (int j = 0; j < NR; j++) {
      const u64 bm = __ballot(kreg[j] >= T);
      if (lane == 0) mrow[j] = bm;
    }
  } else {
    int cgt = 0;
#pragma unroll
    for (int j = 0; j < NR; j++) cgt += __popcll(__ballot(kreg[j] > T));
    int need = 256 - cgt;
#pragma unroll
    for (int j = 0; j < NR; j++) {
      const u64 gt = __ballot(kreg[j] > T);
      const u64 eq = __ballot(kreg[j] == T);
      const int rank = __popcll(eq & ((1ull << lane) - 1ull));
      const u64 tk = __ballot((kreg[j] == T) && (rank < need));
      need -= __popcll(eq);
      const u64 bm = gt | tk;
      if (lane == 0) mrow[j] = bm;
    }
  }
}

DEVI void index_unit(const Params& p, int unit, char* smem, volatile __attribute__((address_space(3))) unsigned* gctr, unsigned& gtarget) {
  const int tid = otid(), lane = tid & 63, w = tid >> 6;
  const int l31 = lane & 31, lh = lane >> 5;
  const int c = unit >> 4, b = (unit >> 2) & 3, qr = unit & 3;
  const int t0 = b * SEQ + c * 64 + qr * 16;
  u64* mask = (u64*)(p.ws + R_MASK);
  if (c < 4) {
    if (tid < 16 * (c + 1)) {
      const int q = tid / (c + 1), j = tid % (c + 1);
      u64 ones = ~0ull;
      asm volatile("" : "+v"(ones));
      mask[(size_t)(t0 + q) * 64 + j] = ones;
    }
    return;
  }
  const bf16_t* ciq = (const bf16_t*)(p.ws + R_CIQ);
  const bf16_t* cik = (const bf16_t*)(p.ws + R_CIK);
  const float* ciw = (const float*)(p.ws + R_CIW);
  float* sc = (float*)smem;
  const int nkb = 2 * (c + 1);
  for (int grp = 0; grp < 4; grp++) {
    const int tq = t0 + grp * 4;
    {
      const int a = l31 >> 3, gg = (l31 >> 2) & 1, bq = l31 & 3;
      const int qloc = 2 * gg + (a >> 1), head = (a & 1) * 4 + bq;
      bf16x8 af[4];
#pragma unroll
      for (int ks = 0; ks < 4; ks++) af[ks] = *(const bf16x8*)(ciq + (size_t)(tq + qloc) * 512 + head * 64 + 16 * ks + 8 * lh);
      float wq0[8], wq1[8];
      {
        const f32x4 a0 = *(const f32x4*)(ciw + (size_t)(tq + 2 * lh) * 8), a1 = *(const f32x4*)(ciw + (size_t)(tq + 2 * lh) * 8 + 4);
        const f32x4 b0 = *(const f32x4*)(ciw + (size_t)(tq + 2 * lh + 1) * 8), b1 = *(const f32x4*)(ciw + (size_t)(tq + 2 * lh + 1) * 8 + 4);
        wq0[0] = a0.x; wq0[1] = a0.y; wq0[2] = a0.z; wq0[3] = a0.w; wq0[4] = a1.x; wq0[5] = a1.y; wq0[6] = a1.z; wq0[7] = a1.w;
        wq1[0] = b0.x; wq1[1] = b0.y; wq1[2] = b0.z; wq1[3] = b0.w; wq1[4] = b1.x; wq1[5] = b1.y; wq1[6] = b1.z; wq1[7] = b1.w;
      }
      const int nit = (nkb - w + 3) >> 2;
      const bf16_t* ikb = cik + (size_t)b * SEQ * 64 + 8 * lh;
      bf16x8 nb[4][4];
#pragma unroll
      for (int u = 0; u < 4; u++) {
        const int kb = min(w + 4 * u, nkb - 1);
#pragma unroll
        for (int ks = 0; ks < 4; ks++) nb[u][ks] = *(const bf16x8*)(ikb + (size_t)(kb * 32 + l31) * 64 + 16 * ks);
      }
      for (int it0 = 0; it0 < nit; it0 += 4) {
        bf16x8 cb[4][4];
#pragma unroll
        for (int u = 0; u < 4; u++)
#pragma unroll
          for (int ks = 0; ks < 4; ks++) cb[u][ks] = nb[u][ks];
        if (it0 + 4 < nit) {
#pragma unroll
          for (int u = 0; u < 4; u++) {
            const int kb = min(w + 4 * (it0 + 4 + u), nkb - 1);
#pragma unroll
            for (int ks = 0; ks < 4; ks++) nb[u][ks] = *(const bf16x8*)(ikb + (size_t)(kb * 32 + l31) * 64 + 16 * ks);
          }
        }
#pragma unroll
        for (int u = 0; u < 4; u++) {
          const int kb = w + 4 * (it0 + u);
          f32x16 acc;
#pragma unroll
          for (int r = 0; r < 16; r++) acc[r] = 0.f;
#pragma unroll
          for (int ks = 0; ks < 4; ks++) acc = mfma32(af[ks], cb[u][ks], acc);
          float s0 = 0.f, s1 = 0.f;
#pragma unroll
          for (int r = 0; r < 8; r++) s0 += wq0[r] * fmaxf(acc[r], 0.f);
#pragma unroll
          for (int r = 0; r < 8; r++) s1 += wq1[r] * fmaxf(acc[8 + r], 0.f);
          if (s0 == 0.f) s0 = 0.f;
          if (s1 == 0.f) s1 = 0.f;
          if (kb < nkb) {
            const int key = kb * 32 + l31;
            sc[(2 * lh) * 4096 + key] = s0;
            sc[(2 * lh + 1) * 4096 + key] = s1;
          }
        }
      }
    }
    grp_barrier(gctr, gtarget, lane);
    {
      u64* mrow = mask + (size_t)(tq + w) * 64;
      const float* srow = sc + w * 4096;
      if (c < 16) select_topk<16>(srow, c, lane, mrow);
      else if (c < 32) select_topk<32>(srow, c, lane, mrow);
      else if (c < 48) select_topk<48>(srow, c, lane, mrow);
      else select_topk<64>(srow, c, lane, mrow);
    }
    grp_barrier(gctr, gtarget, lane);
  }
}

DEVI void index_phase(const Params& p, char* smem, volatile __attribute__((address_space(3))) unsigned* gctr, unsigned& gtarget) {
  for (int it2 = vblk() * 2; it2 < 1024; it2 += nvblk() * 2) {
    for (int k = 0; k < 2; k++) {
      const int item = it2 >> 1;
      index_unit(p, k ? item : (1023 - item), smem, gctr, gtarget);
    }
  }
}


#define XB_TMO      128
#define XB_XCNT(j)  (256  + 64 * (j))
#define XB_XSUB(j)  (1280 + 64 * (j))
#define XB_XGEN(j)  (2304 + 64 * (j))
#define XB_TOP      3328
#define XB_TOPGEN   3392
#define XCD_BAR_WORDS 3456
#define XB_SPIN_CAP (1u << 22)
#define LAS __attribute__((address_space(3)))
constexpr size_t OFF_BAR = 250 * MB;

DEVI unsigned xb_ld(unsigned* p)              { return __hip_atomic_load(p, __ATOMIC_RELAXED, __HIP_MEMORY_SCOPE_AGENT); }
DEVI unsigned xb_add(unsigned* p, unsigned v) { return __hip_atomic_fetch_add(p, v, __ATOMIC_RELAXED, __HIP_MEMORY_SCOPE_AGENT); }
DEVI unsigned xb_xcc_id() { return (unsigned)__builtin_amdgcn_s_getreg((3 << 11) | 20) & 0xFu; }
#define XB_SPIN(cond, bar) do { unsigned _sp = 0; while (cond) { __builtin_amdgcn_s_sleep(1); \
    if ((++_sp & 255u) == 0u) { if (xb_ld(&(bar)[XB_TMO])) break; if (_sp > XB_SPIN_CAP) { atomicAdd(&(bar)[XB_TMO], 1u); break; } } } } while (0)

struct XcdBarrier { unsigned* bar; volatile LAS unsigned* st; };

DEVI XcdBarrier xcd_barrier_post(unsigned* bar, volatile LAS unsigned* st) {
  XcdBarrier b; b.bar = bar; b.st = st;
  if (threadIdx.x == 0) (void)xb_add(&bar[XB_XCNT(xb_xcc_id())], 1u);
  return b;
}
DEVI void xcd_barrier_complete(unsigned* bar, unsigned x, unsigned& nloc, unsigned& nx) {
  const unsigned G = gridDim.x * gridDim.y * gridDim.z;
  unsigned sum, cnt, mine, sp = 0u;
  for (;;) {
    sum = 0u; cnt = 0u; mine = 0u;
#pragma unroll
    for (unsigned j = 0; j < 16; ++j) { const unsigned c = xb_ld(&bar[XB_XCNT(j)]); sum += c; cnt += (c > 0u) ? 1u : 0u; mine = (j == x) ? c : mine; }
    if (sum == G) break;
    __builtin_amdgcn_s_sleep(1);
    if ((++sp & 255u) == 0u) { if (xb_ld(&bar[XB_TMO])) break; if (sp > XB_SPIN_CAP) { atomicAdd(&bar[XB_TMO], 1u); break; } }
  }
  nloc = mine > 0u ? mine : 1u; nx = cnt > 0u ? cnt : 1u;
}
DEVI void xcd_barrier(const XcdBarrier& b) {
  asm volatile("s_waitcnt vmcnt(0)" ::: "memory");
  __syncthreads();
  if (threadIdx.x == 0) {
    unsigned* bar = b.bar;
    const unsigned bx = xb_xcc_id();
    __builtin_amdgcn_s_waitcnt(0);
    unsigned nloc = b.st[0], nx = b.st[1];
    if (nloc == 0u) { xcd_barrier_complete(bar, bx, nloc, nx); b.st[0] = nloc; b.st[1] = nx; }
    const unsigned old = xb_add(&bar[XB_XSUB(bx)], 1u);
    const unsigned gen = old / nloc;
    if (old + 1u == (gen + 1u) * nloc) {
      __builtin_amdgcn_fence(__ATOMIC_RELEASE, "agent");
      asm volatile("s_waitcnt vmcnt(0)" ::: "memory");
      const unsigned og = xb_add(&bar[XB_TOP], 1u);
      const unsigned tg = og / nx;
      if (og + 1u == (tg + 1u) * nx) xb_add(&bar[XB_TOPGEN], 1u);
      else XB_SPIN(xb_ld(&bar[XB_TOPGEN]) == tg, bar);
      __builtin_amdgcn_fence(__ATOMIC_ACQUIRE, "agent");
      xb_add(&bar[XB_XGEN(bx)], 1u);
      asm volatile("s_waitcnt vmcnt(0)" ::: "memory");
    } else {
      XB_SPIN(xb_ld(&bar[XB_XGEN(bx)]) == gen, bar);
      __builtin_amdgcn_fence(__ATOMIC_ACQUIRE, "agent");
      asm volatile("s_waitcnt vmcnt(0)" ::: "memory");
    }
  }
  __syncthreads();
}

__global__ void __launch_bounds__(512, 2) fwd_megakernel(Params p) {
  __shared__ __attribute__((aligned(16))) char smem[SMEM_BYTES];
  cg::grid_group grid = cg::this_grid();
  char* gs = smem + grp_id() * 65536;
  char* ws = p.ws;
  __shared__ __attribute__((aligned(16))) unsigned xb_words[4];
  if (threadIdx.x == 0) { xb_words[0] = 0u; xb_words[1] = 0u; xb_words[2] = 0u; xb_words[3] = 0u; }
  __syncthreads();
  volatile LAS unsigned* gctr = (volatile LAS unsigned*)&xb_words[2 + grp_id()];
  unsigned gtarget = 0u;
  const XcdBarrier xb = xcd_barrier_post((unsigned*)(ws + OFF_BAR), (volatile LAS unsigned*)xb_words);
  if (gridDim.y == 0x7fffffffu) grid.sync();
  bf16_t* hb = (bf16_t*)(ws + OFF_HB);

  for (int rep = 0; rep <= DUP_CONV; rep++) convert_phase(p, gs);
  xcd_barrier(xb);

  for (int layer = 0; layer < 4; layer++) {
    const int mixer = layer % 3, jl = layer / 3;
    const float* resid_src = (layer == 0) ? p.x : p.out;
    if (mixer == 0) {
      const float lambda_init = (layer == 0) ? 0.2f : 0.5560582041564594f;
      {
        GemmArgs ga{};
      ga.ssq = (float*)(ws + OFF_SSQ);
        ga.ssq = (float*)(ws + OFF_SSQ);
        ga.A = hb; ga.lda = 1024; ga.Bt = (const bf16_t*)(ws + OFF_AIN + (size_t)jl * 6 * MB); ga.K = 1024; ga.NT = 12;
        ga.o0 = ws + R_QK; ga.o1 = ws + R_VT; ga.g0 = p.a_q_g + jl * 64; ga.g1 = p.a_k_g + jl * 64;
        for (int rep = 0; rep <= DUP_GEMM; rep++) gemm_phase<M_AQKV, 1024>(ga, smem);
      }
      xcd_barrier(xb);
      for (int rep = 0; rep <= DUP_ATTNA; rep++) attnA_phase(p, jl, lambda_init, gs, gctr, gtarget);
      xcd_barrier(xb);
      {
        GemmArgs ga{};
      ga.ssq = (float*)(ws + OFF_SSQ);
        ga.ssq = (float*)(ws + OFF_SSQ);
        ga.A = (const bf16_t*)(ws + R_AO); ga.lda = 1024; ga.Bt = (const bf16_t*)(ws + OFF_AOUT + (size_t)jl * 2 * MB); ga.K = 1024; ga.NT = 4;
        ga.o0 = p.out; ga.o1 = hb; ga.resid = resid_src;
        gemm_phase<M_RESID, 1024>(ga, smem);
      }
      xcd_barrier(xb);
    } else if (mixer == 1) {
      pool_phase(p, gs);
      xcd_barrier(xb);
      {
        GemmArgs ga{};
      ga.ssq = (float*)(ws + OFF_SSQ);
        ga.ssq = (float*)(ws + OFF_SSQ);
        ga.A = (const bf16_t*)(ws + R_POOL); ga.lda = 1024; ga.Bt = (const bf16_t*)(ws + OFF_BW); ga.K = 256; ga.NT = 4;
        ga.o0 = p.out; ga.o1 = hb; ga.resid = resid_src; ga.g0 = p.b_scale;
        gemm_phase<M_POOL, 256>(ga, smem);
      }
      xcd_barrier(xb);
    } else {
      {
        GemmArgs ga{};
      ga.ssq = (float*)(ws + OFF_SSQ);
        ga.ssq = (float*)(ws + OFF_SSQ);
        ga.A = hb; ga.lda = 1024; ga.Bt = (const bf16_t*)(ws + OFF_CIN); ga.K = 1024; ga.NT = 9;
        ga.o0 = ws + R_CQ; ga.o1 = ws + R_CK; ga.o2 = ws + R_CVT; ga.o3 = ws + R_CIQ; ga.o4 = ws + R_CIK; ga.o5 = ws + R_CIW;
        ga.g0 = p.c_q_g; ga.g1 = p.c_k_g;
        for (int rep = 0; rep <= DUP_GEMM; rep++) gemm_phase<M_CIN, 1024>(ga, smem);
      }
      xcd_barrier(xb);
      for (int rep = 0; rep <= DUP_IDX; rep++) index_phase(p, gs, gctr, gtarget);
      xcd_barrier(xb);
      for (int rep = 0; rep <= DUP_ATTNC; rep++) attnC_phase(p, gs, gctr, gtarget);
      xcd_barrier(xb);
      {
        GemmArgs ga{};
      ga.ssq = (float*)(ws + OFF_SSQ);
        ga.ssq = (float*)(ws + OFF_SSQ);
        ga.A = (const bf16_t*)(ws + R_AO); ga.lda = 1024; ga.Bt = (const bf16_t*)(ws + OFF_COUT); ga.K = 1024; ga.NT = 4;
        ga.o0 = p.out; ga.o1 = hb; ga.resid = resid_src;
        gemm_phase<M_RESID, 1024>(ga, smem);
      }
      xcd_barrier(xb);
    }
    {
      GemmArgs ga{};
      ga.ssq = (float*)(ws + OFF_SSQ);
      ga.A = hb; ga.lda = 1024; ga.Bt = (const bf16_t*)(ws + OFF_W1 + (size_t)layer * 8 * MB); ga.K = 1024; ga.NT = 16;
      ga.o0 = ws + R_HID;
      for (int rep = 0; rep <= DUP_GEMM; rep++) gemm_phase<M_MLP1, 1024>(ga, smem);
    }
    xcd_barrier(xb);
    {
      GemmArgs ga{};
      ga.ssq = (float*)(ws + OFF_SSQ);
      ga.A = (const bf16_t*)(ws + R_HID); ga.lda = 4096; ga.Bt = (const bf16_t*)(ws + OFF_W2 + (size_t)layer * 8 * MB); ga.K = 4096; ga.NT = 4;
      ga.o0 = p.out; ga.o1 = hb; ga.resid = p.out;
      gemm_phase<M_RESID, 4096>(ga, smem);
    }
    if (layer < 3) xcd_barrier(xb);
  }
}

extern "C" void kernel_launch(void* const* d_in, const int* in_sizes, int n_in, void* d_out, int out_size,
                              void* d_ws, size_t ws_size, hipStream_t stream) {
  static int grid_blocks = 0;
  if (!grid_blocks) {
    int dev = 0, cus = 0, per_cu = 0;
    hipGetDevice(&dev);
    hipDeviceGetAttribute(&cus, hipDeviceAttributeMultiprocessorCount, dev);
    hipOccupancyMaxActiveBlocksPerMultiprocessor(&per_cu, fwd_megakernel, 512, 0);
    if (per_cu > 1) per_cu = 1;
    if (per_cu < 1) per_cu = 1;
    grid_blocks = cus * per_cu;
  }
  if (ws_size < WS_NEED) { fprintf(stderr, "workspace too small: %zu < %zu\n", ws_size, (size_t)WS_NEED); return; }
  Params p{};
  p.x = (const float*)d_in[0]; p.norm1_g = (const float*)d_in[1]; p.norm2_g = (const float*)d_in[2];
  p.a_w_in = (const float*)d_in[3]; p.a_q_g = (const float*)d_in[4]; p.a_k_g = (const float*)d_in[5];
  p.a_lq1 = (const float*)d_in[6]; p.a_lk1 = (const float*)d_in[7]; p.a_lq2 = (const float*)d_in[8]; p.a_lk2 = (const float*)d_in[9];
  p.a_sub_g = (const float*)d_in[10]; p.a_w_out = (const float*)d_in[11];
  p.b_w = (const float*)d_in[12]; p.b_scale = (const float*)d_in[13];
  p.c_w_in = (const float*)d_in[14]; p.c_q_g = (const float*)d_in[15]; p.c_k_g = (const float*)d_in[16]; p.c_w_out = (const float*)d_in[17];
  p.w1 = (const float*)d_in[18]; p.w2 = (const float*)d_in[19];
  p.out = (float*)d_out; p.ws = (char*)d_ws;
  hipMemsetAsync((char*)d_ws + OFF_BAR, 0, XCD_BAR_WORDS * sizeof(unsigned), stream);
  void* args[] = {&p};
  hipError_t e = hipLaunchCooperativeKernel((void*)fwd_megakernel, dim3(grid_blocks), dim3(512), args, 0, stream);
  if (e != hipSuccess) fprintf(stderr, "cooperative launch failed: %s (grid %d)\n", hipGetErrorString(e), grid_blocks);
}
```

```cpp
#include <hip/hip_runtime.h>
#include <hip/hip_cooperative_groups.h>
#include <cstdio>
namespace cg = cooperative_groups;

typedef unsigned short bf16_t;
typedef __attribute__((ext_vector_type(8))) short bf16x8;
typedef __attribute__((ext_vector_type(16))) float f32x16;
typedef unsigned long long u64;
typedef unsigned __attribute__((ext_vector_type(4))) u32x4;
typedef unsigned __attribute__((ext_vector_type(2))) u32x2;
typedef float __attribute__((ext_vector_type(4))) f32x4;

#define DEVI __device__ __forceinline__
#define DUP_GEMM 0
#define DUP_ATTNA 0
#define DUP_IDX 0
#define DUP_ATTNC 0
#define DUP_CONV 0

constexpr int T_TOK = 16384;
constexpr int DM = 1024;
constexpr int SEQ = 4096;
constexpr float EPS = 1e-6f;
constexpr float LOG2E = 1.4426950408889634f;
constexpr size_t MB = 1ull << 20;

constexpr size_t OFF_W1 = 0;
constexpr size_t OFF_W2 = 32 * MB;
constexpr size_t OFF_AIN = 64 * MB;
constexpr size_t OFF_AOUT = 76 * MB;
constexpr size_t OFF_BW = 80 * MB;
constexpr size_t OFF_CIN = 81 * MB;
constexpr size_t OFF_COUT = 86 * MB;
constexpr size_t OFF_HB = 88 * MB;
constexpr size_t OFF_R = 120 * MB;
constexpr size_t OFF_SSQ = 249 * MB;
constexpr size_t WS_NEED = 251 * MB;
constexpr size_t R_QK = OFF_R;
constexpr size_t R_VT = OFF_R + 64 * MB;
constexpr size_t R_AO = OFF_R + 96 * MB;
constexpr size_t R_HID = OFF_R;
constexpr size_t R_POOL = OFF_R;
constexpr size_t R_CQ = OFF_R;
constexpr size_t R_CK = OFF_R + 32 * MB;
constexpr size_t R_CVT = OFF_R + 40 * MB;
constexpr size_t R_CIQ = OFF_R + 48 * MB;
constexpr size_t R_CIK = OFF_R + 64 * MB;
constexpr size_t R_CIW = OFF_R + 66 * MB;
constexpr size_t R_MASK = OFF_R + 67 * MB;

struct Params {
  const float* x; const float* norm1_g; const float* norm2_g;
  const float* a_w_in; const float* a_q_g; const float* a_k_g;
  const float* a_lq1; const float* a_lk1; const float* a_lq2; const float* a_lk2;
  const float* a_sub_g; const float* a_w_out;
  const float* b_w; const float* b_scale;
  const float* c_w_in; const float* c_q_g; const float* c_k_g; const float* c_w_out;
  const float* w1; const float* w2;
  float* out; char* ws;
};

DEVI bf16_t f2bf(float f) {
  return __builtin_bit_cast(bf16_t, (__bf16)f);
}
typedef __bf16 bf16x2_t __attribute__((ext_vector_type(2)));
DEVI unsigned pack2(float a, float b) {
  bf16x2_t v;
  v.x = (__bf16)a; v.y = (__bf16)b;
  return __builtin_bit_cast(unsigned, v);
}
DEVI float bf_lo(unsigned p) { return __uint_as_float(p << 16); }
DEVI float bf_hi(unsigned p) { return __uint_as_float(p & 0xffff0000u); }
DEVI float fexp2(float x) { return __builtin_amdgcn_exp2f(x); }

template <int ROWB>
DEVI int lds_off(int row, int chunk) {
  if (ROWB == 128) return row * 128 + ((chunk ^ ((row >> 1) & 7)) << 4);
  else return row * 256 + ((chunk ^ (row & 15)) << 4);
}

DEVI f32x16 mfma32(bf16x8 a, bf16x8 b, f32x16 c) {
  return __builtin_amdgcn_mfma_f32_32x32x16_bf16(a, b, c, 0, 0, 0);
}

constexpr int SMEM_BYTES = 131072 + 1024 + 4096;

DEVI int otid() { int t = threadIdx.x & 255; asm volatile("" : "+v"(t)); return t; }
DEVI int otid512() { int t = threadIdx.x; asm volatile("" : "+v"(t)); return t; }
DEVI int grp_id() { return __builtin_amdgcn_readfirstlane((int)(threadIdx.x >> 8)); }
DEVI int vblk() { return (int)blockIdx.x * 2 + grp_id(); }
DEVI int nvblk() { return (int)gridDim.x * 2; }

struct Job { const float* src; bf16_t* dst; const float* gain; int K, N, NP; };

DEVI Job get_job(const Params& p, int j) {
  Job jb;
  char* ws = p.ws;
  if (j < 4) {
    jb.src = p.w1 + (size_t)j * 1024 * 4096; jb.dst = (bf16_t*)(ws + OFF_W1 + (size_t)j * 8 * MB);
    jb.gain = p.norm2_g + j * 1024; jb.K = 1024; jb.N = 4096; jb.NP = 4096;
  } else if (j < 8) {
    int i = j - 4;
    jb.src = p.w2 + (size_t)i * 1024 * 4096; jb.dst = (bf16_t*)(ws + OFF_W2 + (size_t)i * 8 * MB);
    jb.gain = nullptr; jb.K = 4096; jb.N = 1024; jb.NP = 1024;
  } else if (j < 10) {
    int i = j - 8;
    jb.src = p.a_w_in + (size_t)i * 1024 * 3072; jb.dst = (bf16_t*)(ws + OFF_AIN + (size_t)i * 6 * MB);
    jb.gain = p.norm1_g + (i == 0 ? 0 : 3) * 1024; jb.K = 1024; jb.N = 3072; jb.NP = 3072;
  } else if (j < 12) {
    int i = j - 10;
    jb.src = p.a_w_out + (size_t)i * 1024 * 1024; jb.dst = (bf16_t*)(ws + OFF_AOUT + (size_t)i * 2 * MB);
    jb.gain = nullptr; jb.K = 1024; jb.N = 1024; jb.NP = 1024;
  } else if (j < 16) {
    int g = j - 12;
    jb.src = p.b_w + (size_t)g * 65536; jb.dst = (bf16_t*)(ws + OFF_BW) + (size_t)g * 65536;
    jb.gain = p.norm1_g + 1024 + g * 256; jb.K = 256; jb.N = 256; jb.NP = 256;
  } else if (j == 16) {
    jb.src = p.c_w_in; jb.dst = (bf16_t*)(ws + OFF_CIN);
    jb.gain = p.norm1_g + 2 * 1024; jb.K = 1024; jb.N = 2120; jb.NP = 2304;
  } else {
    jb.src = p.c_w_out; jb.dst = (bf16_t*)(ws + OFF_COUT);
    jb.gain = nullptr; jb.K = 1024; jb.N = 1024; jb.NP = 1024;
  }
  return jb;
}
constexpr int NJOBS = 18;

DEVI void convert_phase(const Params& p, char* smem) {
  const int tid = otid();
  float* t = (float*)smem;
  int total = 0;
  for (int j = 0; j < NJOBS; j++) { Job jb = get_job(p, j); total += (jb.K / 64) * (jb.NP / 64); }
  const int vb = vblk(), nvb = nvblk();
  Job jb; int k0 = 0, n0 = 0; bool act;
  f32x4 vc[4], vn[4];
#define CV_LOCATE(TILE, JB, K0, N0, ACT)                                                 \
  { ACT = (TILE) < total;                                              \
    int rem = ACT ? (TILE) : 0, j = 0;                                                   \
    JB = get_job(p, 0);                                                                  \
    for (;;) { int nt = (JB.K / 64) * (JB.NP / 64); if (rem < nt) break; rem -= nt; j++; JB = get_job(p, j); } \
    const int ntn = JB.NP / 64;                                                          \
    K0 = (rem / ntn) * 64; N0 = (rem % ntn) * 64; }
#define CV_LOAD(V, JB, K0, N0, ACT)                                                      \
  _Pragma("unroll") for (int i = 0; i < 4; i++) {                                        \
    const int kk = (tid >> 4) + 16 * i, n = (N0) + (tid & 15) * 4;                       \
    V[i] = f32x4{0.f, 0.f, 0.f, 0.f};                                                    \
    if ((ACT) && n < JB.N) V[i] = *(const f32x4*)(JB.src + (size_t)((K0) + kk) * JB.N + n); }
  CV_LOCATE(vb, jb, k0, n0, act)
  CV_LOAD(vc, jb, k0, n0, act)
  for (int base = 0; base < total; base += nvb) {
    if (act) {
#pragma unroll
      for (int i = 0; i < 4; i++) {
        const int kk = (tid >> 4) + 16 * i, nn = (tid & 15) * 4;
        t[kk * 65 + nn + 0] = vc[i].x; t[kk * 65 + nn + 1] = vc[i].y; t[kk * 65 + nn + 2] = vc[i].z; t[kk * 65 + nn + 3] = vc[i].w;
      }
    }
    Job jbn; int k0n = 0, n0n = 0; bool actn;
    CV_LOCATE(base + nvb + vb, jbn, k0n, n0n, actn)
    CV_LOAD(vn, jbn, k0n, n0n, actn)
    __syncthreads();
    if (act) {
      const int nl = tid >> 2, kq = tid & 3;
      unsigned pk[8];
#pragma unroll
      for (int i = 0; i < 8; i++) {
        int k = kq * 16 + 2 * i;
        float a = t[k * 65 + nl], b = t[(k + 1) * 65 + nl];
        if (jb.gain) { a *= jb.gain[k0 + k]; b *= jb.gain[k0 + k + 1]; }
        pk[i] = pack2(a, b);
      }
      u32x4* d = (u32x4*)(jb.dst + (size_t)(n0 + nl) * jb.K + k0 + kq * 16);
      d[0] = u32x4{pk[0], pk[1], pk[2], pk[3]};
      d[1] = u32x4{pk[4], pk[5], pk[6], pk[7]};
    }
    __syncthreads();
    jb = jbn; k0 = k0n; n0 = n0n; act = actn;
#pragma unroll
    for (int i = 0; i < 4; i++) vc[i] = vn[i];
  }
#undef CV_LOCATE
#undef CV_LOAD
  bf16_t* hb = (bf16_t*)(p.ws + OFF_HB);
  float* ssqp = (float*)(p.ws + OFF_SSQ);
  {
    const int lane = tid & 63, wv = tid >> 6;
    for (int row = vb * 4 + wv; row < T_TOK; row += nvb * 4) {
      const float* xr = p.x + (size_t)row * DM;
      float ssum = 0.f;
#pragma unroll
      for (int i = 0; i < 2; i++) {
        const int c = i * 512 + lane * 8;
        f32x4 a = *(const f32x4*)(xr + c), b = *(const f32x4*)(xr + c + 4);
        ssum += a.x * a.x + a.y * a.y + a.z * a.z + a.w * a.w + b.x * b.x + b.y * b.y + b.z * b.z + b.w * b.w;
        *(u32x4*)(hb + (size_t)row * DM + c) = u32x4{pack2(a.x, a.y), pack2(a.z, a.w), pack2(b.x, b.y), pack2(b.z, b.w)};
      }
#pragma unroll
      for (int o = 32; o >= 1; o >>= 1) ssum += __shfl_xor(ssum, o);
      if (lane < 16) ssqp[(size_t)row * 16 + lane] = (lane == 0) ? ssum : 0.f;
    }
  }
}

DEVI void wave_put_bf16(char* wbuf, const int ml, const int nt, const int q4, const int lh, const u32x2 v) {
  const int chunk = nt * 4 + q4;
  *(u32x2*)(wbuf + ml * 128 + ((chunk ^ (ml & 7)) << 4) + 8 * lh) = v;
}
DEVI void wave_flush_bf16(char* wbuf, bf16_t* dst, const int stride, const int lane) {
  const int c = lane & 7;
#pragma unroll
  for (int i = 0; i < 8; i++) {
    const int row = i * 8 + (lane >> 3);
    const u32x4 v = *(const u32x4*)(wbuf + row * 128 + ((c ^ (row & 7)) << 4));
    *(u32x4*)(dst + (size_t)row * stride + c * 8) = v;
  }
}

enum { M_AQKV = 0, M_CIN = 1, M_RESID = 2, M_MLP1 = 3, M_POOL = 4 };

struct GemmArgs {
  const bf16_t* A; int lda; const bf16_t* Bt; int K; int NT;
  void* o0; void* o1; void* o2; void* o3; void* o4; void* o5;
  const float* g0; const float* g1; const float* resid; float* ssq;
};

template <int MODE, int KC>
DEVI void gemm_phase(const GemmArgs& ga, char* smem) {
  constexpr bool NORM = (MODE == M_AQKV || MODE == M_CIN || MODE == M_MLP1);
  const int tid = otid512(), lane = tid & 63, w = tid >> 6;
  const int wn = w & 3, wm = w >> 2;
  const int l31 = lane & 31, lh = lane >> 5;
  float* rs_lds = (float*)(smem + 131072);
  float* xch = (float*)(smem + 131072 + 1024);
  constexpr int K = KC;
  constexpr int KT = K / 64;
  const int NT256 = ga.NT;
  const int ntiles = (T_TOK / 256) * NT256;
  for (int tile = blockIdx.x; tile < ntiles; tile += gridDim.x) {
    const int tn256 = tile % NT256, tm = tile / NT256;
    const int m0 = tm * 256;
    const bf16_t* Ab = ga.A + (size_t)m0 * ga.lda + (MODE == M_POOL ? tn256 * 256 : 0);
    const bf16_t* Bb = ga.Bt + (size_t)tn256 * 256 * K;
    f32x16 acc[2][4];
#pragma unroll
    for (int a = 0; a < 2; a++)
#pragma unroll
      for (int b = 0; b < 4; b++)
#pragma unroll
        for (int r = 0; r < 16; r++) acc[a][b][r] = 0.f;
    u32x4 rw0[4], rx0[4];
    int ttid = tid;
    asm volatile("" : "+v"(ttid));
    const int ldsb = lds_off<128>(ttid >> 3, ttid & 7);
    const unsigned woff0 = (unsigned)((ttid >> 3) * K + (ttid & 7) * 8) * 2u;
    const unsigned xoff0 = (unsigned)((ttid >> 3) * ga.lda + (ttid & 7) * 8) * 2u;
#define G_LOAD(RW, RX, KTI)                                                              \
  _Pragma("unroll") for (int j = 0; j < 4; j++) {                                        \
    RW[j] = *(const u32x4*)((const char*)Bb + (size_t)(KTI) * 128 + (size_t)j * 64 * K * 2 + woff0);            \
    RX[j] = *(const u32x4*)((const char*)Ab + (size_t)(KTI) * 128 + (size_t)j * 64 * ga.lda * 2 + xoff0);      \
  }
#define G_STORE(RW, RX, S)                                                               \
  _Pragma("unroll") for (int j = 0; j < 4; j++) {                                        \
    *(u32x4*)(smem + (S) * 32768 + ldsb + j * 8192) = RW[j];            \
    *(u32x4*)(smem + 65536 + (S) * 32768 + ldsb + j * 8192) = RX[j];                     \
  }
#define G_COMPUTE_KS(S, KS0, KS1)                                                        \
  _Pragma("unroll") for (int ks = KS0; ks < KS1; ks++) {                                 \
    bf16x8 wf[2], xf[4];                                                                 \
    _Pragma("unroll") for (int nt = 0; nt < 2; nt++)                                     \
      wf[nt] = *(const bf16x8*)(smem + (S) * 32768 + lds_off<128>(wn * 64 + nt * 32 + l31, 2 * ks + lh)); \
    _Pragma("unroll") for (int mt = 0; mt < 4; mt++)                                     \
      xf[mt] = *(const bf16x8*)(smem + 65536 + (S) * 32768 + lds_off<128>(wm * 128 + mt * 32 + l31, 2 * ks + lh)); \
    _Pragma("unroll") for (int nt = 0; nt < 2; nt++)                                     \
      _Pragma("unroll") for (int mt = 0; mt < 4; mt++) acc[nt][mt] = mfma32(wf[nt], xf[mt], acc[nt][mt]); \
  }
#define G_HALF(S, KSI, MP)                                                               \
  { bf16x8 wf[2], xf[2];                                                                 \
    _Pragma("unroll") for (int nt = 0; nt < 2; nt++)                                     \
      wf[nt] = *(const bf16x8*)(smem + (S) * 32768 + lds_off<128>(wn * 64 + nt * 32 + l31, 2 * (KSI) + lh)); \
    _Pragma("unroll") for (int mt = 0; mt < 2; mt++)                                     \
      xf[mt] = *(const bf16x8*)(smem + 65536 + (S) * 32768 + lds_off<128>(wm * 128 + (2 * (MP) + mt) * 32 + l31, 2 * (KSI) + lh)); \
    _Pragma("unroll") for (int nt = 0; nt < 2; nt++)                                     \
      _Pragma("unroll") for (int mt = 0; mt < 2; mt++) acc[nt][2 * (MP) + mt] = mfma32(wf[nt], xf[mt], acc[nt][2 * (MP) + mt]); }
#define G_ST2(RW, RX, S, A)                                                              \
  { *(u32x4*)(smem + (S) * 32768 + ldsb + (A) * 8192) = RW[A];                           \
    *(u32x4*)(smem + 65536 + (S) * 32768 + ldsb + (A) * 8192) = RX[A]; }
    G_LOAD(rw0, rx0, 0)
    G_STORE(rw0, rx0, 0)
    __syncthreads();
    if (NORM) {
      if (tid < 256) {
        const f32x4* sp = (const f32x4*)(ga.ssq + (size_t)(m0 + tid) * 16);
        const f32x4 a = sp[0], b = sp[1], c = sp[2], d = sp[3];
        const float tot = (a.x + a.y + a.z + a.w) + (b.x + b.y + b.z + b.w) + (c.x + c.y + c.z + c.w) + (d.x + d.y + d.z + d.w);
        rs_lds[tid] = rsqrtf(tot * (1.f / 1024.f) + EPS);
      }
    }
#pragma unroll 1
    for (int kt = 0; kt < KT; kt += 2) {
      const bool more = (kt + 2 < KT);
      G_LOAD(rw0, rx0, kt + 1)
      asm volatile("" ::: "memory");
      G_COMPUTE_KS(0, 0, 2)
      G_ST2(rw0, rx0, 1, 0)
      G_HALF(0, 2, 0)
      G_ST2(rw0, rx0, 1, 1)
      G_HALF(0, 2, 1)
      G_ST2(rw0, rx0, 1, 2)
      G_HALF(0, 3, 0)
      G_ST2(rw0, rx0, 1, 3)
      G_HALF(0, 3, 1)
      __syncthreads();
      if (more) { G_LOAD(rw0, rx0, kt + 2) }
      asm volatile("" ::: "memory");
      G_COMPUTE_KS(1, 0, 2)
      if (more) { G_ST2(rw0, rx0, 0, 0) }
      G_HALF(1, 2, 0)
      if (more) { G_ST2(rw0, rx0, 0, 1) }
      G_HALF(1, 2, 1)
      if (more) { G_ST2(rw0, rx0, 0, 2) }
      G_HALF(1, 3, 0)
      if (more) { G_ST2(rw0, rx0, 0, 3) }
      G_HALF(1, 3, 1)
      __syncthreads();
    }
#undef G_LOAD
#undef G_STORE
#undef G_COMPUTE_KS
#undef G_HALF
#undef G_ST2
    float rstd[4] = {1.f, 1.f, 1.f, 1.f};
    if (NORM) {
#pragma unroll
      for (int mt = 0; mt < 4; mt++) rstd[mt] = rs_lds[wm * 128 + mt * 32 + l31];
    }
    int el31 = l31, elh = lh, ewn = wn & 1, ewm = wm, elane = lane, ewq = wn >> 1, eww = w;
    asm volatile("" : "+v"(el31), "+v"(elh), "+v"(ewn), "+v"(ewm), "+v"(elane), "+v"(ewq), "+v"(eww));
    const int tn = tn256 * 2 + __builtin_amdgcn_readfirstlane(ewq);
    const int n0 = tn * 128;
    char* wbuf = smem + eww * 16384;
    const int mw0 = m0 + ewm * 128;
    if (MODE == M_AQKV) {
      const int nw = n0 + ewn * 64;
      if (n0 < 2048) {
        const float* g = (n0 < 1024) ? ga.g0 : ga.g1;
        const float post = (n0 < 1024) ? (0.125f * LOG2E) : 1.f;
#pragma unroll
        for (int h = 0; h < 2; h++) {
#pragma unroll
          for (int mh = 0; mh < 2; mh++) {
            const int mt = 2 * h + mh;
            float s = 0.f;
#pragma unroll
            for (int nt = 0; nt < 2; nt++)
#pragma unroll
              for (int r = 0; r < 16; r++) { float v = acc[nt][mt][r] * rstd[mt]; acc[nt][mt][r] = v; s += v * v; }
            s += __shfl_xor(s, 32);
            const float hn = rsqrtf(s * (1.f / 64.f) + EPS) * post;
#pragma unroll
            for (int nt = 0; nt < 2; nt++)
#pragma unroll
              for (int q4 = 0; q4 < 4; q4++) {
                const int d = nt * 32 + 8 * q4 + 4 * elh;
                const f32x4 gv = *(const f32x4*)(g + d);
                { u32x2 pv; pv.x = pack2(acc[nt][mt][4 * q4 + 0] * hn * gv.x, acc[nt][mt][4 * q4 + 1] * hn * gv.y); pv.y = pack2(acc[nt][mt][4 * q4 + 2] * hn * gv.z, acc[nt][mt][4 * q4 + 3] * hn * gv.w); wave_put_bf16(wbuf, mh * 32 + el31, nt, q4, elh, pv); }
              }
          }
          wave_flush_bf16(wbuf, (bf16_t*)ga.o0 + (size_t)(mw0 + h * 64) * 2048 + nw, 2048, elane);
        }
      } else {
        bf16_t* vt = (bf16_t*)ga.o1;
        const int nn = nw - 2048, head = nn >> 7, e0 = nn & 127;
#pragma unroll
        for (int mt = 0; mt < 4; mt++) {
          const int m = mw0 + mt * 32 + el31;
          const int b = m >> 12, s = m & 4095;
          bf16_t* vp = vt + ((size_t)(b * 8 + head) * 128 + e0 + 4 * elh) * 4096 + s;
          asm volatile("" : "+v"(vp));
#pragma unroll
          for (int nt = 0; nt < 2; nt++)
#pragma unroll
            for (int r = 0; r < 16; r++)
              vp[(size_t)(nt * 32 + (r & 3) + 8 * (r >> 2)) * 4096] = f2bf(acc[nt][mt][r] * rstd[mt]);
        }
      }
    } else if (MODE == M_CIN) {
      if (tn < 10) {
#pragma unroll
        for (int mt = 0; mt < 4; mt++) {
          float s = 0.f;
#pragma unroll
          for (int nt = 0; nt < 2; nt++)
#pragma unroll
            for (int r = 0; r < 16; r++) { float v = acc[nt][mt][r] * rstd[mt]; acc[nt][mt][r] = v; s += v * v; }
          s += __shfl_xor(s, 32);
          if (elh == 0) xch[(ewq * 2 + ewn) * 256 + ewm * 128 + mt * 32 + el31] = s;
        }
        __syncthreads();
        const float* g = (tn < 8) ? ga.g0 : ga.g1;
        const float post = (tn < 8) ? (0.08838834764831845f * LOG2E) : 1.f;
#pragma unroll
        for (int h = 0; h < 2; h++) {
#pragma unroll
          for (int mh = 0; mh < 2; mh++) {
            const int mt = 2 * h + mh;
            const int ml = ewm * 128 + mt * 32 + el31;
            const float tot = xch[(ewq * 2) * 256 + ml] + xch[(ewq * 2 + 1) * 256 + ml];
            const float hn = rsqrtf(tot * (1.f / 128.f) + EPS) * post;
#pragma unroll
            for (int nt = 0; nt < 2; nt++)
#pragma unroll
              for (int q4 = 0; q4 < 4; q4++) {
                const int d = ewn * 64 + nt * 32 + 8 * q4 + 4 * elh;
                const f32x4 gv = *(const f32x4*)(g + d);
                { u32x2 pv; pv.x = pack2(acc[nt][mt][4 * q4 + 0] * hn * gv.x, acc[nt][mt][4 * q4 + 1] * hn * gv.y); pv.y = pack2(acc[nt][mt][4 * q4 + 2] * hn * gv.z, acc[nt][mt][4 * q4 + 3] * hn * gv.w); wave_put_bf16(wbuf, mh * 32 + el31, nt, q4, elh, pv); }
              }
          }
          if (tn < 8) wave_flush_bf16(wbuf, (bf16_t*)ga.o0 + (size_t)(mw0 + h * 64) * 1024 + tn * 128 + ewn * 64, 1024, elane);
          else wave_flush_bf16(wbuf, (bf16_t*)ga.o1 + (size_t)(mw0 + h * 64) * 256 + (tn - 8) * 128 + ewn * 64, 256, elane);
        }
      } else if (tn < 12) {
        bf16_t* vt = (bf16_t*)ga.o2;
        const int g = tn - 10;
#pragma unroll
        for (int mt = 0; mt < 4; mt++) {
          const int m = mw0 + mt * 32 + el31;
          const int b = m >> 12, s = m & 4095;
          bf16_t* vp = vt + ((size_t)(b * 2 + g) * 128 + ewn * 64 + 4 * elh) * 4096 + s;
          asm volatile("" : "+v"(vp));
#pragma unroll
          for (int nt = 0; nt < 2; nt++)
#pragma unroll
            for (int r = 0; r < 16; r++)
              vp[(size_t)(nt * 32 + (r & 3) + 8 * (r >> 2)) * 4096] = f2bf(acc[nt][mt][r] * rstd[mt]);
        }
      } else {
        if (tn < 16 || (tn == 16 && ewn == 0)) {
#pragma unroll
          for (int h = 0; h < 2; h++) {
  #pragma unroll
            for (int mh = 0; mh < 2; mh++) {
              const int mt = 2 * h + mh;
#pragma unroll
              for (int nt = 0; nt < 2; nt++)
#pragma unroll
                for (int q4 = 0; q4 < 4; q4++) {
                  { u32x2 pv; pv.x = pack2(acc[nt][mt][4 * q4 + 0] * rstd[mt], acc[nt][mt][4 * q4 + 1] * rstd[mt]); pv.y = pack2(acc[nt][mt][4 * q4 + 2] * rstd[mt], acc[nt][mt][4 * q4 + 3] * rstd[mt]); wave_put_bf16(wbuf, mh * 32 + el31, nt, q4, elh, pv); }
                }
            }
            if (tn < 16) wave_flush_bf16(wbuf, (bf16_t*)ga.o3 + (size_t)(mw0 + h * 64) * 512 + (tn - 12) * 128 + ewn * 64, 512, elane);
            else wave_flush_bf16(wbuf, (bf16_t*)ga.o4 + (size_t)(mw0 + h * 64) * 64, 64, elane);
          }
        } else if (tn == 16) {
          float* iw = (float*)ga.o5;
          const float sc = 0.35355339059327373f * 0.125f;
#pragma unroll
          for (int mt = 0; mt < 4; mt++) {
            const int m = mw0 + mt * 32 + el31;
            f32x4 o;
            o.x = acc[0][mt][0] * rstd[mt] * sc; o.y = acc[0][mt][1] * rstd[mt] * sc;
            o.z = acc[0][mt][2] * rstd[mt] * sc; o.w = acc[0][mt][3] * rstd[mt] * sc;
            *(f32x4*)(iw + (size_t)m * 8 + 4 * elh) = o;
          }
        }
      }
    } else if (MODE == M_RESID || MODE == M_POOL) {
      float* ho = (float*)ga.o0;
      bf16_t* hb = (bf16_t*)ga.o1;
      const int cch = elane & 15;
      const int n = n0 + ewn * 64 + cch * 4;
      f32x4 cs = f32x4{1.f, 1.f, 1.f, 1.f};
      if (MODE == M_POOL) cs = *(const f32x4*)(ga.g0 + n);
#pragma unroll
      for (int h = 0; h < 2; h++) {
#pragma unroll
        for (int mh = 0; mh < 2; mh++) {
          const int mt = 2 * h + mh;
          const int ml = mh * 32 + el31;
#pragma unroll
          for (int nt = 0; nt < 2; nt++)
#pragma unroll
            for (int q4 = 0; q4 < 4; q4++) {
              const int chunk = nt * 8 + 2 * q4 + elh;
              f32x4 v; v.x = acc[nt][mt][4 * q4 + 0]; v.y = acc[nt][mt][4 * q4 + 1]; v.z = acc[nt][mt][4 * q4 + 2]; v.w = acc[nt][mt][4 * q4 + 3];
              *(f32x4*)(wbuf + ml * 256 + ((chunk ^ (ml & 15)) << 4)) = v;
            }
        }
#pragma unroll 4
        for (int i = 0; i < 16; i++) {
          const int row = i * 4 + (elane >> 4);
          const int m = mw0 + h * 64 + row;
          const f32x4 a = *(const f32x4*)(wbuf + row * 256 + ((cch ^ (row & 15)) << 4));
          const f32x4 rv = *(const f32x4*)(ga.resid + (size_t)m * 1024 + n);
          f32x4 o;
          o.x = rv.x + a.x * cs.x; o.y = rv.y + a.y * cs.y; o.z = rv.z + a.z * cs.z; o.w = rv.w + a.w * cs.w;
          *(f32x4*)(ho + (size_t)m * 1024 + n) = o;
          u32x2 ob; ob.x = pack2(o.x, o.y); ob.y = pack2(o.z, o.w);
          *(u32x2*)(hb + (size_t)m * 1024 + n) = ob;
          float sq = o.x * o.x + o.y * o.y + o.z * o.z + o.w * o.w;
          sq += __shfl_xor(sq, 1); sq += __shfl_xor(sq, 2); sq += __shfl_xor(sq, 4); sq += __shfl_xor(sq, 8);
          if (cch == 0) ga.ssq[(size_t)m * 16 + tn * 2 + ewn] = sq;
        }
      }
    } else if (MODE == M_MLP1) {
#pragma unroll
      for (int h = 0; h < 2; h++) {
#pragma unroll
        for (int mh = 0; mh < 2; mh++) {
          const int mt = 2 * h + mh;
#pragma unroll
          for (int nt = 0; nt < 2; nt++)
#pragma unroll
            for (int q4 = 0; q4 < 4; q4++) {
              const float v0 = fmaxf(acc[nt][mt][4 * q4 + 0] * rstd[mt], 0.f), v1 = fmaxf(acc[nt][mt][4 * q4 + 1] * rstd[mt], 0.f);
              const float v2 = fmaxf(acc[nt][mt][4 * q4 + 2] * rstd[mt], 0.f), v3 = fmaxf(acc[nt][mt][4 * q4 + 3] * rstd[mt], 0.f);
              { u32x2 pv; pv.x = pack2(v0 * v0, v1 * v1); pv.y = pack2(v2 * v2, v3 * v3); wave_put_bf16(wbuf, mh * 32 + el31, nt, q4, elh, pv); }
            }
        }
        wave_flush_bf16(wbuf, (bf16_t*)ga.o0 + (size_t)(mw0 + h * 64) * 4096 + n0 + ewn * 64, 4096, elane);
      }
    }
    __syncthreads();
  }
}

DEVI void grp_barrier(volatile __attribute__((address_space(3))) unsigned* ctr, unsigned& target, const int lane) {
  asm volatile("s_waitcnt vmcnt(0) lgkmcnt(0)" ::: "memory");
  target += 4u;
  if (lane == 0) __hip_atomic_fetch_add((__attribute__((address_space(3))) unsigned*)ctr, 1u, __ATOMIC_RELAXED, __HIP_MEMORY_SCOPE_WORKGROUP);
  while (__hip_atomic_load((__attribute__((address_space(3))) unsigned*)ctr, __ATOMIC_RELAXED, __HIP_MEMORY_SCOPE_WORKGROUP) < target) __builtin_amdgcn_s_sleep(1);
  asm volatile("" ::: "memory");
}

template <int DQK, bool MASKED>
DEVI void flash_qtile(const bf16_t* __restrict__ qrow, const bf16_t* __restrict__ Kb, const int kstride,
                      const bf16_t* __restrict__ Vt, const u64* __restrict__ mrow, const int qt,
                      char* smem, f32x16 (&O)[4], const float negc0,
                      volatile __attribute__((address_space(3))) unsigned* gctr, unsigned& gtarget) {
  constexpr int KROWB = DQK * 2;
  constexpr int KS = DQK / 16;
  constexpr int KBYTES = 64 * KROWB;
  constexpr int STAGE = KBYTES + 16384;
  constexpr int KI = KBYTES / 4096;
  const int tid = otid(), lane = tid & 63, w = tid >> 6;
  const int l31 = lane & 31, lh = lane >> 5;
  unsigned kgo[KI], vgo[4];
#pragma unroll
  for (int i = 0; i < KI; i++) {
    const int blk = i * 4 + w;
    int row, kc;
    if (DQK == 64) { row = blk * 8 + (lane >> 3); kc = (lane & 7) ^ ((row >> 1) & 7); }
    else { row = blk * 4 + (lane >> 4); kc = (lane & 15) ^ (row & 15); }
    kgo[i] = (unsigned)(row * kstride + kc * 8) * 2u;
  }
#pragma unroll
  for (int i = 0; i < 4; i++) {
    const int blk = i * 4 + w;
    const int row = blk * 8 + (lane >> 3);
    const int kc = (lane & 7) ^ ((row >> 1) & 7);
    vgo[i] = (unsigned)(row * 4096 + kc * 8) * 2u;
  }
  bf16x8 qf[KS];
#pragma unroll
  for (int ks = 0; ks < KS; ks++) qf[ks] = *(const bf16x8*)(qrow + 16 * ks + 8 * lh);
#pragma unroll
  for (int eb = 0; eb < 4; eb++)
#pragma unroll
    for (int r = 0; r < 16; r++) O[eb][r] = 0.f;
  float lsum = 0.f;
  const int ntile = 2 * qt + 2;
  const int mylast = 2 * qt + (w >> 1);
  u64 mw_next = 0ull;
  if (MASKED) mw_next = mrow[0];
  grp_barrier(gctr, gtarget, lane);
  {
    const char* kt = (const char*)Kb;
    const char* vtp = (const char*)Vt;
#pragma unroll
    for (int i = 0; i < KI; i++)
      __builtin_amdgcn_global_load_lds((const unsigned*)(kt + kgo[i]), (__attribute__((address_space(3))) unsigned*)(smem + (i * 4 + w) * 1024), 16, 0, 0);
#pragma unroll
    for (int i = 0; i < 4; i++)
      __builtin_amdgcn_global_load_lds((const unsigned*)(vtp + vgo[i]), (__attribute__((address_space(3))) unsigned*)(smem + KBYTES + (i * 4 + w) * 1024), 16, 0, 0);
  }
  grp_barrier(gctr, gtarget, lane);
  for (int j = 0; j < ntile; j++) {
    const char* st = smem + (j & 1) * STAGE;
    const bool more = (j + 1 < ntile);
    if (more) {
      const char* kt = (const char*)Kb + (size_t)(j + 1) * 64 * kstride * 2;
      const char* vtp = (const char*)Vt + (size_t)(j + 1) * 64 * 2;
      char* sn = smem + ((j + 1) & 1) * STAGE;
#pragma unroll
      for (int i = 0; i < KI; i++) {
        unsigned off = kgo[i];
        asm volatile("" : "+v"(off));
        __builtin_amdgcn_global_load_lds((const unsigned*)(kt + off), (__attribute__((address_space(3))) unsigned*)(sn + (i * 4 + w) * 1024), 16, 0, 0);
      }
#pragma unroll
      for (int i = 0; i < 4; i++) {
        unsigned off = vgo[i];
        asm volatile("" : "+v"(off));
        __builtin_amdgcn_global_load_lds((const unsigned*)(vtp + off), (__attribute__((address_space(3))) unsigned*)(sn + KBYTES + (i * 4 + w) * 1024), 16, 0, 0);
      }
    }
    const u64 mw = mw_next;
    if (MASKED && more) mw_next = mrow[j + 1];
    if (j <= mylast) {
      f32x16 S[2];
#pragma unroll
      for (int mt = 0; mt < 2; mt++)
#pragma unroll
        for (int r = 0; r < 16; r++) S[mt][r] = negc0;
#pragma unroll
      for (int ks = 0; ks < KS; ks++)
#pragma unroll
        for (int mt = 0; mt < 2; mt++) {
          bf16x8 kf = *(const bf16x8*)(st + lds_off<KROWB>(mt * 32 + l31, 2 * ks + lh));
          S[mt] = mfma32(kf, qf[ks], S[mt]);
        }
      unsigned wlo = 0xffffffffu, whi = 0xffffffffu;
      if (MASKED) {
        wlo = ((unsigned)mw) >> (4 * lh);
        whi = ((unsigned)(mw >> 32)) >> (4 * lh);
      }
      float ps = 0.f;
#pragma unroll
      for (int mt = 0; mt < 2; mt++)
#pragma unroll
        for (int r = 0; r < 16; r++) {
          float pv = fexp2(S[mt][r]);
          if (MASKED) {
            const unsigned wd = mt ? whi : wlo;
            pv = ((wd >> ((r & 3) + 8 * (r >> 2))) & 1u) ? pv : 0.f;
          }
          S[mt][r] = pv;
          ps += pv;
        }
      lsum += ps;
#pragma unroll
      for (int kb = 0; kb < 2; kb++)
#pragma unroll
        for (int s = 0; s < 2; s++) {
          u32x4 pfu;
          pfu.x = pack2(S[kb][8 * s + 0], S[kb][8 * s + 1]);
          pfu.y = pack2(S[kb][8 * s + 2], S[kb][8 * s + 3]);
          pfu.z = pack2(S[kb][8 * s + 4], S[kb][8 * s + 5]);
          pfu.w = pack2(S[kb][8 * s + 6], S[kb][8 * s + 7]);
          const bf16x8 pfv = __builtin_bit_cast(bf16x8, pfu);
#pragma unroll
          for (int eb = 0; eb < 4; eb++) {
            const int row = eb * 32 + l31;
            const u32x2 h0 = *(const u32x2*)(st + KBYTES + lds_off<128>(row, 4 * kb + 2 * s) + 8 * lh);
            const u32x2 h1 = *(const u32x2*)(st + KBYTES + lds_off<128>(row, 4 * kb + 2 * s + 1) + 8 * lh);
            const u32x4 vfu = u32x4{h0.x, h0.y, h1.x, h1.y};
            O[eb] = mfma32(__builtin_bit_cast(bf16x8, vfu), pfv, O[eb]);
          }
        }
    }
    grp_barrier(gctr, gtarget, lane);
  }
  float lt = lsum + __shfl_xor(lsum, 32);
  const float inv = 1.f / lt;
#pragma unroll
  for (int eb = 0; eb < 4; eb++)
#pragma unroll
    for (int r = 0; r < 16; r++) O[eb][r] *= inv;
}

DEVI void flash_qtile_pipe(const bf16_t* __restrict__ qrow, const bf16_t* __restrict__ Kb, const int kstride,
                           const bf16_t* __restrict__ Vt, const int qt,
                           char* smem, f32x16 (&O)[4], const float negc0,
                           volatile __attribute__((address_space(3))) unsigned* gctr, unsigned& gtarget) {
  constexpr int KBYTES = 64 * 128;
  constexpr int STAGE = KBYTES + 16384;
  const int tid = otid(), lane = tid & 63, w = tid >> 6;
  const int l31 = lane & 31, lh = lane >> 5;
  unsigned kgo[2], vgo[4];
#pragma unroll
  for (int i = 0; i < 2; i++) {
    const int blk = i * 4 + w;
    const int row = blk * 8 + (lane >> 3);
    const int kc = (lane & 7) ^ ((row >> 1) & 7);
    kgo[i] = (unsigned)(row * kstride + kc * 8) * 2u;
  }
#pragma unroll
  for (int i = 0; i < 4; i++) {
    const int blk = i * 4 + w;
    const int row = blk * 8 + (lane >> 3);
    const int kc = (lane & 7) ^ ((row >> 1) & 7);
    vgo[i] = (unsigned)(row * 4096 + kc * 8) * 2u;
  }
  bf16x8 qf[4];
#pragma unroll
  for (int ks = 0; ks < 4; ks++) qf[ks] = *(const bf16x8*)(qrow + 16 * ks + 8 * lh);
#pragma unroll
  for (int eb = 0; eb < 4; eb++)
#pragma unroll
    for (int r = 0; r < 16; r++) O[eb][r] = 0.f;
  float lsum = 0.f;
  const int ntile = 2 * qt + 2;
  const int mylast = 2 * qt + (w >> 1);
#define FP_DMA_K(T, STG)                                                                              \
  { const char* kt = (const char*)Kb + (size_t)(T) * 64 * kstride * 2;                                \
    _Pragma("unroll") for (int i = 0; i < 2; i++) {                                                   \
      unsigned off = kgo[i]; asm volatile("" : "+v"(off));                                            \
      __builtin_amdgcn_global_load_lds((const unsigned*)(kt + off), (__attribute__((address_space(3))) unsigned*)(smem + (STG) * STAGE + (i * 4 + w) * 1024), 16, 0, 0); } }
#define FP_DMA_V(T, STG)                                                                              \
  { const char* vtp = (const char*)Vt + (size_t)(T) * 64 * 2;                                         \
    _Pragma("unroll") for (int i = 0; i < 4; i++) {                                                   \
      unsigned off = vgo[i]; asm volatile("" : "+v"(off));                                            \
      __builtin_amdgcn_global_load_lds((const unsigned*)(vtp + off), (__attribute__((address_space(3))) unsigned*)(smem + (STG) * STAGE + KBYTES + (i * 4 + w) * 1024), 16, 0, 0); } }
#define FP_QK(SX, STG)                                                                                \
  { _Pragma("unroll") for (int mt = 0; mt < 2; mt++)                                                  \
      _Pragma("unroll") for (int r = 0; r < 16; r++) SX[mt][r] = negc0;                               \
    _Pragma("unroll") for (int ks = 0; ks < 4; ks++)                                                  \
      _Pragma("unroll") for (int mt = 0; mt < 2; mt++) {                                              \
        bf16x8 kf = *(const bf16x8*)(smem + (STG) * STAGE + lds_off<128>(mt * 32 + l31, 2 * ks + lh)); \
        SX[mt] = mfma32(kf, qf[ks], SX[mt]); } }
#define FP_SMPV(SX, STG)                                                                              \
  { float ps = 0.f;                                                                                   \
    _Pragma("unroll") for (int mt = 0; mt < 2; mt++)                                                  \
      _Pragma("unroll") for (int r = 0; r < 16; r++) { const float pv = fexp2(SX[mt][r]); SX[mt][r] = pv; ps += pv; } \
    lsum += ps;                                                                                       \
    _Pragma("unroll") for (int kb = 0; kb < 2; kb++)                                                  \
      _Pragma("unroll") for (int s = 0; s < 2; s++) {                                                 \
        u32x4 pfu;                                                                                    \
        pfu.x = pack2(SX[kb][8 * s + 0], SX[kb][8 * s + 1]);                                          \
        pfu.y = pack2(SX[kb][8 * s + 2], SX[kb][8 * s + 3]);                                          \
        pfu.z = pack2(SX[kb][8 * s + 4], SX[kb][8 * s + 5]);                                          \
        pfu.w = pack2(SX[kb][8 * s + 6], SX[kb][8 * s + 7]);                                          \
        const bf16x8 pfv = __builtin_bit_cast(bf16x8, pfu);                                           \
        _Pragma("unroll") for (int eb = 0; eb < 4; eb++) {                                            \
          const int row = eb * 32 + l31;                                                              \
          const u32x2 h0 = *(const u32x2*)(smem + (STG) * STAGE + KBYTES + lds_off<128>(row, 4 * kb + 2 * s) + 8 * lh);     \
          const u32x2 h1 = *(const u32x2*)(smem + (STG) * STAGE + KBYTES + lds_off<128>(row, 4 * kb + 2 * s + 1) + 8 * lh); \
          const u32x4 vfu = u32x4{h0.x, h0.y, h1.x, h1.y};                                            \
          O[eb] = mfma32(__builtin_bit_cast(bf16x8, vfu), pfv, O[eb]); } } }
#define FP_STEP(J, SCUR, SNEXT, STG)                                                                  \
  { if ((J) + 2 < ntile) FP_DMA_K((J) + 2, STG)                                                       \
    if ((J) + 1 < ntile) FP_DMA_V((J) + 1, (STG) ^ 1)                                                 \
    if ((J) + 1 <= mylast) FP_QK(SNEXT, (STG) ^ 1)                                                    \
    if ((J) <= mylast) FP_SMPV(SCUR, STG)                                                             \
    grp_barrier(gctr, gtarget, lane); }
  f32x16 SA[2], SB[2];
  grp_barrier(gctr, gtarget, lane);
  FP_DMA_K(0, 0)
  FP_DMA_V(0, 0)
  FP_DMA_K(1, 1)
  grp_barrier(gctr, gtarget, lane);
  FP_QK(SA, 0)
  grp_barrier(gctr, gtarget, lane);
#pragma unroll
  for (int mt = 0; mt < 2; mt++)
#pragma unroll
    for (int r = 0; r < 16; r++) SB[mt][r] = 0.f;
  for (int j = 0; j < ntile; j += 2) {
    FP_STEP(j, SA, SB, 0)
    FP_STEP(j + 1, SB, SA, 1)
  }
#undef FP_DMA_K
#undef FP_DMA_V
#undef FP_QK
#undef FP_SMPV
#undef FP_STEP
  float lt = lsum + __shfl_xor(lsum, 32);
  const float inv = 1.f / lt;
#pragma unroll
  for (int eb = 0; eb < 4; eb++)
#pragma unroll
    for (int r = 0; r < 16; r++) O[eb][r] *= inv;
}

DEVI void attnA_phase(const Params& p, int jl, float lambda_init, char* smem,
                        volatile __attribute__((address_space(3))) unsigned* gctr, unsigned& gtarget) {
  const int tid = otid(), lane = tid & 63, w = tid >> 6;
  const int l31 = lane & 31, lh = lane >> 5;
  const bf16_t* qk = (const bf16_t*)(p.ws + R_QK);
  const bf16_t* vt = (const bf16_t*)(p.ws + R_VT);
  bf16_t* ao = (bf16_t*)(p.ws + R_AO);
  float s1 = p.a_lq1[jl * 64 + lane] * p.a_lk1[jl * 64 + lane];
  float s2 = p.a_lq2[jl * 64 + lane] * p.a_lk2[jl * 64 + lane];
#pragma unroll
  for (int o = 32; o >= 1; o >>= 1) { s1 += __shfl_xor(s1, o); s2 += __shfl_xor(s2, o); }
  const float lam = expf(s1) - expf(s2) + lambda_init;
  float gq = fabsf(p.a_q_g[jl * 64 + lane]), gk = fabsf(p.a_k_g[jl * 64 + lane]);
#pragma unroll
  for (int o = 32; o >= 1; o >>= 1) { gq = fmaxf(gq, __shfl_xor(gq, o)); gk = fmaxf(gk, __shfl_xor(gk, o)); }
  const float negc0 = -(8.0f * gq * gk * LOG2E * 1.01f);
  const float* subg = p.a_sub_g + jl * 128;
  for (int item = vblk(); item < 512; item += nvblk()) {
    const int pr = item & 15, h = (item >> 4) & 7, b = item >> 7;
    for (int qi = 0; qi < 2; qi++) {
      const int qt = qi ? pr : (31 - pr);
      const int t = b * SEQ + qt * 128 + w * 32 + l31;
      f32x16 O[4];
      flash_qtile_pipe(qk + (size_t)t * 2048 + h * 128, qk + (size_t)b * SEQ * 2048 + 1024 + h * 128, 2048,
                             vt + (size_t)(b * 8 + h) * 128 * 4096, qt, smem, O, negc0, gctr, gtarget);
#pragma unroll
      for (int eb = 0; eb < 4; eb++)
#pragma unroll
        for (int q4 = 0; q4 < 4; q4++) {
          const int e = eb * 32 + 8 * q4 + 4 * lh;
          u32x2 o;
          o.x = pack2(O[eb][4 * q4 + 0], O[eb][4 * q4 + 1]);
          o.y = pack2(O[eb][4 * q4 + 2], O[eb][4 * q4 + 3]);
          *(u32x2*)(ao + (size_t)t * 1024 + h * 128 + e) = o;
        }
      flash_qtile_pipe(qk + (size_t)t * 2048 + h * 128 + 64, qk + (size_t)b * SEQ * 2048 + 1024 + h * 128 + 64, 2048,
                             vt + (size_t)(b * 8 + h) * 128 * 4096, qt, smem, O, negc0, gctr, gtarget);
      float ssq = 0.f;
#pragma unroll
      for (int eb = 0; eb < 4; eb++)
#pragma unroll
        for (int q4 = 0; q4 < 4; q4++) {
          const int e = eb * 32 + 8 * q4 + 4 * lh;
          const u32x2 o1 = *(const u32x2*)(ao + (size_t)t * 1024 + h * 128 + e);
          const float a0 = bf_lo(o1.x) - lam * O[eb][4 * q4 + 0];
          const float a1 = bf_hi(o1.x) - lam * O[eb][4 * q4 + 1];
          const float a2 = bf_lo(o1.y) - lam * O[eb][4 * q4 + 2];
          const float a3 = bf_hi(o1.y) - lam * O[eb][4 * q4 + 3];
          O[eb][4 * q4 + 0] = a0; O[eb][4 * q4 + 1] = a1; O[eb][4 * q4 + 2] = a2; O[eb][4 * q4 + 3] = a3;
          ssq += a0 * a0 + a1 * a1 + a2 * a2 + a3 * a3;
        }
      ssq += __shfl_xor(ssq, 32);
      const float rn = rsqrtf(ssq * (1.f / 128.f) + EPS) * (1.f - lambda_init);
#pragma unroll
      for (int eb = 0; eb < 4; eb++)
#pragma unroll
        for (int q4 = 0; q4 < 4; q4++) {
          const int e = eb * 32 + 8 * q4 + 4 * lh;
          const f32x4 gv = *(const f32x4*)(subg + e);
          u32x2 o;
          o.x = pack2(O[eb][4 * q4 + 0] * rn * gv.x, O[eb][4 * q4 + 1] * rn * gv.y);
          o.y = pack2(O[eb][4 * q4 + 2] * rn * gv.z, O[eb][4 * q4 + 3] * rn * gv.w);
          *(u32x2*)(ao + (size_t)t * 1024 + h * 128 + e) = o;
        }
    }
  }
}

DEVI void attnC_phase(const Params& p, char* smem, volatile __attribute__((address_space(3))) unsigned* gctr, unsigned& gtarget) {
  const int tid = otid(), lane = tid & 63, w = tid >> 6;
  const int l31 = lane & 31, lh = lane >> 5;
  const bf16_t* cq = (const bf16_t*)(p.ws + R_CQ);
  const bf16_t* ck = (const bf16_t*)(p.ws + R_CK);
  const bf16_t* cvt = (const bf16_t*)(p.ws + R_CVT);
  const u64* mask = (const u64*)(p.ws + R_MASK);
  bf16_t* ao = (bf16_t*)(p.ws + R_AO);
  float gq = fmaxf(fabsf(p.c_q_g[lane]), fabsf(p.c_q_g[64 + lane])), gk = fmaxf(fabsf(p.c_k_g[lane]), fabsf(p.c_k_g[64 + lane]));
#pragma unroll
  for (int o = 32; o >= 1; o >>= 1) { gq = fmaxf(gq, __shfl_xor(gq, o)); gk = fmaxf(gk, __shfl_xor(gk, o)); }
  const float negc0 = -(11.313708498984761f * gq * gk * LOG2E * 1.01f);
  for (int item = vblk(); item < 512; item += nvblk()) {
    const int pr = item & 15, hh = (item >> 4) & 7, b = item >> 7;
    const int g = hh >> 2;
    for (int qi = 0; qi < 2; qi++) {
      const int qt = qi ? pr : (31 - pr);
      const int t = b * SEQ + qt * 128 + w * 32 + l31;
      f32x16 O[4];
      flash_qtile<128, true>(cq + (size_t)t * 1024 + hh * 128, ck + (size_t)b * SEQ * 256 + g * 128, 256,
                             cvt + (size_t)(b * 2 + g) * 128 * 4096, mask + (size_t)t * 64, qt, smem, O, negc0, gctr, gtarget);
#pragma unroll
      for (int eb = 0; eb < 4; eb++)
#pragma unroll
        for (int q4 = 0; q4 < 4; q4++) {
          const int e = eb * 32 + 8 * q4 + 4 * lh;
          u32x2 o;
          o.x = pack2(O[eb][4 * q4 + 0], O[eb][4 * q4 + 1]);
          o.y = pack2(O[eb][4 * q4 + 2], O[eb][4 * q4 + 3]);
          *(u32x2*)(ao + (size_t)t * 1024 + hh * 128 + e) = o;
        }
    }
  }
}

DEVI void pool_phase(const Params& p, char* smem) {
  const int tid = otid(), lane = tid & 63, w = tid >> 6;
  float* rs = (float*)smem;
  const float* h = p.out;
  bf16_t* pooled = (bf16_t*)(p.ws + R_POOL);
  for (int tile = vblk(); tile < T_TOK / 32; tile += nvblk()) {
    const int t0 = tile * 32;
    const int pos0 = t0 & (SEQ - 1);
    __syncthreads();
    for (int r = w; r < 47; r += 4) {
      const int pos = pos0 - 15 + r;
      if (pos >= 0) {
        const float* row = h + (size_t)(t0 - 15 + r) * 1024;
        float s = 0.f;
#pragma unroll
        for (int i = 0; i < 4; i++) {
          f32x4 v = *(const f32x4*)(row + i * 256 + lane * 4);
          s += v.x * v.x + v.y * v.y + v.z * v.z + v.w * v.w;
        }
#pragma unroll
        for (int o = 32; o >= 1; o >>= 1) s += __shfl_xor(s, o);
        if (lane == 0) rs[r] = rsqrtf(s * (1.f / 1024.f) + EPS);
      }
    }
    __syncthreads();
    const int c = tid * 4;
    const int grp = c >> 8;
    const int win = 2 << grp;
    f32x4 sum = f32x4{0.f, 0.f, 0.f, 0.f};
    for (int r = -(win - 1); r < 0; r++) {
      if (pos0 + r >= 0) {
        f32x4 v = *(const f32x4*)(h + (size_t)(t0 + r) * 1024 + c);
        const float s = rs[r + 15];
        sum.x += v.x * s; sum.y += v.y * s; sum.z += v.z * s; sum.w += v.w * s;
      }
    }
    for (int r = 0; r < 32; r++) {
      f32x4 v = *(const f32x4*)(h + (size_t)(t0 + r) * 1024 + c);
      const float s = rs[r + 15];
      v.x *= s; v.y *= s; v.z *= s; v.w *= s;
      sum.x += v.x; sum.y += v.y; sum.z += v.z; sum.w += v.w;
      const int pos = pos0 + r;
      const float ic = 1.f / (float)min(pos + 1, win);
      u32x2 o;
      o.x = pack2(sum.x * ic - v.x, sum.y * ic - v.y);
      o.y = pack2(sum.z * ic - v.z, sum.w * ic - v.w);
      *(u32x2*)(pooled + (size_t)(t0 + r) * 1024 + c) = o;
      const int ro = r - win + 1;
      if (pos0 + ro >= 0) {
        f32x4 u = *(const f32x4*)(h + (size_t)(t0 + ro) * 1024 + c);
        const float so = rs[ro + 15];
        sum.x -= u.x * so; sum.y -= u.y * so; sum.z -= u.z * so; sum.w -= u.w * so;
      }
    }
  }
}

DEVI unsigned fkey(float f) {
  unsigned u = __float_as_uint(f);
  return (u & 0x80000000u) ? ~u : (u | 0x80000000u);
}

template <int NR>
DEVI void select_topk(const float* srow, const int c, const int lane, u64* mrow) {
  unsigned kreg[NR];
#pragma unroll
  for (int j = 0; j < NR; j++) {
    const unsigned k = fkey(srow[j * 64 + lane]);
    kreg[j] = (j <= c) ? k : 0u;
  }
  unsigned T = 0u;
  bool exact = false;
#pragma unroll 1
  for (int bit = 31; bit >= 0; bit--) {
    const unsigned cand = T | (1u << bit);
    int cnt = 0;
#pragma unroll
    for (int j = 0; j < NR; j++) cnt += __popcll(__ballot(kreg[j] >= cand));
    if (cnt >= 256) T = cand;
    if (cnt == 256) { exact = true; break; }
  }
  asm volatile("" : "+v"(T));
  if (exact) {
#pragma unroll
    for (int j = 0; j < NR; j++) {
      const u64 bm = __ballot(kreg[j] >= T);
      if (lane == 0) mrow[j] = bm;
    }
  } else {
    int cgt = 0;
#pragma unroll
    for (int j = 0; j < NR; j++) cgt += __popcll(__ballot(kreg[j] > T));
    int need = 256 - cgt;
#pragma unroll
    for (int j = 0; j < NR; j++) {
      const u64 gt = __ballot(kreg[j] > T);
      const u64 eq = __ballot(kreg[j] == T);
      const int rank = __popcll(eq & ((1ull << lane) - 1ull));
      const u64 tk = __ballot((kreg[j] == T) && (rank < need));
      need -= __popcll(eq);
      const u64 bm = gt | tk;
      if (lane == 0) mrow[j] = bm;
    }
  }
}

DEVI void index_unit(const Params& p, int unit, char* smem, volatile __attribute__((address_space(3))) unsigned* gctr, unsigned& gtarget) {
  const int tid = otid(), lane = tid & 63, w = tid >> 6;
  const int l31 = lane & 31, lh = lane >> 5;
  const int c = unit >> 4, b = (unit >> 2) & 3, qr = unit & 3;
  const int t0 = b * SEQ + c * 64 + qr * 16;
  u64* mask = (u64*)(p.ws + R_MASK);
  if (c < 4) {
    if (tid < 16 * (c + 1)) {
      const int q = tid / (c + 1), j = tid % (c + 1);
      u64 ones = ~0ull;
      asm volatile("" : "+v"(ones));
      mask[(size_t)(t0 + q) * 64 + j] = ones;
    }
    return;
  }
  const bf16_t* ciq = (const bf16_t*)(p.ws + R_CIQ);
  const bf16_t* cik = (const bf16_t*)(p.ws + R_CIK);
  const float* ciw = (const float*)(p.ws + R_CIW);
  float* sc = (float*)smem;
  const int nkb = 2 * (c + 1);
  for (int grp = 0; grp < 4; grp++) {
    const int tq = t0 + grp * 4;
    {
      const int a = l31 >> 3, gg = (l31 >> 2) & 1, bq = l31 & 3;
      const int qloc = 2 * gg + (a >> 1), head = (a & 1) * 4 + bq;
      bf16x8 af[4];
#pragma unroll
      for (int ks = 0; ks < 4; ks++) af[ks] = *(const bf16x8*)(ciq + (size_t)(tq + qloc) * 512 + head * 64 + 16 * ks + 8 * lh);
      float wq0[8], wq1[8];
      {
        const f32x4 a0 = *(const f32x4*)(ciw + (size_t)(tq + 2 * lh) * 8), a1 = *(const f32x4*)(ciw + (size_t)(tq + 2 * lh) * 8 + 4);
        const f32x4 b0 = *(const f32x4*)(ciw + (size_t)(tq + 2 * lh + 1) * 8), b1 = *(const f32x4*)(ciw + (size_t)(tq + 2 * lh + 1) * 8 + 4);
        wq0[0] = a0.x; wq0[1] = a0.y; wq0[2] = a0.z; wq0[3] = a0.w; wq0[4] = a1.x; wq0[5] = a1.y; wq0[6] = a1.z; wq0[7] = a1.w;
        wq1[0] = b0.x; wq1[1] = b0.y; wq1[2] = b0.z; wq1[3] = b0.w; wq1[4] = b1.x; wq1[5] = b1.y; wq1[6] = b1.z; wq1[7] = b1.w;
      }
      const int nit = (nkb - w + 3) >> 2;
      const bf16_t* ikb = cik + (size_t)b * SEQ * 64 + 8 * lh;
      bf16x8 nb[4][4];
#pragma unroll
      for (int u = 0; u < 4; u++) {
        const int kb = min(w + 4 * u, nkb - 1);
#pragma unroll
        for (int ks = 0; ks < 4; ks++) nb[u][ks] = *(const bf16x8*)(ikb + (size_t)(kb * 32 + l31) * 64 + 16 * ks);
      }
      for (int it0 = 0; it0 < nit; it0 += 4) {
        bf16x8 cb[4][4];
#pragma unroll
        for (int u = 0; u < 4; u++)
#pragma unroll
          for (int ks = 0; ks < 4; ks++) cb[u][ks] = nb[u][ks];
        if (it0 + 4 < nit) {
#pragma unroll
          for (int u = 0; u < 4; u++) {
            const int kb = min(w + 4 * (it0 + 4 + u), nkb - 1);
#pragma unroll
            for (int ks = 0; ks < 4; ks++) nb[u][ks] = *(const bf16x8*)(ikb + (size_t)(kb * 32 + l31) * 64 + 16 * ks);
          }
        }
#pragma unroll
        for (int u = 0; u < 4; u++) {
          const int kb = w + 4 * (it0 + u);
          f32x16 acc;
#pragma unroll
          for (int r = 0; r < 16; r++) acc[r] = 0.f;
#pragma unroll
          for (int ks = 0; ks < 4; ks++) acc = mfma32(af[ks], cb[u][ks], acc);
          float s0 = 0.f, s1 = 0.f;
#pragma unroll
          for (int r = 0; r < 8; r++) s0 += wq0[r] * fmaxf(acc[r], 0.f);
#pragma unroll
          for (int r = 0; r < 8; r++) s1 += wq1[r] * fmaxf(acc[8 + r], 0.f);
          if (s0 == 0.f) s0 = 0.f;
          if (s1 == 0.f) s1 = 0.f;
          if (kb < nkb) {
            const int key = kb * 32 + l31;
            sc[(2 * lh) * 4096 + key] = s0;
            sc[(2 * lh + 1) * 4096 + key] = s1;
          }
        }
      }
    }
    grp_barrier(gctr, gtarget, lane);
    {
      u64* mrow = mask + (size_t)(tq + w) * 64;
      const float* srow = sc + w * 4096;
      if (c < 16) select_topk<16>(srow, c, lane, mrow);
      else if (c < 32) select_topk<32>(srow, c, lane, mrow);
      else if (c < 48) select_topk<48>(srow, c, lane, mrow);
      else select_topk<64>(srow, c, lane, mrow);
    }
    grp_barrier(gctr, gtarget, lane);
  }
}

DEVI void index_phase(const Params& p, char* smem, volatile __attribute__((address_space(3))) unsigned* gctr, unsigned& gtarget) {
  for (int it2 = vblk() * 2; it2 < 1024; it2 += nvblk() * 2) {
    for (int k = 0; k < 2; k++) {
      const int item = it2 >> 1;
      index_unit(p, k ? item : (1023 - item), smem, gctr, gtarget);
    }
  }
}


#define XB_TMO      128
#define XB_XCNT(j)  (256  + 64 * (j))
#define XB_XSUB(j)  (1280 + 64 * (j))
#define XB_XGEN(j)  (2304 + 64 * (j))
#define XB_TOP      3328
#define XB_TOPGEN   3392
#define XCD_BAR_WORDS 3456
#define XB_SPIN_CAP (1u << 22)
#define LAS __attribute__((address_space(3)))
constexpr size_t OFF_BAR = 250 * MB;

DEVI unsigned xb_ld(unsigned* p)              { return __hip_atomic_load(p, __ATOMIC_RELAXED, __HIP_MEMORY_SCOPE_AGENT); }
DEVI unsigned xb_add(unsigned* p, unsigned v) { return __hip_atomic_fetch_add(p, v, __ATOMIC_RELAXED, __HIP_MEMORY_SCOPE_AGENT); }
DEVI unsigned xb_xcc_id() { return (unsigned)__builtin_amdgcn_s_getreg((3 << 11) | 20) & 0xFu; }
#define XB_SPIN(cond, bar) do { unsigned _sp = 0; while (cond) { __builtin_amdgcn_s_sleep(1); \
    if ((++_sp & 255u) == 0u) { if (xb_ld(&(bar)[XB_TMO])) break; if (_sp > XB_SPIN_CAP) { atomicAdd(&(bar)[XB_TMO], 1u); break; } } } } while (0)

struct XcdBarrier { unsigned* bar; volatile LAS unsigned* st; };

DEVI XcdBarrier xcd_barrier_post(unsigned* bar, volatile LAS unsigned* st) {
  XcdBarrier b; b.bar = bar; b.st = st;
  if (threadIdx.x == 0) (void)xb_add(&bar[XB_XCNT(xb_xcc_id())], 1u);
  return b;
}
DEVI void xcd_barrier_complete(unsigned* bar, unsigned x, unsigned& nloc, unsigned& nx) {
  const unsigned G = gridDim.x * gridDim.y * gridDim.z;
  unsigned sum, cnt, mine, sp = 0u;
  for (;;) {
    sum = 0u; cnt = 0u; mine = 0u;
#pragma unroll
    for (unsigned j = 0; j < 16; ++j) { const unsigned c = xb_ld(&bar[XB_XCNT(j)]); sum += c; cnt += (c > 0u) ? 1u : 0u; mine = (j == x) ? c : mine; }
    if (sum == G) break;
    __builtin_amdgcn_s_sleep(1);
    if ((++sp & 255u) == 0u) { if (xb_ld(&bar[XB_TMO])) break; if (sp > XB_SPIN_CAP) { atomicAdd(&bar[XB_TMO], 1u); break; } }
  }
  nloc = mine > 0u ? mine : 1u; nx = cnt > 0u ? cnt : 1u;
}
DEVI void xcd_barrier(const XcdBarrier& b) {
  asm volatile("s_waitcnt vmcnt(0)" ::: "memory");
  __syncthreads();
  if (threadIdx.x == 0) {
    unsigned* bar = b.bar;
    const unsigned bx = xb_xcc_id();
    __builtin_amdgcn_s_waitcnt(0);
    unsigned nloc = b.st[0], nx = b.st[1];
    if (nloc == 0u) { xcd_barrier_complete(bar, bx, nloc, nx); b.st[0] = nloc; b.st[1] = nx; }
    const unsigned old = xb_add(&bar[XB_XSUB(bx)], 1u);
    const unsigned gen = old / nloc;
    if (old + 1u == (gen + 1u) * nloc) {
      __builtin_amdgcn_fence(__ATOMIC_RELEASE, "agent");
      asm volatile("s_waitcnt vmcnt(0)" ::: "memory");
      const unsigned og = xb_add(&bar[XB_TOP], 1u);
      const unsigned tg = og / nx;
      if (og + 1u == (tg + 1u) * nx) xb_add(&bar[XB_TOPGEN], 1u);
      else XB_SPIN(xb_ld(&bar[XB_TOPGEN]) == tg, bar);
      __builtin_amdgcn_fence(__ATOMIC_ACQUIRE, "agent");
      xb_add(&bar[XB_XGEN(bx)], 1u);
      asm volatile("s_waitcnt vmcnt(0)" ::: "memory");
    } else {
      XB_SPIN(xb_ld(&bar[XB_XGEN(bx)]) == gen, bar);
      __builtin_amdgcn_fence(__ATOMIC_ACQUIRE, "agent");
      asm volatile("s_waitcnt vmcnt(0)" ::: "memory");
    }
  }
  __syncthreads();
}

__global__ void __launch_bounds__(512, 2) fwd_megakernel(Params p) {
  __shared__ __attribute__((aligned(16))) char smem[SMEM_BYTES];
  cg::grid_group grid = cg::this_grid();
  char* gs = smem + grp_id() * 65536;
  char* ws = p.ws;
  __shared__ __attribute__((aligned(16))) unsigned xb_words[4];
  if (threadIdx.x == 0) { xb_words[0] = 0u; xb_words[1] = 0u; xb_words[2] = 0u; xb_words[3] = 0u; }
  __syncthreads();
  volatile LAS unsigned* gctr = (volatile LAS unsigned*)&xb_words[2 + grp_id()];
  unsigned gtarget = 0u;
  const XcdBarrier xb = xcd_barrier_post((unsigned*)(ws + OFF_BAR), (volatile LAS unsigned*)xb_words);
  if (gridDim.y == 0x7fffffffu) grid.sync();
  bf16_t* hb = (bf16_t*)(ws + OFF_HB);

  for (int rep = 0; rep <= DUP_CONV; rep++) convert_phase(p, gs);
  xcd_barrier(xb);

  for (int layer = 0; layer < 4; layer++) {
    const int mixer = layer % 3, jl = layer / 3;
    const float* resid_src = (layer == 0) ? p.x : p.out;
    if (mixer == 0) {
      const float lambda_init = (layer == 0) ? 0.2f : 0.5560582041564594f;
      {
        GemmArgs ga{};
      ga.ssq = (float*)(ws + OFF_SSQ);
        ga.ssq = (float*)(ws + OFF_SSQ);
        ga.A = hb; ga.lda = 1024; ga.Bt = (const bf16_t*)(ws + OFF_AIN + (size_t)jl * 6 * MB); ga.K = 1024; ga.NT = 12;
        ga.o0 = ws + R_QK; ga.o1 = ws + R_VT; ga.g0 = p.a_q_g + jl * 64; ga.g1 = p.a_k_g + jl * 64;
        for (int rep = 0; rep <= DUP_GEMM; rep++) gemm_phase<M_AQKV, 1024>(ga, smem);
      }
      xcd_barrier(xb);
      for (int rep = 0; rep <= DUP_ATTNA; rep++) attnA_phase(p, jl, lambda_init, gs, gctr, gtarget);
      xcd_barrier(xb);
      {
        GemmArgs ga{};
      ga.ssq = (float*)(ws + OFF_SSQ);
        ga.ssq = (float*)(ws + OFF_SSQ);
        ga.A = (const bf16_t*)(ws + R_AO); ga.lda = 1024; ga.Bt = (const bf16_t*)(ws + OFF_AOUT + (size_t)jl * 2 * MB); ga.K = 1024; ga.NT = 4;
        ga.o0 = p.out; ga.o1 = hb; ga.resid = resid_src;
        gemm_phase<M_RESID, 1024>(ga, smem);
      }
      xcd_barrier(xb);
    } else if (mixer == 1) {
      pool_phase(p, gs);
      xcd_barrier(xb);
      {
        GemmArgs ga{};
      ga.ssq = (float*)(ws + OFF_SSQ);
        ga.ssq = (float*)(ws + OFF_SSQ);
        ga.A = (const bf16_t*)(ws + R_POOL); ga.lda = 1024; ga.Bt = (const bf16_t*)(ws + OFF_BW); ga.K = 256; ga.NT = 4;
        ga.o0 = p.out; ga.o1 = hb; ga.resid = resid_src; ga.g0 = p.b_scale;
        gemm_phase<M_POOL, 256>(ga, smem);
      }
      xcd_barrier(xb);
    } else {
      {
        GemmArgs ga{};
      ga.ssq = (float*)(ws + OFF_SSQ);
        ga.ssq = (float*)(ws + OFF_SSQ);
        ga.A = hb; ga.lda = 1024; ga.Bt = (const bf16_t*)(ws + OFF_CIN); ga.K = 1024; ga.NT = 9;
        ga.o0 = ws + R_CQ; ga.o1 = ws + R_CK; ga.o2 = ws + R_CVT; ga.o3 = ws + R_CIQ; ga.o4 = ws + R_CIK; ga.o5 = ws + R_CIW;
        ga.g0 = p.c_q_g; ga.g1 = p.c_k_g;
        for (int rep = 0; rep <= DUP_GEMM; rep++) gemm_phase<M_CIN, 1024>(ga, smem);
      }
      xcd_barrier(xb);
      for (int rep = 0; rep <= DUP_IDX; rep++) index_phase(p, gs, gctr, gtarget);
      xcd_barrier(xb);
      for (int rep = 0; rep <= DUP_ATTNC; rep++) attnC_phase(p, gs, gctr, gtarget);
      xcd_barrier(xb);
      {
        GemmArgs ga{};
      ga.ssq = (float*)(ws + OFF_SSQ);
        ga.ssq = (float*)(ws + OFF_SSQ);
        ga.A = (const bf16_t*)(ws + R_AO); ga.lda = 1024; ga.Bt = (const bf16_t*)(ws + OFF_COUT); ga.K = 1024; ga.NT = 4;
        ga.o0 = p.out; ga.o1 = hb; ga.resid = resid_src;
        gemm_phase<M_RESID, 1024>(ga, smem);
      }
      xcd_barrier(xb);
    }
    {
      GemmArgs ga{};
      ga.ssq = (float*)(ws + OFF_SSQ);
      ga.A = hb; ga.lda = 1024; ga.Bt = (const bf16_t*)(ws + OFF_W1 + (size_t)layer * 8 * MB); ga.K = 1024; ga.NT = 16;
      ga.o0 = ws + R_HID;
      for (int rep = 0; rep <= DUP_GEMM; rep++) gemm_phase<M_MLP1, 1024>(ga, smem);
    }
    xcd_barrier(xb);
    {
      GemmArgs ga{};
      ga.ssq = (float*)(ws + OFF_SSQ);
      ga.A = (const bf16_t*)(ws + R_HID); ga.lda = 4096; ga.Bt = (const bf16_t*)(ws + OFF_W2 + (size_t)layer * 8 * MB); ga.K = 4096; ga.NT = 4;
      ga.o0 = p.out; ga.o1 = hb; ga.resid = p.out;
      gemm_phase<M_RESID, 4096>(ga, smem);
    }
    if (layer < 3) xcd_barrier(xb);
  }
}

extern "C" void kernel_launch(void* const* d_in, const int* in_sizes, int n_in, void* d_out, int out_size,
                              void* d_ws, size_t ws_size, hipStream_t stream) {
  static int grid_blocks = 0;
  if (!grid_blocks) {
    int dev = 0, cus = 0, per_cu = 0;
    hipGetDevice(&dev);
    hipDeviceGetAttribute(&cus, hipDeviceAttributeMultiprocessorCount, dev);
    hipOccupancyMaxActiveBlocksPerMultiprocessor(&per_cu, fwd_megakernel, 512, 0);
    if (per_cu > 1) per_cu = 1;
    if (per_cu < 1) per_cu = 1;
    grid_blocks = cus * per_cu;
  }
  if (ws_size < WS_NEED) { fprintf(stderr, "workspace too small: %zu < %zu\n", ws_size, (size_t)WS_NEED); return; }
  Params p{};
  p.x = (const float*)d_in[0]; p.norm1_g = (const float*)d_in[1]; p.norm2_g = (const float*)d_in[2];
  p.a_w_in = (const float*)d_in[3]; p.a_q_g = (const float*)d_in[4]; p.a_k_g = (const float*)d_in[5];
  p.a_lq1 = (const float*)d_in[6]; p.a_lk1 = (const float*)d_in[7]; p.a_lq2 = (const float*)d_in[8]; p.a_lk2 = (const float*)d_in[9];
  p.a_sub_g = (const float*)d_in[10]; p.a_w_out = (const float*)d_in[11];
  p.b_w = (const float*)d_in[12]; p.b_scale = (const float*)d_in[13];
  p.c_w_in = (const float*)d_in[14]; p.c_q_g = (const float*)d_in[15]; p.c_k_g = (const float*)d_in[16]; p.c_w_out = (const float*)d_in[17];
  p.w1 = (const float*)d_in[18]; p.w2 = (const float*)d_in[19];
  p.out = (float*)d_out; p.ws = (char*)d_ws;
  hipMemsetAsync((char*)d_ws + OFF_BAR, 0, XCD_BAR_WORDS * sizeof(unsigned), stream);
  void* args[] = {&p};
  hipError_t e = hipLaunchCooperativeKernel((void*)fwd_megakernel, dim3(grid_blocks), dim3(512), args, 0, stream);
  if (e != hipSuccess) fprintf(stderr, "cooperative launch failed: %s (grid %d)\n", hipGetErrorString(e), grid_blocks);
}
```

```cpp
#include <hip/hip_runtime.h>
#include <hip/hip_cooperative_groups.h>
#include <cstdio>
namespace cg = cooperative_groups;

typedef unsigned short bf16_t;
typedef __attribute__((ext_vector_type(8))) short bf16x8;
typedef __attribute__((ext_vector_type(16))) float f32x16;
typedef unsigned long long u64;
typedef unsigned __attribute__((ext_vector_type(4))) u32x4;
typedef unsigned __attribute__((ext_vector_type(2))) u32x2;
typedef float __attribute__((ext_vector_type(4))) f32x4;

#define DEVI __device__ __forceinline__
#define DUP_GEMM 0
#define DUP_ATTNA 0
#define DUP_IDX 0
#define DUP_ATTNC 0
#define DUP_CONV 0

constexpr int T_TOK = 16384;
constexpr int DM = 1024;
constexpr int SEQ = 4096;
constexpr float EPS = 1e-6f;
constexpr float LOG2E = 1.4426950408889634f;
constexpr size_t MB = 1ull << 20;

constexpr size_t OFF_W1 = 0;
constexpr size_t OFF_W2 = 32 * MB;
constexpr size_t OFF_AIN = 64 * MB;
constexpr size_t OFF_AOUT = 76 * MB;
constexpr size_t OFF_BW = 80 * MB;
constexpr size_t OFF_CIN = 81 * MB;
constexpr size_t OFF_COUT = 86 * MB;
constexpr size_t OFF_HB = 88 * MB;
constexpr size_t OFF_R = 120 * MB;
constexpr size_t OFF_SSQ = 249 * MB;
constexpr size_t WS_NEED = 251 * MB;
constexpr size_t R_QK = OFF_R;
constexpr size_t R_VT = OFF_R + 64 * MB;
constexpr size_t R_AO = OFF_R + 96 * MB;
constexpr size_t R_HID = OFF_R;
constexpr size_t R_POOL = OFF_R;
constexpr size_t R_CQ = OFF_R;
constexpr size_t R_CK = OFF_R + 32 * MB;
constexpr size_t R_CVT = OFF_R + 40 * MB;
constexpr size_t R_CIQ = OFF_R + 48 * MB;
constexpr size_t R_CIK = OFF_R + 64 * MB;
constexpr size_t R_CIW = OFF_R + 66 * MB;
constexpr size_t R_MASK = OFF_R + 67 * MB;

struct Params {
  const float* x; const float* norm1_g; const float* norm2_g;
  const float* a_w_in; const float* a_q_g; const float* a_k_g;
  const float* a_lq1; const float* a_lk1; const float* a_lq2; const float* a_lk2;
  const float* a_sub_g; const float* a_w_out;
  const float* b_w; const float* b_scale;
  const float* c_w_in; const float* c_q_g; const float* c_k_g; const float* c_w_out;
  const float* w1; const float* w2;
  float* out; char* ws;
};

DEVI bf16_t f2bf(float f) {
  return __builtin_bit_cast(bf16_t, (__bf16)f);
}
typedef __bf16 bf16x2_t __attribute__((ext_vector_type(2)));
DEVI unsigned pack2(float a, float b) {
  bf16x2_t v;
  v.x = (__bf16)a; v.y = (__bf16)b;
  return __builtin_bit_cast(unsigned, v);
}
DEVI float bf_lo(unsigned p) { return __uint_as_float(p << 16); }
DEVI float bf_hi(unsigned p) { return __uint_as_float(p & 0xffff0000u); }
DEVI float fexp2(float x) { return __builtin_amdgcn_exp2f(x); }

template <int ROWB>
DEVI int lds_off(int row, int chunk) {
  if (ROWB == 128) return row * 128 + ((chunk ^ ((row >> 1) & 7)) << 4);
  else return row * 256 + ((chunk ^ (row & 15)) << 4);
}

DEVI f32x16 mfma32(bf16x8 a, bf16x8 b, f32x16 c) {
  return __builtin_amdgcn_mfma_f32_32x32x16_bf16(a, b, c, 0, 0, 0);
}

constexpr int SMEM_BYTES = 131072 + 1024 + 4096;

DEVI int otid() { int t = threadIdx.x & 255; asm volatile("" : "+v"(t)); return t; }
DEVI int otid512() { int t = threadIdx.x; asm volatile("" : "+v"(t)); return t; }
DEVI int grp_id() { return __builtin_amdgcn_readfirstlane((int)(threadIdx.x >> 8)); }
DEVI int vblk() { return (int)blockIdx.x * 2 + grp_id(); }
DEVI int nvblk() { return (int)gridDim.x * 2; }

struct Job { const float* src; bf16_t* dst; const float* gain; int K, N, NP; };

DEVI Job get_job(const Params& p, int j) {
  Job jb;
  char* ws = p.ws;
  if (j < 4) {
    jb.src = p.w1 + (size_t)j * 1024 * 4096; jb.dst = (bf16_t*)(ws + OFF_W1 + (size_t)j * 8 * MB);
    jb.gain = p.norm2_g + j * 1024; jb.K = 1024; jb.N = 4096; jb.NP = 4096;
  } else if (j < 8) {
    int i = j - 4;
    jb.src = p.w2 + (size_t)i * 1024 * 4096; jb.dst = (bf16_t*)(ws + OFF_W2 + (size_t)i * 8 * MB);
    jb.gain = nullptr; jb.K = 4096; jb.N = 1024; jb.NP = 1024;
  } else if (j < 10) {
    int i = j - 8;
    jb.src = p.a_w_in + (size_t)i * 1024 * 3072; jb.dst = (bf16_t*)(ws + OFF_AIN + (size_t)i * 6 * MB);
    jb.gain = p.norm1_g + (i == 0 ? 0 : 3) * 1024; jb.K = 1024; jb.N = 3072; jb.NP = 3072;
  } else if (j < 12) {
    int i = j - 10;
    jb.src = p.a_w_out + (size_t)i * 1024 * 1024; jb.dst = (bf16_t*)(ws + OFF_AOUT + (size_t)i * 2 * MB);
    jb.gain = nullptr; jb.K = 1024; jb.N = 1024; jb.NP = 1024;
  } else if (j < 16) {
    int g = j - 12;
    jb.src = p.b_w + (size_t)g * 65536; jb.dst = (bf16_t*)(ws + OFF_BW) + (size_t)g * 65536;
    jb.gain = p.norm1_g + 1024 + g * 256; jb.K = 256; jb.N = 256; jb.NP = 256;
  } else if (j == 16) {
    jb.src = p.c_w_in; jb.dst = (bf16_t*)(ws + OFF_CIN);
    jb.gain = p.norm1_g + 2 * 1024; jb.K = 1024; jb.N = 2120; jb.NP = 2304;
  } else {
    jb.src = p.c_w_out; jb.dst = (bf16_t*)(ws + OFF_COUT);
    jb.gain = nullptr; jb.K = 1024; jb.N = 1024; jb.NP = 1024;
  }
  return jb;
}
constexpr int NJOBS = 18;

DEVI void convert_phase(const Params& p, char* smem) {
  const int tid = otid();
  float* t = (float*)smem;
  int total = 0;
  for (int j = 0; j < NJOBS; j++) { Job jb = get_job(p, j); total += (jb.K / 64) * (jb.NP / 64); }
  const int vb = vblk(), nvb = nvblk();
  Job jb; int k0 = 0, n0 = 0; bool act;
  f32x4 vc[4], vn[4];
#define CV_LOCATE(TILE, JB, K0, N0, ACT)                                                 \
  { ACT = (TILE) < total;                                              \
    int rem = ACT ? (TILE) : 0, j = 0;                                                   \
    JB = get_job(p, 0);                                                                  \
    for (;;) { int nt = (JB.K / 64) * (JB.NP / 64); if (rem < nt) break; rem -= nt; j++; JB = get_job(p, j); } \
    const int ntn = JB.NP / 64;                                                          \
    K0 = (rem / ntn) * 64; N0 = (rem % ntn) * 64; }
#define CV_LOAD(V, JB, K0, N0, ACT)                                                      \
  _Pragma("unroll") for (int i = 0; i < 4; i++) {                                        \
    const int kk = (tid >> 4) + 16 * i, n = (N0) + (tid & 15) * 4;                       \
    V[i] = f32x4{0.f, 0.f, 0.f, 0.f};                                                    \
    if ((ACT) && n < JB.N) V[i] = *(const f32x4*)(JB.src + (size_t)((K0) + kk) * JB.N + n); }
  CV_LOCATE(vb, jb, k0, n0, act)
  CV_LOAD(vc, jb, k0, n0, act)
  for (int base = 0; base < total; base += nvb) {
    if (act) {
#pragma unroll
      for (int i = 0; i < 4; i++) {
        const int kk = (tid >> 4) + 16 * i, nn = (tid & 15) * 4;
        t[kk * 65 + nn + 0] = vc[i].x; t[kk * 65 + nn + 1] = vc[i].y; t[kk * 65 + nn + 2] = vc[i].z; t[kk * 65 + nn + 3] = vc[i].w;
      }
    }
    Job jbn; int k0n = 0, n0n = 0; bool actn;
    CV_LOCATE(base + nvb + vb, jbn, k0n, n0n, actn)
    CV_LOAD(vn, jbn, k0n, n0n, actn)
    __syncthreads();
    if (act) {
      const int nl = tid >> 2, kq = tid & 3;
      unsigned pk[8];
#pragma unroll
      for (int i = 0; i < 8; i++) {
        int k = kq * 16 + 2 * i;
        float a = t[k * 65 + nl], b = t[(k + 1) * 65 + nl];
        if (jb.gain) { a *= jb.gain[k0 + k]; b *= jb.gain[k0 + k + 1]; }
        pk[i] = pack2(a, b);
      }
      u32x4* d = (u32x4*)(jb.dst + (size_t)(n0 + nl) * jb.K + k0 + kq * 16);
      d[0] = u32x4{pk[0], pk[1], pk[2], pk[3]};
      d[1] = u32x4{pk[4], pk[5], pk[6], pk[7]};
    }
    __syncthreads();
    jb = jbn; k0 = k0n; n0 = n0n; act = actn;
#pragma unroll
    for (int i = 0; i < 4; i++) vc[i] = vn[i];
  }
#undef CV_LOCATE
#undef CV_LOAD
  bf16_t* hb = (bf16_t*)(p.ws + OFF_HB);
  float* ssqp = (float*)(p.ws + OFF_SSQ);
  {
    const int lane = tid & 63, wv = tid >> 6;
    for (int row = vb * 4 + wv; row < T_TOK; row += nvb * 4) {
      const float* xr = p.x + (size_t)row * DM;
      float ssum = 0.f;
#pragma unroll
      for (int i = 0; i < 2; i++) {
        const int c = i * 512 + lane * 8;
        f32x4 a = *(const f32x4*)(xr + c), b = *(const f32x4*)(xr + c + 4);
        ssum += a.x * a.x + a.y * a.y + a.z * a.z + a.w * a.w + b.x * b.x + b.y * b.y + b.z * b.z + b.w * b.w;
        *(u32x4*)(hb + (size_t)row * DM + c) = u32x4{pack2(a.x, a.y), pack2(a.z, a.w), pack2(b.x, b.y), pack2(b.z, b.w)};
      }
#pragma unroll
      for (int o = 32; o >= 1; o >>= 1) ssum += __shfl_xor(ssum, o);
      if (lane < 16) ssqp[(size_t)row * 16 + lane] = (lane == 0) ? ssum : 0.f;
    }
  }
}

DEVI void wave_put_bf16(char* wbuf, const int ml, const int nt, const int q4, const int lh, const u32x2 v) {
  const int chunk = nt * 4 + q4;
  *(u32x2*)(wbuf + ml * 128 + ((chunk ^ (ml & 7)) << 4) + 8 * lh) = v;
}
DEVI void wave_flush_bf16(char* wbuf, bf16_t* dst, const int stride, const int lane) {
  const int c = lane & 7;
#pragma unroll
  for (int i = 0; i < 8; i++) {
    const int row = i * 8 + (lane >> 3);
    const u32x4 v = *(const u32x4*)(wbuf + row * 128 + ((c ^ (row & 7)) << 4));
    *(u32x4*)(dst + (size_t)row * stride + c * 8) = v;
  }
}

enum { M_AQKV = 0, M_CIN = 1, M_RESID = 2, M_MLP1 = 3, M_POOL = 4 };

struct GemmArgs {
  const bf16_t* A; int lda; const bf16_t* Bt; int K; int NT;
  void* o0; void* o1; void* o2; void* o3; void* o4; void* o5;
  const float* g0; const float* g1; const float* resid; float* ssq;
};

template <int MODE, int KC>
DEVI void gemm_phase(const GemmArgs& ga, char* smem) {
  constexpr bool NORM = (MODE == M_AQKV || MODE == M_CIN || MODE == M_MLP1);
  const int tid = otid512(), lane = tid & 63, w = tid >> 6;
  const int wn = w & 3, wm = w >> 2;
  const int l31 = lane & 31, lh = lane >> 5;
  float* rs_lds = (float*)(smem + 131072);
  float* xch = (float*)(smem + 131072 + 1024);
  constexpr int K = KC;
  constexpr int KT = K / 64;
  const int NT256 = ga.NT;
  const int ntiles = (T_TOK / 256) * NT256;
  for (int tile = blockIdx.x; tile < ntiles; tile += gridDim.x) {
    const int tn256 = tile % NT256, tm = tile / NT256;
    const int m0 = tm * 256;
    const bf16_t* Ab = ga.A + (size_t)m0 * ga.lda + (MODE == M_POOL ? tn256 * 256 : 0);
    const bf16_t* Bb = ga.Bt + (size_t)tn256 * 256 * K;
    f32x16 acc[2][4];
#pragma unroll
    for (int a = 0; a < 2; a++)
#pragma unroll
      for (int b = 0; b < 4; b++)
#pragma unroll
        for (int r = 0; r < 16; r++) acc[a][b][r] = 0.f;
    u32x4 rw0[4], rx0[4];
    int ttid = tid;
    asm volatile("" : "+v"(ttid));
    const int ldsb = lds_off<128>(ttid >> 3, ttid & 7);
    const unsigned woff0 = (unsigned)((ttid >> 3) * K + (ttid & 7) * 8) * 2u;
    const unsigned xoff0 = (unsigned)((ttid >> 3) * ga.lda + (ttid & 7) * 8) * 2u;
#define G_LOAD(RW, RX, KTI)                                                              \
  _Pragma("unroll") for (int j = 0; j < 4; j++) {                                        \
    RW[j] = *(const u32x4*)((const char*)Bb + (size_t)(KTI) * 128 + (size_t)j * 64 * K * 2 + woff0);            \
    RX[j] = *(const u32x4*)((const char*)Ab + (size_t)(KTI) * 128 + (size_t)j * 64 * ga.lda * 2 + xoff0);      \
  }
#define G_STORE(RW, RX, S)                                                               \
  _Pragma("unroll") for (int j = 0; j < 4; j++) {                                        \
    *(u32x4*)(smem + (S) * 32768 + ldsb + j * 8192) = RW[j];            \
    *(u32x4*)(smem + 65536 + (S) * 32768 + ldsb + j * 8192) = RX[j];                     \
  }
#define G_COMPUTE_KS(S, KS0, KS1)                                                        \
  _Pragma("unroll") for (int ks = KS0; ks < KS1; ks++) {                                 \
    bf16x8 wf[2], xf[4];                                                                 \
    _Pragma("unroll") for (int nt = 0; nt < 2; nt++)                                     \
      wf[nt] = *(const bf16x8*)(smem + (S) * 32768 + lds_off<128>(wn * 64 + nt * 32 + l31, 2 * ks + lh)); \
    _Pragma("unroll") for (int mt = 0; mt < 4; mt++)                                     \
      xf[mt] = *(const bf16x8*)(smem + 65536 + (S) * 32768 + lds_off<128>(wm * 128 + mt * 32 + l31, 2 * ks + lh)); \
    _Pragma("unroll") for (int nt = 0; nt < 2; nt++)                                     \
      _Pragma("unroll") for (int mt = 0; mt < 4; mt++) acc[nt][mt] = mfma32(wf[nt], xf[mt], acc[nt][mt]); \
  }
#define G_KS_SPLIT(S, KSI, MID, END)                                                     \
  { bf16x8 wf[2], xf[2];                                                                 \
    _Pragma("unroll") for (int nt = 0; nt < 2; nt++)                                     \
      wf[nt] = *(const bf16x8*)(smem + (S) * 32768 + lds_off<128>(wn * 64 + nt * 32 + l31, 2 * (KSI) + lh)); \
    _Pragma("unroll") for (int mt = 0; mt < 2; mt++)                                     \
      xf[mt] = *(const bf16x8*)(smem + 65536 + (S) * 32768 + lds_off<128>(wm * 128 + mt * 32 + l31, 2 * (KSI) + lh)); \
    _Pragma("unroll") for (int nt = 0; nt < 2; nt++)                                     \
      _Pragma("unroll") for (int mt = 0; mt < 2; mt++) acc[nt][mt] = mfma32(wf[nt], xf[mt], acc[nt][mt]); \
    MID                                                                                  \
    _Pragma("unroll") for (int mt = 0; mt < 2; mt++)                                     \
      xf[mt] = *(const bf16x8*)(smem + 65536 + (S) * 32768 + lds_off<128>(wm * 128 + (2 + mt) * 32 + l31, 2 * (KSI) + lh)); \
    _Pragma("unroll") for (int nt = 0; nt < 2; nt++)                                     \
      _Pragma("unroll") for (int mt = 0; mt < 2; mt++) acc[nt][2 + mt] = mfma32(wf[nt], xf[mt], acc[nt][2 + mt]); \
    END }
#define G_ST2(RW, RX, S, A)                                                              \
  { *(u32x4*)(smem + (S) * 32768 + ldsb + (A) * 8192) = RW[A];                           \
    *(u32x4*)(smem + 65536 + (S) * 32768 + ldsb + (A) * 8192) = RX[A]; }
    G_LOAD(rw0, rx0, 0)
    G_STORE(rw0, rx0, 0)
    __syncthreads();
    if (NORM) {
      if (tid < 256) {
        const f32x4* sp = (const f32x4*)(ga.ssq + (size_t)(m0 + tid) * 16);
        const f32x4 a = sp[0], b = sp[1], c = sp[2], d = sp[3];
        const float tot = (a.x + a.y + a.z + a.w) + (b.x + b.y + b.z + b.w) + (c.x + c.y + c.z + c.w) + (d.x + d.y + d.z + d.w);
        rs_lds[tid] = rsqrtf(tot * (1.f / 1024.f) + EPS);
      }
    }
#pragma unroll 1
    for (int kt = 0; kt < KT; kt += 2) {
      const bool more = (kt + 2 < KT);
      G_LOAD(rw0, rx0, kt + 1)
      asm volatile("" ::: "memory");
      G_COMPUTE_KS(0, 0, 2)
      G_ST2(rw0, rx0, 1, 0)
      G_KS_SPLIT(0, 2, G_ST2(rw0, rx0, 1, 1), G_ST2(rw0, rx0, 1, 2))
      G_KS_SPLIT(0, 3, G_ST2(rw0, rx0, 1, 3), )
      __syncthreads();
      if (more) { G_LOAD(rw0, rx0, kt + 2) }
      asm volatile("" ::: "memory");
      G_COMPUTE_KS(1, 0, 2)
      if (more) { G_ST2(rw0, rx0, 0, 0) }
      G_KS_SPLIT(1, 2, if (more) { G_ST2(rw0, rx0, 0, 1) }, if (more) { G_ST2(rw0, rx0, 0, 2) })
      G_KS_SPLIT(1, 3, if (more) { G_ST2(rw0, rx0, 0, 3) }, )
      __syncthreads();
    }
#undef G_LOAD
#undef G_STORE
#undef G_COMPUTE_KS
#undef G_KS_SPLIT
#undef G_ST2
    float rstd[4] = {1.f, 1.f, 1.f, 1.f};
    if (NORM) {
#pragma unroll
      for (int mt = 0; mt < 4; mt++) rstd[mt] = rs_lds[wm * 128 + mt * 32 + l31];
    }
    int el31 = l31, elh = lh, ewn = wn & 1, ewm = wm, elane = lane, ewq = wn >> 1, eww = w;
    asm volatile("" : "+v"(el31), "+v"(elh), "+v"(ewn), "+v"(ewm), "+v"(elane), "+v"(ewq), "+v"(eww));
    const int tn = tn256 * 2 + __builtin_amdgcn_readfirstlane(ewq);
    const int n0 = tn * 128;
    char* wbuf = smem + eww * 16384;
    const int mw0 = m0 + ewm * 128;
    if (MODE == M_AQKV) {
      const int nw = n0 + ewn * 64;
      if (n0 < 2048) {
        const float* g = (n0 < 1024) ? ga.g0 : ga.g1;
        const float post = (n0 < 1024) ? (0.125f * LOG2E) : 1.f;
#pragma unroll
        for (int h = 0; h < 2; h++) {
#pragma unroll
          for (int mh = 0; mh < 2; mh++) {
            const int mt = 2 * h + mh;
            float s = 0.f;
#pragma unroll
            for (int nt = 0; nt < 2; nt++)
#pragma unroll
              for (int r = 0; r < 16; r++) { float v = acc[nt][mt][r] * rstd[mt]; acc[nt][mt][r] = v; s += v * v; }
            s += __shfl_xor(s, 32);
            const float hn = rsqrtf(s * (1.f / 64.f) + EPS) * post;
#pragma unroll
            for (int nt = 0; nt < 2; nt++)
#pragma unroll
              for (int q4 = 0; q4 < 4; q4++) {
                const int d = nt * 32 + 8 * q4 + 4 * elh;
                const f32x4 gv = *(const f32x4*)(g + d);
                { u32x2 pv; pv.x = pack2(acc[nt][mt][4 * q4 + 0] * hn * gv.x, acc[nt][mt][4 * q4 + 1] * hn * gv.y); pv.y = pack2(acc[nt][mt][4 * q4 + 2] * hn * gv.z, acc[nt][mt][4 * q4 + 3] * hn * gv.w); wave_put_bf16(wbuf, mh * 32 + el31, nt, q4, elh, pv); }
              }
          }
          wave_flush_bf16(wbuf, (bf16_t*)ga.o0 + (size_t)(mw0 + h * 64) * 2048 + nw, 2048, elane);
        }
      } else {
        bf16_t* vt = (bf16_t*)ga.o1;
        const int nn = nw - 2048, head = nn >> 7, e0 = nn & 127;
#pragma unroll
        for (int mt = 0; mt < 4; mt++) {
          const int m = mw0 + mt * 32 + el31;
          const int b = m >> 12, s = m & 4095;
          bf16_t* vp = vt + ((size_t)(b * 8 + head) * 128 + e0 + 4 * elh) * 4096 + s;
          asm volatile("" : "+v"(vp));
#pragma unroll
          for (int nt = 0; nt < 2; nt++)
#pragma unroll
            for (int r = 0; r < 16; r++)
              vp[(size_t)(nt * 32 + (r & 3) + 8 * (r >> 2)) * 4096] = f2bf(acc[nt][mt][r] * rstd[mt]);
        }
      }
    } else if (MODE == M_CIN) {
      if (tn < 10) {
#pragma unroll
        for (int mt = 0; mt < 4; mt++) {
          float s = 0.f;
#pragma unroll
          for (int nt = 0; nt < 2; nt++)
#pragma unroll
            for (int r = 0; r < 16; r++) { float v = acc[nt][mt][r] * rstd[mt]; acc[nt][mt][r] = v; s += v * v; }
          s += __shfl_xor(s, 32);
          if (elh == 0) xch[(ewq * 2 + ewn) * 256 + ewm * 128 + mt * 32 + el31] = s;
        }
        __syncthreads();
        const float* g = (tn < 8) ? ga.g0 : ga.g1;
        const float post = (tn < 8) ? (0.08838834764831845f * LOG2E) : 1.f;
#pragma unroll
        for (int h = 0; h < 2; h++) {
#pragma unroll
          for (int mh = 0; mh < 2; mh++) {
            const int mt = 2 * h + mh;
            const int ml = ewm * 128 + mt * 32 + el31;
            const float tot = xch[(ewq * 2) * 256 + ml] + xch[(ewq * 2 + 1) * 256 + ml];
            const float hn = rsqrtf(tot * (1.f / 128.f) + EPS) * post;
#pragma unroll
            for (int nt = 0; nt < 2; nt++)
#pragma unroll
              for (int q4 = 0; q4 < 4; q4++) {
                const int d = ewn * 64 + nt * 32 + 8 * q4 + 4 * elh;
                const f32x4 gv = *(const f32x4*)(g + d);
                { u32x2 pv; pv.x = pack2(acc[nt][mt][4 * q4 + 0] * hn * gv.x, acc[nt][mt][4 * q4 + 1] * hn * gv.y); pv.y = pack2(acc[nt][mt][4 * q4 + 2] * hn * gv.z, acc[nt][mt][4 * q4 + 3] * hn * gv.w); wave_put_bf16(wbuf, mh * 32 + el31, nt, q4, elh, pv); }
              }
          }
          if (tn < 8) wave_flush_bf16(wbuf, (bf16_t*)ga.o0 + (size_t)(mw0 + h * 64) * 1024 + tn * 128 + ewn * 64, 1024, elane);
          else wave_flush_bf16(wbuf, (bf16_t*)ga.o1 + (size_t)(mw0 + h * 64) * 256 + (tn - 8) * 128 + ewn * 64, 256, elane);
        }
      } else if (tn < 12) {
        bf16_t* vt = (bf16_t*)ga.o2;
        const int g = tn - 10;
#pragma unroll
        for (int mt = 0; mt < 4; mt++) {
          const int m = mw0 + mt * 32 + el31;
          const int b = m >> 12, s = m & 4095;
          bf16_t* vp = vt + ((size_t)(b * 2 + g) * 128 + ewn * 64 + 4 * elh) * 4096 + s;
          asm volatile("" : "+v"(vp));
#pragma unroll
          for (int nt = 0; nt < 2; nt++)
#pragma unroll
            for (int r = 0; r < 16; r++)
              vp[(size_t)(nt * 32 + (r & 3) + 8 * (r >> 2)) * 4096] = f2bf(acc[nt][mt][r] * rstd[mt]);
        }
      } else {
        if (tn < 16 || (tn == 16 && ewn == 0)) {
#pragma unroll
          for (int h = 0; h < 2; h++) {
  #pragma unroll
            for (int mh = 0; mh < 2; mh++) {
              const int mt = 2 * h + mh;
#pragma unroll
              for (int nt = 0; nt < 2; nt++)
#pragma unroll
                for (int q4 = 0; q4 < 4; q4++) {
                  { u32x2 pv; pv.x = pack2(acc[nt][mt][4 * q4 + 0] * rstd[mt], acc[nt][mt][4 * q4 + 1] * rstd[mt]); pv.y = pack2(acc[nt][mt][4 * q4 + 2] * rstd[mt], acc[nt][mt][4 * q4 + 3] * rstd[mt]); wave_put_bf16(wbuf, mh * 32 + el31, nt, q4, elh, pv); }
                }
            }
            if (tn < 16) wave_flush_bf16(wbuf, (bf16_t*)ga.o3 + (size_t)(mw0 + h * 64) * 512 + (tn - 12) * 128 + ewn * 64, 512, elane);
            else wave_flush_bf16(wbuf, (bf16_t*)ga.o4 + (size_t)(mw0 + h * 64) * 64, 64, elane);
          }
        } else if (tn == 16) {
          float* iw = (float*)ga.o5;
          const float sc = 0.35355339059327373f * 0.125f;
#pragma unroll
          for (int mt = 0; mt < 4; mt++) {
            const int m = mw0 + mt * 32 + el31;
            f32x4 o;
            o.x = acc[0][mt][0] * rstd[mt] * sc; o.y = acc[0][mt][1] * rstd[mt] * sc;
            o.z = acc[0][mt][2] * rstd[mt] * sc; o.w = acc[0][mt][3] * rstd[mt] * sc;
            *(f32x4*)(iw + (size_t)m * 8 + 4 * elh) = o;
          }
        }
      }
    } else if (MODE == M_RESID || MODE == M_POOL) {
      float* ho = (float*)ga.o0;
      bf16_t* hb = (bf16_t*)ga.o1;
      const int cch = elane & 15;
      const int n = n0 + ewn * 64 + cch * 4;
      f32x4 cs = f32x4{1.f, 1.f, 1.f, 1.f};
      if (MODE == M_POOL) cs = *(const f32x4*)(ga.g0 + n);
#pragma unroll
      for (int h = 0; h < 2; h++) {
#pragma unroll
        for (int mh = 0; mh < 2; mh++) {
          const int mt = 2 * h + mh;
          const int ml = mh * 32 + el31;
#pragma unroll
          for (int nt = 0; nt < 2; nt++)
#pragma unroll
            for (int q4 = 0; q4 < 4; q4++) {
              const int chunk = nt * 8 + 2 * q4 + elh;
              f32x4 v; v.x = acc[nt][mt][4 * q4 + 0]; v.y = acc[nt][mt][4 * q4 + 1]; v.z = acc[nt][mt][4 * q4 + 2]; v.w = acc[nt][mt][4 * q4 + 3];
              *(f32x4*)(wbuf + ml * 256 + ((chunk ^ (ml & 15)) << 4)) = v;
            }
        }
#pragma unroll 4
        for (int i = 0; i < 16; i++) {
          const int row = i * 4 + (elane >> 4);
          const int m = mw0 + h * 64 + row;
          const f32x4 a = *(const f32x4*)(wbuf + row * 256 + ((cch ^ (row & 15)) << 4));
          const f32x4 rv = *(const f32x4*)(ga.resid + (size_t)m * 1024 + n);
          f32x4 o;
          o.x = rv.x + a.x * cs.x; o.y = rv.y + a.y * cs.y; o.z = rv.z + a.z * cs.z; o.w = rv.w + a.w * cs.w;
          *(f32x4*)(ho + (size_t)m * 1024 + n) = o;
          u32x2 ob; ob.x = pack2(o.x, o.y); ob.y = pack2(o.z, o.w);
          *(u32x2*)(hb + (size_t)m * 1024 + n) = ob;
          float sq = o.x * o.x + o.y * o.y + o.z * o.z + o.w * o.w;
          sq += __shfl_xor(sq, 1); sq += __shfl_xor(sq, 2); sq += __shfl_xor(sq, 4); sq += __shfl_xor(sq, 8);
          if (cch == 0) ga.ssq[(size_t)m * 16 + tn * 2 + ewn] = sq;
        }
      }
    } else if (MODE == M_MLP1) {
#pragma unroll
      for (int h = 0; h < 2; h++) {
#pragma unroll
        for (int mh = 0; mh < 2; mh++) {
          const int mt = 2 * h + mh;
#pragma unroll
          for (int nt = 0; nt < 2; nt++)
#pragma unroll
            for (int q4 = 0; q4 < 4; q4++) {
              const float v0 = fmaxf(acc[nt][mt][4 * q4 + 0] * rstd[mt], 0.f), v1 = fmaxf(acc[nt][mt][4 * q4 + 1] * rstd[mt], 0.f);
              const float v2 = fmaxf(acc[nt][mt][4 * q4 + 2] * rstd[mt], 0.f), v3 = fmaxf(acc[nt][mt][4 * q4 + 3] * rstd[mt], 0.f);
              { u32x2 pv; pv.x = pack2(v0 * v0, v1 * v1); pv.y = pack2(v2 * v2, v3 * v3); wave_put_bf16(wbuf, mh * 32 + el31, nt, q4, elh, pv); }
            }
        }
        wave_flush_bf16(wbuf, (bf16_t*)ga.o0 + (size_t)(mw0 + h * 64) * 4096 + n0 + ewn * 64, 4096, elane);
      }
    }
    __syncthreads();
  }
}

DEVI void grp_barrier(volatile __attribute__((address_space(3))) unsigned* ctr, unsigned& target, const int lane) {
  asm volatile("s_waitcnt vmcnt(0) lgkmcnt(0)" ::: "memory");
  target += 4u;
  if (lane == 0) __hip_atomic_fetch_add((__attribute__((address_space(3))) unsigned*)ctr, 1u, __ATOMIC_RELAXED, __HIP_MEMORY_SCOPE_WORKGROUP);
  while (__hip_atomic_load((__attribute__((address_space(3))) unsigned*)ctr, __ATOMIC_RELAXED, __HIP_MEMORY_SCOPE_WORKGROUP) < target) __builtin_amdgcn_s_sleep(1);
  asm volatile("" ::: "memory");
}

template <int DQK, bool MASKED>
DEVI void flash_qtile(const bf16_t* __restrict__ qrow, const bf16_t* __restrict__ Kb, const int kstride,
                      const bf16_t* __restrict__ Vt, const u64* __restrict__ mrow, const int qt,
                      char* smem, f32x16 (&O)[4], const float negc0,
                      volatile __attribute__((address_space(3))) unsigned* gctr, unsigned& gtarget) {
  constexpr int KROWB = DQK * 2;
  constexpr int KS = DQK / 16;
  constexpr int KBYTES = 64 * KROWB;
  constexpr int STAGE = KBYTES + 16384;
  constexpr int KI = KBYTES / 4096;
  const int tid = otid(), lane = tid & 63, w = tid >> 6;
  const int l31 = lane & 31, lh = lane >> 5;
  unsigned kgo[KI], vgo[4];
#pragma unroll
  for (int i = 0; i < KI; i++) {
    const int blk = i * 4 + w;
    int row, kc;
    if (DQK == 64) { row = blk * 8 + (lane >> 3); kc = (lane & 7) ^ ((row >> 1) & 7); }
    else { row = blk * 4 + (lane >> 4); kc = (lane & 15) ^ (row & 15); }
    kgo[i] = (unsigned)(row * kstride + kc * 8) * 2u;
  }
#pragma unroll
  for (int i = 0; i < 4; i++) {
    const int blk = i * 4 + w;
    const int row = blk * 8 + (lane >> 3);
    const int kc = (lane & 7) ^ ((row >> 1) & 7);
    vgo[i] = (unsigned)(row * 4096 + kc * 8) * 2u;
  }
  bf16x8 qf[KS];
#pragma unroll
  for (int ks = 0; ks < KS; ks++) qf[ks] = *(const bf16x8*)(qrow + 16 * ks + 8 * lh);
#pragma unroll
  for (int eb = 0; eb < 4; eb++)
#pragma unroll
    for (int r = 0; r < 16; r++) O[eb][r] = 0.f;
  float lsum = 0.f;
  const int ntile = 2 * qt + 2;
  const int mylast = 2 * qt + (w >> 1);
  u64 mw_next = 0ull;
  if (MASKED) mw_next = mrow[0];
  grp_barrier(gctr, gtarget, lane);
  {
    const char* kt = (const char*)Kb;
    const char* vtp = (const char*)Vt;
#pragma unroll
    for (int i = 0; i < KI; i++)
      __builtin_amdgcn_global_load_lds((const unsigned*)(kt + kgo[i]), (__attribute__((address_space(3))) unsigned*)(smem + (i * 4 + w) * 1024), 16, 0, 0);
#pragma unroll
    for (int i = 0; i < 4; i++)
      __builtin_amdgcn_global_load_lds((const unsigned*)(vtp + vgo[i]), (__attribute__((address_space(3))) unsigned*)(smem + KBYTES + (i * 4 + w) * 1024), 16, 0, 0);
  }
  grp_barrier(gctr, gtarget, lane);
  for (int j = 0; j < ntile; j++) {
    const char* st = smem + (j & 1) * STAGE;
    const bool more = (j + 1 < ntile);
    if (more) {
      const char* kt = (const char*)Kb + (size_t)(j + 1) * 64 * kstride * 2;
      const char* vtp = (const char*)Vt + (size_t)(j + 1) * 64 * 2;
      char* sn = smem + ((j + 1) & 1) * STAGE;
#pragma unroll
      for (int i = 0; i < KI; i++) {
        unsigned off = kgo[i];
        asm volatile("" : "+v"(off));
        __builtin_amdgcn_global_load_lds((const unsigned*)(kt + off), (__attribute__((address_space(3))) unsigned*)(sn + (i * 4 + w) * 1024), 16, 0, 0);
      }
#pragma unroll
      for (int i = 0; i < 4; i++) {
        unsigned off = vgo[i];
        asm volatile("" : "+v"(off));
        __builtin_amdgcn_global_load_lds((const unsigned*)(vtp + off), (__attribute__((address_space(3))) unsigned*)(sn + KBYTES + (i * 4 + w) * 1024), 16, 0, 0);
      }
    }
    const u64 mw = mw_next;
    if (MASKED && more) mw_next = mrow[j + 1];
    if (j <= mylast) {
      f32x16 S[2];
#pragma unroll
      for (int mt = 0; mt < 2; mt++)
#pragma unroll
        for (int r = 0; r < 16; r++) S[mt][r] = negc0;
#pragma unroll
      for (int ks = 0; ks < KS; ks++)
#pragma unroll
        for (int mt = 0; mt < 2; mt++) {
          bf16x8 kf = *(const bf16x8*)(st + lds_off<KROWB>(mt * 32 + l31, 2 * ks + lh));
          S[mt] = mfma32(kf, qf[ks], S[mt]);
        }
      unsigned wlo = 0xffffffffu, whi = 0xffffffffu;
      if (MASKED) {
        wlo = ((unsigned)mw) >> (4 * lh);
        whi = ((unsigned)(mw >> 32)) >> (4 * lh);
      }
      float ps = 0.f;
#pragma unroll
      for (int mt = 0; mt < 2; mt++)
#pragma unroll
        for (int r = 0; r < 16; r++) {
          float pv = fexp2(S[mt][r]);
          if (MASKED) {
            const unsigned wd = mt ? whi : wlo;
            pv = ((wd >> ((r & 3) + 8 * (r >> 2))) & 1u) ? pv : 0.f;
          }
          S[mt][r] = pv;
          ps += pv;
        }
      lsum += ps;
#pragma unroll
      for (int kb = 0; kb < 2; kb++)
#pragma unroll
        for (int s = 0; s < 2; s++) {
          u32x4 pfu;
          pfu.x = pack2(S[kb][8 * s + 0], S[kb][8 * s + 1]);
          pfu.y = pack2(S[kb][8 * s + 2], S[kb][8 * s + 3]);
          pfu.z = pack2(S[kb][8 * s + 4], S[kb][8 * s + 5]);
          pfu.w = pack2(S[kb][8 * s + 6], S[kb][8 * s + 7]);
          const bf16x8 pfv = __builtin_bit_cast(bf16x8, pfu);
#pragma unroll
          for (int eb = 0; eb < 4; eb++) {
            const int row = eb * 32 + l31;
            const u32x2 h0 = *(const u32x2*)(st + KBYTES + lds_off<128>(row, 4 * kb + 2 * s) + 8 * lh);
            const u32x2 h1 = *(const u32x2*)(st + KBYTES + lds_off<128>(row, 4 * kb + 2 * s + 1) + 8 * lh);
            const u32x4 vfu = u32x4{h0.x, h0.y, h1.x, h1.y};
            O[eb] = mfma32(__builtin_bit_cast(bf16x8, vfu), pfv, O[eb]);
          }
        }
    }
    grp_barrier(gctr, gtarget, lane);
  }
  float lt = lsum + __shfl_xor(lsum, 32);
  const float inv = 1.f / lt;
#pragma unroll
  for (int eb = 0; eb < 4; eb++)
#pragma unroll
    for (int r = 0; r < 16; r++) O[eb][r] *= inv;
}

DEVI void flash_qtile_pipe(const bf16_t* __restrict__ qrow, const bf16_t* __restrict__ Kb, const int kstride,
                           const bf16_t* __restrict__ Vt, const int qt,
                           char* smem, f32x16 (&O)[4], const float negc0,
                           volatile __attribute__((address_space(3))) unsigned* gctr, unsigned& gtarget) {
  constexpr int KBYTES = 64 * 128;
  constexpr int STAGE = KBYTES + 16384;
  const int tid = otid(), lane = tid & 63, w = tid >> 6;
  const int l31 = lane & 31, lh = lane >> 5;
  unsigned kgo[2], vgo[4];
#pragma unroll
  for (int i = 0; i < 2; i++) {
    const int blk = i * 4 + w;
    const int row = blk * 8 + (lane >> 3);
    const int kc = (lane & 7) ^ ((row >> 1) & 7);
    kgo[i] = (unsigned)(row * kstride + kc * 8) * 2u;
  }
#pragma unroll
  for (int i = 0; i < 4; i++) {
    const int blk = i * 4 + w;
    const int row = blk * 8 + (lane >> 3);
    const int kc = (lane & 7) ^ ((row >> 1) & 7);
    vgo[i] = (unsigned)(row * 4096 + kc * 8) * 2u;
  }
  bf16x8 qf[4];
#pragma unroll
  for (int ks = 0; ks < 4; ks++) qf[ks] = *(const bf16x8*)(qrow + 16 * ks + 8 * lh);
#pragma unroll
  for (int eb = 0; eb < 4; eb++)
#pragma unroll
    for (int r = 0; r < 16; r++) O[eb][r] = 0.f;
  float lsum = 0.f;
  const int ntile = 2 * qt + 2;
  const int mylast = 2 * qt + (w >> 1);
#define FP_DMA_K(T, STG)                                                                              \
  { const char* kt = (const char*)Kb + (size_t)(T) * 64 * kstride * 2;                                \
    _Pragma("unroll") for (int i = 0; i < 2; i++) {                                                   \
      unsigned off = kgo[i]; asm volatile("" : "+v"(off));                                            \
      __builtin_amdgcn_global_load_lds((const unsigned*)(kt + off), (__attribute__((address_space(3))) unsigned*)(smem + (STG) * STAGE + (i * 4 + w) * 1024), 16, 0, 0); } }
#define FP_DMA_V(T, STG)                                                                              \
  { const char* vtp = (const char*)Vt + (size_t)(T) * 64 * 2;                                         \
    _Pragma("unroll") for (int i = 0; i < 4; i++) {                                                   \
      unsigned off = vgo[i]; asm volatile("" : "+v"(off));                                            \
      __builtin_amdgcn_global_load_lds((const unsigned*)(vtp + off), (__attribute__((address_space(3))) unsigned*)(smem + (STG) * STAGE + KBYTES + (i * 4 + w) * 1024), 16, 0, 0); } }
#define FP_QK(SX, STG)                                                                                \
  { _Pragma("unroll") for (int mt = 0; mt < 2; mt++)                                                  \
      _Pragma("unroll") for (int r = 0; r < 16; r++) SX[mt][r] = negc0;                               \
    _Pragma("unroll") for (int ks = 0; ks < 4; ks++)                                                  \
      _Pragma("unroll") for (int mt = 0; mt < 2; mt++) {                                              \
        bf16x8 kf = *(const bf16x8*)(smem + (STG) * STAGE + lds_off<128>(mt * 32 + l31, 2 * ks + lh)); \
        SX[mt] = mfma32(kf, qf[ks], SX[mt]); } }
#define FP_SMPV(SX, STG)                                                                              \
  { float ps = 0.f;                                                                                   \
    _Pragma("unroll") for (int mt = 0; mt < 2; mt++)                                                  \
      _Pragma("unroll") for (int r = 0; r < 16; r++) { const float pv = fexp2(SX[mt][r]); SX[mt][r] = pv; ps += pv; } \
    lsum += ps;                                                                                       \
    _Pragma("unroll") for (int kb = 0; kb < 2; kb++)                                                  \
      _Pragma("unroll") for (int s = 0; s < 2; s++) {                                                 \
        u32x4 pfu;                                                                                    \
        pfu.x = pack2(SX[kb][8 * s + 0], SX[kb][8 * s + 1]);                                          \
        pfu.y = pack2(SX[kb][8 * s + 2], SX[kb][8 * s + 3]);                                          \
        pfu.z = pack2(SX[kb][8 * s + 4], SX[kb][8 * s + 5]);                                          \
        pfu.w = pack2(SX[kb][8 * s + 6], SX[kb][8 * s + 7]);                                          \
        const bf16x8 pfv = __builtin_bit_cast(bf16x8, pfu);                                           \
        _Pragma("unroll") for (int eb = 0; eb < 4; eb++) {                                            \
          const int row = eb * 32 + l31;                                                              \
          const u32x2 h0 = *(const u32x2*)(smem + (STG) * STAGE + KBYTES + lds_off<128>(row, 4 * kb + 2 * s) + 8 * lh);     \
          const u32x2 h1 = *(const u32x2*)(smem + (STG) * STAGE + KBYTES + lds_off<128>(row, 4 * kb + 2 * s + 1) + 8 * lh); \
          const u32x4 vfu = u32x4{h0.x, h0.y, h1.x, h1.y};                                            \
          O[eb] = mfma32(__builtin_bit_cast(bf16x8, vfu), pfv, O[eb]); } } }
#define FP_STEP(J, SCUR, SNEXT, STG)                                                                  \
  { if ((J) + 2 < ntile) FP_DMA_K((J) + 2, STG)                                                       \
    if ((J) + 1 < ntile) FP_DMA_V((J) + 1, (STG) ^ 1)                                                 \
    if ((J) + 1 <= mylast) FP_QK(SNEXT, (STG) ^ 1)                                                    \
    if ((J) <= mylast) FP_SMPV(SCUR, STG)                                                             \
    grp_barrier(gctr, gtarget, lane); }
  f32x16 SA[2], SB[2];
  grp_barrier(gctr, gtarget, lane);
  FP_DMA_K(0, 0)
  FP_DMA_V(0, 0)
  FP_DMA_K(1, 1)
  grp_barrier(gctr, gtarget, lane);
  FP_QK(SA, 0)
  grp_barrier(gctr, gtarget, lane);
#pragma unroll
  for (int mt = 0; mt < 2; mt++)
#pragma unroll
    for (int r = 0; r < 16; r++) SB[mt][r] = 0.f;
  for (int j = 0; j < ntile; j += 2) {
    FP_STEP(j, SA, SB, 0)
    FP_STEP(j + 1, SB, SA, 1)
  }
#undef FP_DMA_K
#undef FP_DMA_V
#undef FP_QK
#undef FP_SMPV
#undef FP_STEP
  float lt = lsum + __shfl_xor(lsum, 32);
  const float inv = 1.f / lt;
#pragma unroll
  for (int eb = 0; eb < 4; eb++)
#pragma unroll
    for (int r = 0; r < 16; r++) O[eb][r] *= inv;
}

DEVI void attnA_phase(const Params& p, int jl, float lambda_init, char* smem,
                        volatile __attribute__((address_space(3))) unsigned* gctr, unsigned& gtarget) {
  const int tid = otid(), lane = tid & 63, w = tid >> 6;
  const int l31 = lane & 31, lh = lane >> 5;
  const bf16_t* qk = (const bf16_t*)(p.ws + R_QK);
  const bf16_t* vt = (const bf16_t*)(p.ws + R_VT);
  bf16_t* ao = (bf16_t*)(p.ws + R_AO);
  float s1 = p.a_lq1[jl * 64 + lane] * p.a_lk1[jl * 64 + lane];
  float s2 = p.a_lq2[jl * 64 + lane] * p.a_lk2[jl * 64 + lane];
#pragma unroll
  for (int o = 32; o >= 1; o >>= 1) { s1 += __shfl_xor(s1, o); s2 += __shfl_xor(s2, o); }
  const float lam = expf(s1) - expf(s2) + lambda_init;
  float gq = fabsf(p.a_q_g[jl * 64 + lane]), gk = fabsf(p.a_k_g[jl * 64 + lane]);
#pragma unroll
  for (int o = 32; o >= 1; o >>= 1) { gq = fmaxf(gq, __shfl_xor(gq, o)); gk = fmaxf(gk, __shfl_xor(gk, o)); }
  const float negc0 = -(8.0f * gq * gk * LOG2E * 1.01f);
  const float* subg = p.a_sub_g + jl * 128;
  for (int item = vblk(); item < 512; item += nvblk()) {
    const int pr = item & 15, h = (item >> 4) & 7, b = item >> 7;
    for (int qi = 0; qi < 2; qi++) {
      const int qt = qi ? pr : (31 - pr);
      const int t = b * SEQ + qt * 128 + w * 32 + l31;
      f32x16 O[4];
      flash_qtile_pipe(qk + (size_t)t * 2048 + h * 128, qk + (size_t)b * SEQ * 2048 + 1024 + h * 128, 2048,
                             vt + (size_t)(b * 8 + h) * 128 * 4096, qt, smem, O, negc0, gctr, gtarget);
#pragma unroll
      for (int eb = 0; eb < 4; eb++)
#pragma unroll
        for (int q4 = 0; q4 < 4; q4++) {
          const int e = eb * 32 + 8 * q4 + 4 * lh;
          u32x2 o;
          o.x = pack2(O[eb][4 * q4 + 0], O[eb][4 * q4 + 1]);
          o.y = pack2(O[eb][4 * q4 + 2], O[eb][4 * q4 + 3]);
          *(u32x2*)(ao + (size_t)t * 1024 + h * 128 + e) = o;
        }
      flash_qtile_pipe(qk + (size_t)t * 2048 + h * 128 + 64, qk + (size_t)b * SEQ * 2048 + 1024 + h * 128 + 64, 2048,
                             vt + (size_t)(b * 8 + h) * 128 * 4096, qt, smem, O, negc0, gctr, gtarget);
      float ssq = 0.f;
#pragma unroll
      for (int eb = 0; eb < 4; eb++)
#pragma unroll
        for (int q4 = 0; q4 < 4; q4++) {
          const int e = eb * 32 + 8 * q4 + 4 * lh;
          const u32x2 o1 = *(const u32x2*)(ao + (size_t)t * 1024 + h * 128 + e);
          const float a0 = bf_lo(o1.x) - lam * O[eb][4 * q4 + 0];
          const float a1 = bf_hi(o1.x) - lam * O[eb][4 * q4 + 1];
          const float a2 = bf_lo(o1.y) - lam * O[eb][4 * q4 + 2];
          const float a3 = bf_hi(o1.y) - lam * O[eb][4 * q4 + 3];
          O[eb][4 * q4 + 0] = a0; O[eb][4 * q4 + 1] = a1; O[eb][4 * q4 + 2] = a2; O[eb][4 * q4 + 3] = a3;
          ssq += a0 * a0 + a1 * a1 + a2 * a2 + a3 * a3;
        }
      ssq += __shfl_xor(ssq, 32);
      const float rn = rsqrtf(ssq * (1.f / 128.f) + EPS) * (1.f - lambda_init);
#pragma unroll
      for (int eb = 0; eb < 4; eb++)
#pragma unroll
        for (int q4 = 0; q4 < 4; q4++) {
          const int e = eb * 32 + 8 * q4 + 4 * lh;
          const f32x4 gv = *(const f32x4*)(subg + e);
          u32x2 o;
          o.x = pack2(O[eb][4 * q4 + 0] * rn * gv.x, O[eb][4 * q4 + 1] * rn * gv.y);
          o.y = pack2(O[eb][4 * q4 + 2] * rn * gv.z, O[eb][4 * q4 + 3] * rn * gv.w);
          *(u32x2*)(ao + (size_t)t * 1024 + h * 128 + e) = o;
        }
    }
  }
}

DEVI void attnC_phase(const Params& p, char* smem, volatile __attribute__((address_space(3))) unsigned* gctr, unsigned& gtarget) {
  const int tid = otid(), lane = tid & 63, w = tid >> 6;
  const int l31 = lane & 31, lh = lane >> 5;
  const bf16_t* cq = (const bf16_t*)(p.ws + R_CQ);
  const bf16_t* ck = (const bf16_t*)(p.ws + R_CK);
  const bf16_t* cvt = (const bf16_t*)(p.ws + R_CVT);
  const u64* mask = (const u64*)(p.ws + R_MASK);
  bf16_t* ao = (bf16_t*)(p.ws + R_AO);
  float gq = fmaxf(fabsf(p.c_q_g[lane]), fabsf(p.c_q_g[64 + lane])), gk = fmaxf(fabsf(p.c_k_g[lane]), fabsf(p.c_k_g[64 + lane]));
#pragma unroll
  for (int o = 32; o >= 1; o >>= 1) { gq = fmaxf(gq, __shfl_xor(gq, o)); gk = fmaxf(gk, __shfl_xor(gk, o)); }
  const float negc0 = -(11.313708498984761f * gq * gk * LOG2E * 1.01f);
  for (int item = vblk(); item < 512; item += nvblk()) {
    const int pr = item & 15, hh = (item >> 4) & 7, b = item >> 7;
    const int g = hh >> 2;
    for (int qi = 0; qi < 2; qi++) {
      const int qt = qi ? pr : (31 - pr);
      const int t = b * SEQ + qt * 128 + w * 32 + l31;
      f32x16 O[4];
      flash_qtile<128, true>(cq + (size_t)t * 1024 + hh * 128, ck + (size_t)b * SEQ * 256 + g * 128, 256,
                             cvt + (size_t)(b * 2 + g) * 128 * 4096, mask + (size_t)t * 64, qt, smem, O, negc0, gctr, gtarget);
#pragma unroll
      for (int eb = 0; eb < 4; eb++)
#pragma unroll
        for (int q4 = 0; q4 < 4; q4++) {
          const int e = eb * 32 + 8 * q4 + 4 * lh;
          u32x2 o;
          o.x = pack2(O[eb][4 * q4 + 0], O[eb][4 * q4 + 1]);
          o.y = pack2(O[eb][4 * q4 + 2], O[eb][4 * q4 + 3]);
          *(u32x2*)(ao + (size_t)t * 1024 + hh * 128 + e) = o;
        }
    }
  }
}

DEVI void pool_phase(const Params& p, char* smem) {
  const int tid = otid(), lane = tid & 63, w = tid >> 6;
  float* rs = (float*)smem;
  const float* h = p.out;
  bf16_t* pooled = (bf16_t*)(p.ws + R_POOL);
  for (int tile = vblk(); tile < T_TOK / 32; tile += nvblk()) {
    const int t0 = tile * 32;
    const int pos0 = t0 & (SEQ - 1);
    __syncthreads();
    for (int r = w; r < 47; r += 4) {
      const int pos = pos0 - 15 + r;
      if (pos >= 0) {
        const float* row = h + (size_t)(t0 - 15 + r) * 1024;
        float s = 0.f;
#pragma unroll
        for (int i = 0; i < 4; i++) {
          f32x4 v = *(const f32x4*)(row + i * 256 + lane * 4);
          s += v.x * v.x + v.y * v.y + v.z * v.z + v.w * v.w;
        }
#pragma unroll
        for (int o = 32; o >= 1; o >>= 1) s += __shfl_xor(s, o);
        if (lane == 0) rs[r] = rsqrtf(s * (1.f / 1024.f) + EPS);
      }
    }
    __syncthreads();
    const int c = tid * 4;
    const int grp = c >> 8;
    const int win = 2 << grp;
    f32x4 sum = f32x4{0.f, 0.f, 0.f, 0.f};
    for (int r = -(win - 1); r < 0; r++) {
      if (pos0 + r >= 0) {
        f32x4 v = *(const f32x4*)(h + (size_t)(t0 + r) * 1024 + c);
        const float s = rs[r + 15];
        sum.x += v.x * s; sum.y += v.y * s; sum.z += v.z * s; sum.w += v.w * s;
      }
    }
    for (int r = 0; r < 32; r++) {
      f32x4 v = *(const f32x4*)(h + (size_t)(t0 + r) * 1024 + c);
      const float s = rs[r + 15];
      v.x *= s; v.y *= s; v.z *= s; v.w *= s;
      sum.x += v.x; sum.y += v.y; sum.z += v.z; sum.w += v.w;
      const int pos = pos0 + r;
      const float ic = 1.f / (float)min(pos + 1, win);
      u32x2 o;
      o.x = pack2(sum.x * ic - v.x, sum.y * ic - v.y);
      o.y = pack2(sum.z * ic - v.z, sum.w * ic - v.w);
      *(u32x2*)(pooled + (size_t)(t0 + r) * 1024 + c) = o;
      const int ro = r - win + 1;
      if (pos0 + ro >= 0) {
        f32x4 u = *(const f32x4*)(h + (size_t)(t0 + ro) * 1024 + c);
        const float so = rs[ro + 15];
        sum.x -= u.x * so; sum.y -= u.y * so; sum.z -= u.z * so; sum.w -= u.w * so;
      }
    }
  }
}

DEVI unsigned fkey(float f) {
  unsigned u = __float_as_uint(f);
  return (u & 0x80000000u) ? ~u : (u | 0x80000000u);
}

template <int NR>
DEVI void select_topk(const float* srow, const int c, const int lane, u64* mrow) {
  unsigned kreg[NR];
#pragma unroll
  for (int j = 0; j < NR; j++) {
    const unsigned k = fkey(srow[j * 64 + lane]);
    kreg[j] = (j <= c) ? k : 0u;
  }
  unsigned T = 0u;
  bool exact = false;
#pragma unroll 1
  for (int bit = 31; bit >= 0; bit--) {
    const unsigned cand = T | (1u << bit);
    int cnt = 0;
#pragma unroll
    for (int j = 0; j < NR; j++) cnt += __popcll(__ballot(kreg[j] >= cand));
    if (cnt >= 256) T = cand;
    if (cnt == 256) { exact = true; break; }
  }
  asm volatile("" : "+v"(T));
  if (exact) {
#pragma unroll
    for (int j = 0; j < NR; j++) {
      const u64 bm = __ballot(kreg[j] >= T);
      if (lane == 0) mrow[j] = bm;
    }
  } else {
    int cgt = 0;
#pragma unroll
    for (int j = 0; j < NR; j++) cgt += __popcll(__ballot(kreg[j] > T));
    int need = 256 - cgt;
#pragma unroll
    for (int j = 0; j < NR; j++) {
      const u64 gt = __ballot(kreg[j] > T);
      const u64 eq = __ballot(kreg[j] == T);
      const int rank = __popcll(eq & ((1ull << lane) - 1ull));
      const u64 tk = __ballot((kreg[j] == T) && (rank < need));
      need -= __popcll(eq);
      const u64 bm = gt | tk;
      if (lane == 0) mrow[j] = bm;
    }
  }
}

DEVI void index_unit(const Params& p, int unit, char* smem, volatile __attribute__((address_space(3))) unsigned* gctr, unsigned& gtarget) {
  const int tid = otid(), lane = tid & 63, w = tid >> 6;
  const int l31 = lane & 31, lh = lane >> 5;
  const int c = unit >> 4, b = (unit >> 2) & 3, qr = unit & 3;
  const int t0 = b * SEQ + c * 64 + qr * 16;
  u64* mask = (u64*)(p.ws + R_MASK);
  if (c < 4) {
    if (tid < 16 * (c + 1)) {
      const int q = tid / (c + 1), j = tid % (c + 1);
      u64 ones = ~0ull;
      asm volatile("" : "+v"(ones));
      mask[(size_t)(t0 + q) * 64 + j] = ones;
    }
    return;
  }
  const bf16_t* ciq = (const bf16_t*)(p.ws + R_CIQ);
  const bf16_t* cik = (const bf16_t*)(p.ws + R_CIK);
  const float* ciw = (const float*)(p.ws + R_CIW);
  float* sc = (float*)smem;
  const int nkb = 2 * (c + 1);
  for (int grp = 0; grp < 4; grp++) {
    const int tq = t0 + grp * 4;
    {
      const int a = l31 >> 3, gg = (l31 >> 2) & 1, bq = l31 & 3;
      const int qloc = 2 * gg + (a >> 1), head = (a & 1) * 4 + bq;
      bf16x8 af[4];
#pragma unroll
      for (int ks = 0; ks < 4; ks++) af[ks] = *(const bf16x8*)(ciq + (size_t)(tq + qloc) * 512 + head * 64 + 16 * ks + 8 * lh);
      float wq0[8], wq1[8];
      {
        const f32x4 a0 = *(const f32x4*)(ciw + (size_t)(tq + 2 * lh) * 8), a1 = *(const f32x4*)(ciw + (size_t)(tq + 2 * lh) * 8 + 4);
        const f32x4 b0 = *(const f32x4*)(ciw + (size_t)(tq + 2 * lh + 1) * 8), b1 = *(const f32x4*)(ciw + (size_t)(tq + 2 * lh + 1) * 8 + 4);
        wq0[0] = a0.x; wq0[1] = a0.y; wq0[2] = a0.z; wq0[3] = a0.w; wq0[4] = a1.x; wq0[5] = a1.y; wq0[6] = a1.z; wq0[7] = a1.w;
        wq1[0] = b0.x; wq1[1] = b0.y; wq1[2] = b0.z; wq1[3] = b0.w; wq1[4] = b1.x; wq1[5] = b1.y; wq1[6] = b1.z; wq1[7] = b1.w;
      }
      const int nit = (nkb - w + 3) >> 2;
      const bf16_t* ikb = cik + (size_t)b * SEQ * 64 + 8 * lh;
      bf16x8 nb[4][4];
#pragma unroll
      for (int u = 0; u < 4; u++) {
        const int kb = min(w + 4 * u, nkb - 1);
#pragma unroll
        for (int ks = 0; ks < 4; ks++) nb[u][ks] = *(const bf16x8*)(ikb + (size_t)(kb * 32 + l31) * 64 + 16 * ks);
      }
      for (int it0 = 0; it0 < nit; it0 += 4) {
        bf16x8 cb[4][4];
#pragma unroll
        for (int u = 0; u < 4; u++)
#pragma unroll
          for (int ks = 0; ks < 4; ks++) cb[u][ks] = nb[u][ks];
        if (it0 + 4 < nit) {
#pragma unroll
          for (int u = 0; u < 4; u++) {
            const int kb = min(w + 4 * (it0 + 4 + u), nkb - 1);
#pragma unroll
            for (int ks = 0; ks < 4; ks++) nb[u][ks] = *(const bf16x8*)(ikb + (size_t)(kb * 32 + l31) * 64 + 16 * ks);
          }
        }
#pragma unroll
        for (int u = 0; u < 4; u++) {
          const int kb = w + 4 * (it0 + u);
          f32x16 acc;
#pragma unroll
          for (int r = 0; r < 16; r++) acc[r] = 0.f;
#pragma unroll
          for (int ks = 0; ks < 4; ks++) acc = mfma32(af[ks], cb[u][ks], acc);
          float s0 = 0.f, s1 = 0.f;
#pragma unroll
          for (int r = 0; r < 8; r++) s0 += wq0[r] * fmaxf(acc[r], 0.f);
#pragma unroll
          for (int r = 0; r < 8; r++) s1 += wq1[r] * fmaxf(acc[8 + r], 0.f);
          if (s0 == 0.f) s0 = 0.f;
          if (s1 == 0.f) s1 = 0.f;
          if (kb < nkb) {
            const int key = kb * 32 + l31;
            sc[(2 * lh) * 4096 + key] = s0;
            sc[(2 * lh + 1) * 4096 + key] = s1;
          }
        }
      }
    }
    grp_barrier(gctr, gtarget, lane);
    {
      u64* mrow = mask + (size_t)(tq + w) * 64;
      const float* srow = sc + w * 4096;
      if (c < 16) select_topk<16>(srow, c, lane, mrow);
      else if (c < 32) select_topk<32>(srow, c, lane, mrow);
      else if (c < 48) select_topk<48>(srow, c, lane, mrow);
      else select_topk<64>(srow, c, lane, mrow);
    }
    grp_barrier(gctr, gtarget, lane);
  }
}

DEVI void index_phase(const Params& p, char* smem, volatile __attribute__((address_space(3))) unsigned* gctr, unsigned& gtarget) {
  for (int it2 = vblk() * 2; it2 < 1024; it2 += nvblk() * 2) {
    for (int k = 0; k < 2; k++) {
      const int item = it2 >> 1;
      index_unit(p, k ? item : (1023 - item), smem, gctr, gtarget);
    }
  }
}


#define XB_TMO      128
#define XB_XCNT(j)  (256  + 64 * (j))
#define XB_XSUB(j)  (1280 + 64 * (j))
#define XB_XGEN(j)  (2304 + 64 * (j))
#define XB_TOP      3328
#define XB_TOPGEN   3392
#define XCD_BAR_WORDS 3456
#define XB_SPIN_CAP (1u << 22)
#define LAS __attribute__((address_space(3)))
constexpr size_t OFF_BAR = 250 * MB;

DEVI unsigned xb_ld(unsigned* p)              { return __hip_atomic_load(p, __ATOMIC_RELAXED, __HIP_MEMORY_SCOPE_AGENT); }
DEVI unsigned xb_add(unsigned* p, unsigned v) { return __hip_atomic_fetch_add(p, v, __ATOMIC_RELAXED, __HIP_MEMORY_SCOPE_AGENT); }
DEVI unsigned xb_xcc_id() { return (unsigned)__builtin_amdgcn_s_getreg((3 << 11) | 20) & 0xFu; }
#define XB_SPIN(cond, bar) do { unsigned _sp = 0; while (cond) { __builtin_amdgcn_s_sleep(1); \
    if ((++_sp & 255u) == 0u) { if (xb_ld(&(bar)[XB_TMO])) break; if (_sp > XB_SPIN_CAP) { atomicAdd(&(bar)[XB_TMO], 1u); break; } } } } while (0)

struct XcdBarrier { unsigned* bar; volatile LAS unsigned* st; };

DEVI XcdBarrier xcd_barrier_post(unsigned* bar, volatile LAS unsigned* st) {
  XcdBarrier b; b.bar = bar; b.st = st;
  if (threadIdx.x == 0) (void)xb_add(&bar[XB_XCNT(xb_xcc_id())], 1u);
  return b;
}
DEVI void xcd_barrier_complete(unsigned* bar, unsigned x, unsigned& nloc, unsigned& nx) {
  const unsigned G = gridDim.x * gridDim.y * gridDim.z;
  unsigned sum, cnt, mine, sp = 0u;
  for (;;) {
    sum = 0u; cnt = 0u; mine = 0u;
#pragma unroll
    for (unsigned j = 0; j < 16; ++j) { const unsigned c = xb_ld(&bar[XB_XCNT(j)]); sum += c; cnt += (c > 0u) ? 1u : 0u; mine = (j == x) ? c : mine; }
    if (sum == G) break;
    __builtin_amdgcn_s_sleep(1);
    if ((++sp & 255u) == 0u) { if (xb_ld(&bar[XB_TMO])) break; if (sp > XB_SPIN_CAP) { atomicAdd(&bar[XB_TMO], 1u); break; } }
  }
  nloc = mine > 0u ? mine : 1u; nx = cnt > 0u ? cnt : 1u;
}
DEVI void xcd_barrier(const XcdBarrier& b) {
  asm volatile("s_waitcnt vmcnt(0)" ::: "memory");
  __syncthreads();
  if (threadIdx.x == 0) {
    unsigned* bar = b.bar;
    const unsigned bx = xb_xcc_id();
    __builtin_amdgcn_s_waitcnt(0);
    unsigned nloc = b.st[0], nx = b.st[1];
    if (nloc == 0u) { xcd_barrier_complete(bar, bx, nloc, nx); b.st[0] = nloc; b.st[1] = nx; }
    const unsigned old = xb_add(&bar[XB_XSUB(bx)], 1u);
    const unsigned gen = old / nloc;
    if (old + 1u == (gen + 1u) * nloc) {
      __builtin_amdgcn_fence(__ATOMIC_RELEASE, "agent");
      asm volatile("s_waitcnt vmcnt(0)" ::: "memory");
      const unsigned og = xb_add(&bar[XB_TOP], 1u);
      const unsigned tg = og / nx;
      if (og + 1u == (tg + 1u) * nx) xb_add(&bar[XB_TOPGEN], 1u);
      else XB_SPIN(xb_ld(&bar[XB_TOPGEN]) == tg, bar);
      __builtin_amdgcn_fence(__ATOMIC_ACQUIRE, "agent");
      xb_add(&bar[XB_XGEN(bx)], 1u);
      asm volatile("s_waitcnt vmcnt(0)" ::: "memory");
    } else {
      XB_SPIN(xb_ld(&bar[XB_XGEN(bx)]) == gen, bar);
      __builtin_amdgcn_fence(__ATOMIC_ACQUIRE, "agent");
      asm volatile("s_waitcnt vmcnt(0)" ::: "memory");
    }
  }
  __syncthreads();
}

__global__ void __launch_bounds__(512, 2) fwd_megakernel(Params p) {
  __shared__ __attribute__((aligned(16))) char smem[SMEM_BYTES];
  cg::grid_group grid = cg::this_grid();
  char* gs = smem + grp_id() * 65536;
  char* ws = p.ws;
  __shared__ __attribute__((aligned(16))) unsigned xb_words[4];
  if (threadIdx.x == 0) { xb_words[0] = 0u; xb_words[1] = 0u; xb_words[2] = 0u; xb_words[3] = 0u; }
  __syncthreads();
  volatile LAS unsigned* gctr = (volatile LAS unsigned*)&xb_words[2 + grp_id()];
  unsigned gtarget = 0u;
  const XcdBarrier xb = xcd_barrier_post((unsigned*)(ws + OFF_BAR), (volatile LAS unsigned*)xb_words);
  if (gridDim.y == 0x7fffffffu) grid.sync();
  bf16_t* hb = (bf16_t*)(ws + OFF_HB);

  for (int rep = 0; rep <= DUP_CONV; rep++) convert_phase(p, gs);
  xcd_barrier(xb);

  for (int layer = 0; layer < 4; layer++) {
    const int mixer = layer % 3, jl = layer / 3;
    const float* resid_src = (layer == 0) ? p.x : p.out;
    if (mixer == 0) {
      const float lambda_init = (layer == 0) ? 0.2f : 0.5560582041564594f;
      {
        GemmArgs ga{};
      ga.ssq = (float*)(ws + OFF_SSQ);
        ga.ssq = (float*)(ws + OFF_SSQ);
        ga.A = hb; ga.lda = 1024; ga.Bt = (const bf16_t*)(ws + OFF_AIN + (size_t)jl * 6 * MB); ga.K = 1024; ga.NT = 12;
        ga.o0 = ws + R_QK; ga.o1 = ws + R_VT; ga.g0 = p.a_q_g + jl * 64; ga.g1 = p.a_k_g + jl * 64;
        for (int rep = 0; rep <= DUP_GEMM; rep++) gemm_phase<M_AQKV, 1024>(ga, smem);
      }
      xcd_barrier(xb);
      for (int rep = 0; rep <= DUP_ATTNA; rep++) attnA_phase(p, jl, lambda_init, gs, gctr, gtarget);
      xcd_barrier(xb);
      {
        GemmArgs ga{};
      ga.ssq = (float*)(ws + OFF_SSQ);
        ga.ssq = (float*)(ws + OFF_SSQ);
        ga.A = (const bf16_t*)(ws + R_AO); ga.lda = 1024; ga.Bt = (const bf16_t*)(ws + OFF_AOUT + (size_t)jl * 2 * MB); ga.K = 1024; ga.NT = 4;
        ga.o0 = p.out; ga.o1 = hb; ga.resid = resid_src;
        gemm_phase<M_RESID, 1024>(ga, smem);
      }
      xcd_barrier(xb);
    } else if (mixer == 1) {
      pool_phase(p, gs);
      xcd_barrier(xb);
      {
        GemmArgs ga{};
      ga.ssq = (float*)(ws + OFF_SSQ);
        ga.ssq = (float*)(ws + OFF_SSQ);
        ga.A = (const bf16_t*)(ws + R_POOL); ga.lda = 1024; ga.Bt = (const bf16_t*)(ws + OFF_BW); ga.K = 256; ga.NT = 4;
        ga.o0 = p.out; ga.o1 = hb; ga.resid = resid_src; ga.g0 = p.b_scale;
        gemm_phase<M_POOL, 256>(ga, smem);
      }
      xcd_barrier(xb);
    } else {
      {
        GemmArgs ga{};
      ga.ssq = (float*)(ws + OFF_SSQ);
        ga.ssq = (float*)(ws + OFF_SSQ);
        ga.A = hb; ga.lda = 1024; ga.Bt = (const bf16_t*)(ws + OFF_CIN); ga.K = 1024; ga.NT = 9;
        ga.o0 = ws + R_CQ; ga.o1 = ws + R_CK; ga.o2 = ws + R_CVT; ga.o3 = ws + R_CIQ; ga.o4 = ws + R_CIK; ga.o5 = ws + R_CIW;
        ga.g0 = p.c_q_g; ga.g1 = p.c_k_g;
        for (int rep = 0; rep <= DUP_GEMM; rep++) gemm_phase<M_CIN, 1024>(ga, smem);
      }
      xcd_barrier(xb);
      for (int rep = 0; rep <= DUP_IDX; rep++) index_phase(p, gs, gctr, gtarget);
      xcd_barrier(xb);
      for (int rep = 0; rep <= DUP_ATTNC; rep++) attnC_phase(p, gs, gctr, gtarget);
      xcd_barrier(xb);
      {
        GemmArgs ga{};
      ga.ssq = (float*)(ws + OFF_SSQ);
        ga.ssq = (float*)(ws + OFF_SSQ);
        ga.A = (const bf16_t*)(ws + R_AO); ga.lda = 1024; ga.Bt = (const bf16_t*)(ws + OFF_COUT); ga.K = 1024; ga.NT = 4;
        ga.o0 = p.out; ga.o1 = hb; ga.resid = resid_src;
        gemm_phase<M_RESID, 1024>(ga, smem);
      }
      xcd_barrier(xb);
    }
    {
      GemmArgs ga{};
      ga.ssq = (float*)(ws + OFF_SSQ);
      ga.A = hb; ga.lda = 1024; ga.Bt = (const bf16_t*)(ws + OFF_W1 + (size_t)layer * 8 * MB); ga.K = 1024; ga.NT = 16;
      ga.o0 = ws + R_HID;
      for (int rep = 0; rep <= DUP_GEMM; rep++) gemm_phase<M_MLP1, 1024>(ga, smem);
    }
    xcd_barrier(xb);
    {
      GemmArgs ga{};
      ga.ssq = (float*)(ws + OFF_SSQ);
      ga.A = (const bf16_t*)(ws + R_HID); ga.lda = 4096; ga.Bt = (const bf16_t*)(ws + OFF_W2 + (size_t)layer * 8 * MB); ga.K = 4096; ga.NT = 4;
      ga.o0 = p.out; ga.o1 = hb; ga.resid = p.out;
      gemm_phase<M_RESID, 4096>(ga, smem);
    }
    if (layer < 3) xcd_barrier(xb);
  }
}

extern "C" void kernel_launch(void* const* d_in, const int* in_sizes, int n_in, void* d_out, int out_size,
                              void* d_ws, size_t ws_size, hipStream_t stream) {
  static int grid_blocks = 0;
  if (!grid_blocks) {
    int dev = 0, cus = 0, per_cu = 0;
    hipGetDevice(&dev);
    hipDeviceGetAttribute(&cus, hipDeviceAttributeMultiprocessorCount, dev);
    hipOccupancyMaxActiveBlocksPerMultiprocessor(&per_cu, fwd_megakernel, 512, 0);
    if (per_cu > 1) per_cu = 1;
    if (per_cu < 1) per_cu = 1;
    grid_blocks = cus * per_cu;
  }
  if (ws_size < WS_NEED) { fprintf(stderr, "workspace too small: %zu < %zu\n", ws_size, (size_t)WS_NEED); return; }
  Params p{};
  p.x = (const float*)d_in[0]; p.norm1_g = (const float*)d_in[1]; p.norm2_g = (const float*)d_in[2];
  p.a_w_in = (const float*)d_in[3]; p.a_q_g = (const float*)d_in[4]; p.a_k_g = (const float*)d_in[5];
  p.a_lq1 = (const float*)d_in[6]; p.a_lk1 = (const float*)d_in[7]; p.a_lq2 = (const float*)d_in[8]; p.a_lk2 = (const float*)d_in[9];
  p.a_sub_g = (const float*)d_in[10]; p.a_w_out = (const float*)d_in[11];
  p.b_w = (const float*)d_in[12]; p.b_scale = (const float*)d_in[13];
  p.c_w_in = (const float*)d_in[14]; p.c_q_g = (const float*)d_in[15]; p.c_k_g = (const float*)d_in[16]; p.c_w_out = (const float*)d_in[17];
  p.w1 = (const float*)d_in[18]; p.w2 = (const float*)d_in[19];
  p.out = (float*)d_out; p.ws = (char*)d_ws;
  hipMemsetAsync((char*)d_ws + OFF_BAR, 0, XCD_BAR_WORDS * sizeof(unsigned), stream);
  void* args[] = {&p};
  hipError_t e = hipLaunchCooperativeKernel((void*)fwd_megakernel, dim3(grid_blocks), dim3(512), args, 0, stream);
  if (e != hipSuccess) fprintf(stderr, "cooperative launch failed: %s (grid %d)\n", hipGetErrorString(e), grid_blocks);
}
```

```cpp
#include <hip/hip_runtime.h>
#include <hip/hip_cooperative_groups.h>
#include <cstdio>
namespace cg = cooperative_groups;

typedef unsigned short bf16_t;
typedef __attribute__((ext_vector_type(8))) short bf16x8;
typedef __attribute__((ext_vector_type(16))) float f32x16;
typedef unsigned long long u64;
typedef unsigned __attribute__((ext_vector_type(4))) u32x4;
typedef unsigned __attribute__((ext_vector_type(2))) u32x2;
typedef float __attribute__((ext_vector_type(4))) f32x4;

#define DEVI __device__ __forceinline__
#define DUP_GEMM 0
#define DUP_ATTNA 0
#define DUP_IDX 0
#define DUP_ATTNC 0
#define DUP_CONV 0

constexpr int T_TOK = 16384;
constexpr int DM = 1024;
constexpr int SEQ = 4096;
constexpr float EPS = 1e-6f;
constexpr float LOG2E = 1.4426950408889634f;
constexpr size_t MB = 1ull << 20;

constexpr size_t OFF_W1 = 0;
constexpr size_t OFF_W2 = 32 * MB;
constexpr size_t OFF_AIN = 64 * MB;
constexpr size_t OFF_AOUT = 76 * MB;
constexpr size_t OFF_BW = 80 * MB;
constexpr size_t OFF_CIN = 81 * MB;
constexpr size_t OFF_COUT = 86 * MB;
constexpr size_t OFF_HB = 88 * MB;
constexpr size_t OFF_R = 120 * MB;
constexpr size_t OFF_SSQ = 249 * MB;
constexpr size_t WS_NEED = 251 * MB;
constexpr size_t R_QK = OFF_R;
constexpr size_t R_VT = OFF_R + 64 * MB;
constexpr size_t R_AO = OFF_R + 96 * MB;
constexpr size_t R_HID = OFF_R;
constexpr size_t R_POOL = OFF_R;
constexpr size_t R_CQ = OFF_R;
constexpr size_t R_CK = OFF_R + 32 * MB;
constexpr size_t R_CVT = OFF_R + 40 * MB;
constexpr size_t R_CIQ = OFF_R + 48 * MB;
constexpr size_t R_CIK = OFF_R + 64 * MB;
constexpr size_t R_CIW = OFF_R + 66 * MB;
constexpr size_t R_MASK = OFF_R + 67 * MB;

struct Params {
  const float* x; const float* norm1_g; const float* norm2_g;
  const float* a_w_in; const float* a_q_g; const float* a_k_g;
  const float* a_lq1; const float* a_lk1; const float* a_lq2; const float* a_lk2;
  const float* a_sub_g; const float* a_w_out;
  const float* b_w; const float* b_scale;
  const float* c_w_in; const float* c_q_g; const float* c_k_g; const float* c_w_out;
  const float* w1; const float* w2;
  float* out; char* ws;
};

DEVI bf16_t f2bf(float f) {
  return __builtin_bit_cast(bf16_t, (__bf16)f);
}
typedef __bf16 bf16x2_t __attribute__((ext_vector_type(2)));
DEVI unsigned pack2(float a, float b) {
  bf16x2_t v;
  v.x = (__bf16)a; v.y = (__bf16)b;
  return __builtin_bit_cast(unsigned, v);
}
DEVI float bf_lo(unsigned p) { return __uint_as_float(p << 16); }
DEVI float bf_hi(unsigned p) { return __uint_as_float(p & 0xffff0000u); }
DEVI float fexp2(float x) { return __builtin_amdgcn_exp2f(x); }

template <int ROWB>
DEVI int lds_off(int row, int chunk) {
  if (ROWB == 128) return row * 128 + ((chunk ^ ((row >> 1) & 7)) << 4);
  else return row * 256 + ((chunk ^ (row & 15)) << 4);
}

DEVI f32x16 mfma32(bf16x8 a, bf16x8 b, f32x16 c) {
  return __builtin_amdgcn_mfma_f32_32x32x16_bf16(a, b, c, 0, 0, 0);
}

constexpr int SMEM_BYTES = 131072 + 1024 + 4096;

DEVI int otid() { int t = threadIdx.x & 255; asm volatile("" : "+v"(t)); return t; }
DEVI int otid512() { int t = threadIdx.x; asm volatile("" : "+v"(t)); return t; }
DEVI int grp_id() { return __builtin_amdgcn_readfirstlane((int)(threadIdx.x >> 8)); }
DEVI int vblk() { return (int)blockIdx.x * 2 + grp_id(); }
DEVI int nvblk() { return (int)gridDim.x * 2; }

struct Job { const float* src; bf16_t* dst; const float* gain; int K, N, NP; };

DEVI Job get_job(const Params& p, int j) {
  Job jb;
  char* ws = p.ws;
  if (j < 4) {
    jb.src = p.w1 + (size_t)j * 1024 * 4096; jb.dst = (bf16_t*)(ws + OFF_W1 + (size_t)j * 8 * MB);
    jb.gain = p.norm2_g + j * 1024; jb.K = 1024; jb.N = 4096; jb.NP = 4096;
  } else if (j < 8) {
    int i = j - 4;
    jb.src = p.w2 + (size_t)i * 1024 * 4096; jb.dst = (bf16_t*)(ws + OFF_W2 + (size_t)i * 8 * MB);
    jb.gain = nullptr; jb.K = 4096; jb.N = 1024; jb.NP = 1024;
  } else if (j < 10) {
    int i = j - 8;
    jb.src = p.a_w_in + (size_t)i * 1024 * 3072; jb.dst = (bf16_t*)(ws + OFF_AIN + (size_t)i * 6 * MB);
    jb.gain = p.norm1_g + (i == 0 ? 0 : 3) * 1024; jb.K = 1024; jb.N = 3072; jb.NP = 3072;
  } else if (j < 12) {
    int i = j - 10;
    jb.src = p.a_w_out + (size_t)i * 1024 * 1024; jb.dst = (bf16_t*)(ws + OFF_AOUT + (size_t)i * 2 * MB);
    jb.gain = nullptr; jb.K = 1024; jb.N = 1024; jb.NP = 1024;
  } else if (j < 16) {
    int g = j - 12;
    jb.src = p.b_w + (size_t)g * 65536; jb.dst = (bf16_t*)(ws + OFF_BW) + (size_t)g * 65536;
    jb.gain = p.norm1_g + 1024 + g * 256; jb.K = 256; jb.N = 256; jb.NP = 256;
  } else if (j == 16) {
    jb.src = p.c_w_in; jb.dst = (bf16_t*)(ws + OFF_CIN);
    jb.gain = p.norm1_g + 2 * 1024; jb.K = 1024; jb.N = 2120; jb.NP = 2304;
  } else {
    jb.src = p.c_w_out; jb.dst = (bf16_t*)(ws + OFF_COUT);
    jb.gain = nullptr; jb.K = 1024; jb.N = 1024; jb.NP = 1024;
  }
  return jb;
}
constexpr int NJOBS = 18;

DEVI void convert_phase(const Params& p, char* smem) {
  const int tid = otid();
  float* t = (float*)smem;
  int total = 0;
  for (int j = 0; j < NJOBS; j++) { Job jb = get_job(p, j); total += (jb.K / 64) * (jb.NP / 64); }
  const int vb = vblk(), nvb = nvblk();
  Job jb; int k0 = 0, n0 = 0; bool act;
  f32x4 vc[4], vn[4];
#define CV_LOCATE(TILE, JB, K0, N0, ACT)                                                 \
  { ACT = (TILE) < total;                                              \
    int rem = ACT ? (TILE) : 0, j = 0;                                                   \
    JB = get_job(p, 0);                                                                  \
    for (;;) { int nt = (JB.K / 64) * (JB.NP / 64); if (rem < nt) break; rem -= nt; j++; JB = get_job(p, j); } \
    const int ntn = JB.NP / 64;                                                          \
    K0 = (rem / ntn) * 64; N0 = (rem % ntn) * 64; }
#define CV_LOAD(V, JB, K0, N0, ACT)                                                      \
  _Pragma("unroll") for (int i = 0; i < 4; i++) {                                        \
    const int kk = (tid >> 4) + 16 * i, n = (N0) + (tid & 15) * 4;                       \
    V[i] = f32x4{0.f, 0.f, 0.f, 0.f};                                                    \
    if ((ACT) && n < JB.N) V[i] = *(const f32x4*)(JB.src + (size_t)((K0) + kk) * JB.N + n); }
  CV_LOCATE(vb, jb, k0, n0, act)
  CV_LOAD(vc, jb, k0, n0, act)
  for (int base = 0; base < total; base += nvb) {
    if (act) {
#pragma unroll
      for (int i = 0; i < 4; i++) {
        const int kk = (tid >> 4) + 16 * i, nn = (tid & 15) * 4;
        t[kk * 65 + nn + 0] = vc[i].x; t[kk * 65 + nn + 1] = vc[i].y; t[kk * 65 + nn + 2] = vc[i].z; t[kk * 65 + nn + 3] = vc[i].w;
      }
    }
    Job jbn; int k0n = 0, n0n = 0; bool actn;
    CV_LOCATE(base + nvb + vb, jbn, k0n, n0n, actn)
    CV_LOAD(vn, jbn, k0n, n0n, actn)
    __syncthreads();
    if (act) {
      const int nl = tid >> 2, kq = tid & 3;
      unsigned pk[8];
#pragma unroll
      for (int i = 0; i < 8; i++) {
        int k = kq * 16 + 2 * i;
        float a = t[k * 65 + nl], b = t[(k + 1) * 65 + nl];
        if (jb.gain) { a *= jb.gain[k0 + k]; b *= jb.gain[k0 + k + 1]; }
        pk[i] = pack2(a, b);
      }
      u32x4* d = (u32x4*)(jb.dst + (size_t)(n0 + nl) * jb.K + k0 + kq * 16);
      d[0] = u32x4{pk[0], pk[1], pk[2], pk[3]};
      d[1] = u32x4{pk[4], pk[5], pk[6], pk[7]};
    }
    __syncthreads();
    jb = jbn; k0 = k0n; n0 = n0n; act = actn;
#pragma unroll
    for (int i = 0; i < 4; i++) vc[i] = vn[i];
  }
#undef CV_LOCATE
#undef CV_LOAD
  bf16_t* hb = (bf16_t*)(p.ws + OFF_HB);
  float* ssqp = (float*)(p.ws + OFF_SSQ);
  {
    const int lane = tid & 63, wv = tid >> 6;
    for (int row = vb * 4 + wv; row < T_TOK; row += nvb * 4) {
      const float* xr = p.x + (size_t)row * DM;
      float ssum = 0.f;
#pragma unroll
      for (int i = 0; i < 2; i++) {
        const int c = i * 512 + lane * 8;
        f32x4 a = *(const f32x4*)(xr + c), b = *(const f32x4*)(xr + c + 4);
        ssum += a.x * a.x + a.y * a.y + a.z * a.z + a.w * a.w + b.x * b.x + b.y * b.y + b.z * b.z + b.w * b.w;
        *(u32x4*)(hb + (size_t)row * DM + c) = u32x4{pack2(a.x, a.y), pack2(a.z, a.w), pack2(b.x, b.y), pack2(b.z, b.w)};
      }
#pragma unroll
      for (int o = 32; o >= 1; o >>= 1) ssum += __shfl_xor(ssum, o);
      if (lane < 16) ssqp[(size_t)row * 16 + lane] = (lane == 0) ? ssum : 0.f;
    }
  }
}

DEVI void wave_put_bf16(char* wbuf, const int ml, const int nt, const int q4, const int lh, const u32x2 v) {
  const int chunk = nt * 4 + q4;
  *(u32x2*)(wbuf + ml * 128 + ((chunk ^ (ml & 7)) << 4) + 8 * lh) = v;
}
DEVI void wave_flush_bf16(char* wbuf, bf16_t* dst, const int stride, const int lane) {
  const int c = lane & 7;
#pragma unroll
  for (int i = 0; i < 8; i++) {
    const int row = i * 8 + (lane >> 3);
    const u32x4 v = *(const u32x4*)(wbuf + row * 128 + ((c ^ (row & 7)) << 4));
    *(u32x4*)(dst + (size_t)row * stride + c * 8) = v;
  }
}

enum { M_AQKV = 0, M_CIN = 1, M_RESID = 2, M_MLP1 = 3, M_POOL = 4 };

struct GemmArgs {
  const bf16_t* A; int lda; const bf16_t* Bt; int K; int NT;
  void* o0; void* o1; void* o2; void* o3; void* o4; void* o5;
  const float* g0; const float* g1; const float* resid; float* ssq;
};

template <int MODE, int KC>
DEVI void gemm_phase(const GemmArgs& ga, char* smem) {
  constexpr bool NORM = (MODE == M_AQKV || MODE == M_CIN || MODE == M_MLP1);
  const int tid = otid512(), lane = tid & 63, w = tid >> 6;
  const int wn = w & 3, wm = w >> 2;
  const int l31 = lane & 31, lh = lane >> 5;
  float* rs_lds = (float*)(smem + 131072);
  float* xch = (float*)(smem + 131072 + 1024);
  constexpr int K = KC;
  constexpr int KT = K / 64;
  const int NT256 = ga.NT;
  const int ntiles = (T_TOK / 256) * NT256;
  for (int tile = blockIdx.x; tile < ntiles; tile += gridDim.x) {
    const int tn256 = tile % NT256, tm = tile / NT256;
    const int m0 = tm * 256;
    const bf16_t* Ab = ga.A + (size_t)m0 * ga.lda + (MODE == M_POOL ? tn256 * 256 : 0);
    const bf16_t* Bb = ga.Bt + (size_t)tn256 * 256 * K;
    f32x16 acc[2][4];
#pragma unroll
    for (int a = 0; a < 2; a++)
#pragma unroll
      for (int b = 0; b < 4; b++)
#pragma unroll
        for (int r = 0; r < 16; r++) acc[a][b][r] = 0.f;
    u32x4 rw0[4], rx0[4];
    int ttid = tid;
    asm volatile("" : "+v"(ttid));
    const int ldsb = lds_off<128>(ttid >> 3, ttid & 7);
    const unsigned woff0 = (unsigned)((ttid >> 3) * K + (ttid & 7) * 8) * 2u;
    const unsigned xoff0 = (unsigned)((ttid >> 3) * ga.lda + (ttid & 7) * 8) * 2u;
#define G_LOAD(RW, RX, KTI)                                                              \
  _Pragma("unroll") for (int j = 0; j < 4; j++) {                                        \
    RW[j] = *(const u32x4*)((const char*)Bb + (size_t)(KTI) * 128 + (size_t)j * 64 * K * 2 + woff0);            \
    RX[j] = *(const u32x4*)((const char*)Ab + (size_t)(KTI) * 128 + (size_t)j * 64 * ga.lda * 2 + xoff0);      \
  }
#define G_STORE(RW, RX, S)                                                               \
  _Pragma("unroll") for (int j = 0; j < 4; j++) {                                        \
    *(u32x4*)(smem + (S) * 32768 + ldsb + j * 8192) = RW[j];            \
    *(u32x4*)(smem + 65536 + (S) * 32768 + ldsb + j * 8192) = RX[j];                     \
  }
#define G_COMPUTE_KS(S, KS0, KS1)                                                        \
  _Pragma("unroll") for (int ks = KS0; ks < KS1; ks++) {                                 \
    bf16x8 wf[2], xf[4];                                                                 \
    _Pragma("unroll") for (int nt = 0; nt < 2; nt++)                                     \
      wf[nt] = *(const bf16x8*)(smem + (S) * 32768 + lds_off<128>(wn * 64 + nt * 32 + l31, 2 * ks + lh)); \
    _Pragma("unroll") for (int mt = 0; mt < 4; mt++)                                     \
      xf[mt] = *(const bf16x8*)(smem + 65536 + (S) * 32768 + lds_off<128>(wm * 128 + mt * 32 + l31, 2 * ks + lh)); \
    _Pragma("unroll") for (int nt = 0; nt < 2; nt++)                                     \
      _Pragma("unroll") for (int mt = 0; mt < 4; mt++) acc[nt][mt] = mfma32(wf[nt], xf[mt], acc[nt][mt]); \
  }
#define G_KS_SPLIT(S, KSI, MID, END)                                                     \
  { bf16x8 wf[2], xf[2];                                                                 \
    _Pragma("unroll") for (int nt = 0; nt < 2; nt++)                                     \
      wf[nt] = *(const bf16x8*)(smem + (S) * 32768 + lds_off<128>(wn * 64 + nt * 32 + l31, 2 * (KSI) + lh)); \
    _Pragma("unroll") for (int mt = 0; mt < 2; mt++)                                     \
      xf[mt] = *(const bf16x8*)(smem + 65536 + (S) * 32768 + lds_off<128>(wm * 128 + mt * 32 + l31, 2 * (KSI) + lh)); \
    _Pragma("unroll") for (int nt = 0; nt < 2; nt++)                                     \
      _Pragma("unroll") for (int mt = 0; mt < 2; mt++) acc[nt][mt] = mfma32(wf[nt], xf[mt], acc[nt][mt]); \
    MID                                                                                  \
    _Pragma("unroll") for (int mt = 0; mt < 2; mt++)                                     \
      xf[mt] = *(const bf16x8*)(smem + 65536 + (S) * 32768 + lds_off<128>(wm * 128 + (2 + mt) * 32 + l31, 2 * (KSI) + lh)); \
    _Pragma("unroll") for (int nt = 0; nt < 2; nt++)                                     \
      _Pragma("unroll") for (int mt = 0; mt < 2; mt++) acc[nt][2 + mt] = mfma32(wf[nt], xf[mt], acc[nt][2 + mt]); \
    END }
#define G_LD2(RW, RX, KTI, A)                                                            \
  { RW[A] = *(const u32x4*)((const char*)Bb + (size_t)(KTI) * 128 + (size_t)(A) * 64 * K * 2 + woff0);          \
    RX[A] = *(const u32x4*)((const char*)Ab + (size_t)(KTI) * 128 + (size_t)(A) * 64 * ga.lda * 2 + xoff0); }
#define G_ST2(RW, RX, S, A)                                                              \
  { *(u32x4*)(smem + (S) * 32768 + ldsb + (A) * 8192) = RW[A];                           \
    *(u32x4*)(smem + 65536 + (S) * 32768 + ldsb + (A) * 8192) = RX[A]; }
    G_LOAD(rw0, rx0, 0)
    G_STORE(rw0, rx0, 0)
    __syncthreads();
    if (NORM) {
      if (tid < 256) {
        const f32x4* sp = (const f32x4*)(ga.ssq + (size_t)(m0 + tid) * 16);
        const f32x4 a = sp[0], b = sp[1], c = sp[2], d = sp[3];
        const float tot = (a.x + a.y + a.z + a.w) + (b.x + b.y + b.z + b.w) + (c.x + c.y + c.z + c.w) + (d.x + d.y + d.z + d.w);
        rs_lds[tid] = rsqrtf(tot * (1.f / 1024.f) + EPS);
      }
    }
#pragma unroll 1
    for (int kt = 0; kt < KT; kt += 2) {
      const bool more = (kt + 2 < KT);
      G_LD2(rw0, rx0, kt + 1, 0)
      asm volatile("" ::: "memory");
      G_KS_SPLIT(0, 0, G_LD2(rw0, rx0, kt + 1, 1) asm volatile("" ::: "memory");, G_LD2(rw0, rx0, kt + 1, 2) asm volatile("" ::: "memory");)
      G_KS_SPLIT(0, 1, G_LD2(rw0, rx0, kt + 1, 3) asm volatile("" ::: "memory");, )
      G_ST2(rw0, rx0, 1, 0)
      G_KS_SPLIT(0, 2, G_ST2(rw0, rx0, 1, 1), G_ST2(rw0, rx0, 1, 2))
      G_KS_SPLIT(0, 3, G_ST2(rw0, rx0, 1, 3), )
      __syncthreads();
      if (more) { G_LD2(rw0, rx0, kt + 2, 0) }
      asm volatile("" ::: "memory");
      G_KS_SPLIT(1, 0, if (more) { G_LD2(rw0, rx0, kt + 2, 1) } asm volatile("" ::: "memory");, if (more) { G_LD2(rw0, rx0, kt + 2, 2) } asm volatile("" ::: "memory");)
      G_KS_SPLIT(1, 1, if (more) { G_LD2(rw0, rx0, kt + 2, 3) } asm volatile("" ::: "memory");, )
      if (more) { G_ST2(rw0, rx0, 0, 0) }
      G_KS_SPLIT(1, 2, if (more) { G_ST2(rw0, rx0, 0, 1) }, if (more) { G_ST2(rw0, rx0, 0, 2) })
      G_KS_SPLIT(1, 3, if (more) { G_ST2(rw0, rx0, 0, 3) }, )
      __syncthreads();
    }
#undef G_LOAD
#undef G_STORE
#undef G_COMPUTE_KS
#undef G_KS_SPLIT
#undef G_LD2
#undef G_ST2
    float rstd[4] = {1.f, 1.f, 1.f, 1.f};
    if (NORM) {
#pragma unroll
      for (int mt = 0; mt < 4; mt++) rstd[mt] = rs_lds[wm * 128 + mt * 32 + l31];
    }
    int el31 = l31, elh = lh, ewn = wn & 1, ewm = wm, elane = lane, ewq = wn >> 1, eww = w;
    asm volatile("" : "+v"(el31), "+v"(elh), "+v"(ewn), "+v"(ewm), "+v"(elane), "+v"(ewq), "+v"(eww));
    const int tn = tn256 * 2 + __builtin_amdgcn_readfirstlane(ewq);
    const int n0 = tn * 128;
    char* wbuf = smem + eww * 16384;
    const int mw0 = m0 + ewm * 128;
    if (MODE == M_AQKV) {
      const int nw = n0 + ewn * 64;
      if (n0 < 2048) {
        const float* g = (n0 < 1024) ? ga.g0 : ga.g1;
        const float post = (n0 < 1024) ? (0.125f * LOG2E) : 1.f;
#pragma unroll
        for (int h = 0; h < 2; h++) {
#pragma unroll
          for (int mh = 0; mh < 2; mh++) {
            const int mt = 2 * h + mh;
            float s = 0.f;
#pragma unroll
            for (int nt = 0; nt < 2; nt++)
#pragma unroll
              for (int r = 0; r < 16; r++) { float v = acc[nt][mt][r] * rstd[mt]; acc[nt][mt][r] = v; s += v * v; }
            s += __shfl_xor(s, 32);
            const float hn = rsqrtf(s * (1.f / 64.f) + EPS) * post;
#pragma unroll
            for (int nt = 0; nt < 2; nt++)
#pragma unroll
              for (int q4 = 0; q4 < 4; q4++) {
                const int d = nt * 32 + 8 * q4 + 4 * elh;
                const f32x4 gv = *(const f32x4*)(g + d);
                { u32x2 pv; pv.x = pack2(acc[nt][mt][4 * q4 + 0] * hn * gv.x, acc[nt][mt][4 * q4 + 1] * hn * gv.y); pv.y = pack2(acc[nt][mt][4 * q4 + 2] * hn * gv.z, acc[nt][mt][4 * q4 + 3] * hn * gv.w); wave_put_bf16(wbuf, mh * 32 + el31, nt, q4, elh, pv); }
              }
          }
          wave_flush_bf16(wbuf, (bf16_t*)ga.o0 + (size_t)(mw0 + h * 64) * 2048 + nw, 2048, elane);
        }
      } else {
        bf16_t* vt = (bf16_t*)ga.o1;
        const int nn = nw - 2048, head = nn >> 7, e0 = nn & 127;
#pragma unroll
        for (int mt = 0; mt < 4; mt++) {
          const int m = mw0 + mt * 32 + el31;
          const int b = m >> 12, s = m & 4095;
          bf16_t* vp = vt + ((size_t)(b * 8 + head) * 128 + e0 + 4 * elh) * 4096 + s;
          asm volatile("" : "+v"(vp));
#pragma unroll
          for (int nt = 0; nt < 2; nt++)
#pragma unroll
            for (int r = 0; r < 16; r++)
              vp[(size_t)(nt * 32 + (r & 3) + 8 * (r >> 2)) * 4096] = f2bf(acc[nt][mt][r] * rstd[mt]);
        }
      }
    } else if (MODE == M_CIN) {
      if (tn < 10) {
#pragma unroll
        for (int mt = 0; mt < 4; mt++) {
          float s = 0.f;
#pragma unroll
          for (int nt = 0; nt < 2; nt++)
#pragma unroll
            for (int r = 0; r < 16; r++) { float v = acc[nt][mt][r] * rstd[mt]; acc[nt][mt][r] = v; s += v * v; }
          s += __shfl_xor(s, 32);
          if (elh == 0) xch[(ewq * 2 + ewn) * 256 + ewm * 128 + mt * 32 + el31] = s;
        }
        __syncthreads();
        const float* g = (tn < 8) ? ga.g0 : ga.g1;
        const float post = (tn < 8) ? (0.08838834764831845f * LOG2E) : 1.f;
#pragma unroll
        for (int h = 0; h < 2; h++) {
#pragma unroll
          for (int mh = 0; mh < 2; mh++) {
            const int mt = 2 * h + mh;
            const int ml = ewm * 128 + mt * 32 + el31;
            const float tot = xch[(ewq * 2) * 256 + ml] + xch[(ewq * 2 + 1) * 256 + ml];
            const float hn = rsqrtf(tot * (1.f / 128.f) + EPS) * post;
#pragma unroll
            for (int nt = 0; nt < 2; nt++)
#pragma unroll
              for (int q4 = 0; q4 < 4; q4++) {
                const int d = ewn * 64 + nt * 32 + 8 * q4 + 4 * elh;
                const f32x4 gv = *(const f32x4*)(g + d);
                { u32x2 pv; pv.x = pack2(acc[nt][mt][4 * q4 + 0] * hn * gv.x, acc[nt][mt][4 * q4 + 1] * hn * gv.y); pv.y = pack2(acc[nt][mt][4 * q4 + 2] * hn * gv.z, acc[nt][mt][4 * q4 + 3] * hn * gv.w); wave_put_bf16(wbuf, mh * 32 + el31, nt, q4, elh, pv); }
              }
          }
          if (tn < 8) wave_flush_bf16(wbuf, (bf16_t*)ga.o0 + (size_t)(mw0 + h * 64) * 1024 + tn * 128 + ewn * 64, 1024, elane);
          else wave_flush_bf16(wbuf, (bf16_t*)ga.o1 + (size_t)(mw0 + h * 64) * 256 + (tn - 8) * 128 + ewn * 64, 256, elane);
        }
      } else if (tn < 12) {
        bf16_t* vt = (bf16_t*)ga.o2;
        const int g = tn - 10;
#pragma unroll
        for (int mt = 0; mt < 4; mt++) {
          const int m = mw0 + mt * 32 + el31;
          const int b = m >> 12, s = m & 4095;
          bf16_t* vp = vt + ((size_t)(b * 2 + g) * 128 + ewn * 64 + 4 * elh) * 4096 + s;
          asm volatile("" : "+v"(vp));
#pragma unroll
          for (int nt = 0; nt < 2; nt++)
#pragma unroll
            for (int r = 0; r < 16; r++)
              vp[(size_t)(nt * 32 + (r & 3) + 8 * (r >> 2)) * 4096] = f2bf(acc[nt][mt][r] * rstd[mt]);
        }
      } else {
        if (tn < 16 || (tn == 16 && ewn == 0)) {
#pragma unroll
          for (int h = 0; h < 2; h++) {
  #pragma unroll
            for (int mh = 0; mh < 2; mh++) {
              const int mt = 2 * h + mh;
#pragma unroll
              for (int nt = 0; nt < 2; nt++)
#pragma unroll
                for (int q4 = 0; q4 < 4; q4++) {
                  { u32x2 pv; pv.x = pack2(acc[nt][mt][4 * q4 + 0] * rstd[mt], acc[nt][mt][4 * q4 + 1] * rstd[mt]); pv.y = pack2(acc[nt][mt][4 * q4 + 2] * rstd[mt], acc[nt][mt][4 * q4 + 3] * rstd[mt]); wave_put_bf16(wbuf, mh * 32 + el31, nt, q4, elh, pv); }
                }
            }
            if (tn < 16) wave_flush_bf16(wbuf, (bf16_t*)ga.o3 + (size_t)(mw0 + h * 64) * 512 + (tn - 12) * 128 + ewn * 64, 512, elane);
            else wave_flush_bf16(wbuf, (bf16_t*)ga.o4 + (size_t)(mw0 + h * 64) * 64, 64, elane);
          }
        } else if (tn == 16) {
          float* iw = (float*)ga.o5;
          const float sc = 0.35355339059327373f * 0.125f;
#pragma unroll
          for (int mt = 0; mt < 4; mt++) {
            const int m = mw0 + mt * 32 + el31;
            f32x4 o;
            o.x = acc[0][mt][0] * rstd[mt] * sc; o.y = acc[0][mt][1] * rstd[mt] * sc;
            o.z = acc[0][mt][2] * rstd[mt] * sc; o.w = acc[0][mt][3] * rstd[mt] * sc;
            *(f32x4*)(iw + (size_t)m * 8 + 4 * elh) = o;
          }
        }
      }
    } else if (MODE == M_RESID || MODE == M_POOL) {
      float* ho = (float*)ga.o0;
      bf16_t* hb = (bf16_t*)ga.o1;
      const int cch = elane & 15;
      const int n = n0 + ewn * 64 + cch * 4;
      f32x4 cs = f32x4{1.f, 1.f, 1.f, 1.f};
      if (MODE == M_POOL) cs = *(const f32x4*)(ga.g0 + n);
#pragma unroll
      for (int h = 0; h < 2; h++) {
#pragma unroll
        for (int mh = 0; mh < 2; mh++) {
          const int mt = 2 * h + mh;
          const int ml = mh * 32 + el31;
#pragma unroll
          for (int nt = 0; nt < 2; nt++)
#pragma unroll
            for (int q4 = 0; q4 < 4; q4++) {
              const int chunk = nt * 8 + 2 * q4 + elh;
              f32x4 v; v.x = acc[nt][mt][4 * q4 + 0]; v.y = acc[nt][mt][4 * q4 + 1]; v.z = acc[nt][mt][4 * q4 + 2]; v.w = acc[nt][mt][4 * q4 + 3];
              *(f32x4*)(wbuf + ml * 256 + ((chunk ^ (ml & 15)) << 4)) = v;
            }
        }
#pragma unroll 4
        for (int i = 0; i < 16; i++) {
          const int row = i * 4 + (elane >> 4);
          const int m = mw0 + h * 64 + row;
          const f32x4 a = *(const f32x4*)(wbuf + row * 256 + ((cch ^ (row & 15)) << 4));
          const f32x4 rv = *(const f32x4*)(ga.resid + (size_t)m * 1024 + n);
          f32x4 o;
          o.x = rv.x + a.x * cs.x; o.y = rv.y + a.y * cs.y; o.z = rv.z + a.z * cs.z; o.w = rv.w + a.w * cs.w;
          *(f32x4*)(ho + (size_t)m * 1024 + n) = o;
          u32x2 ob; ob.x = pack2(o.x, o.y); ob.y = pack2(o.z, o.w);
          *(u32x2*)(hb + (size_t)m * 1024 + n) = ob;
          float sq = o.x * o.x + o.y * o.y + o.z * o.z + o.w * o.w;
          sq += __shfl_xor(sq, 1); sq += __shfl_xor(sq, 2); sq += __shfl_xor(sq, 4); sq += __shfl_xor(sq, 8);
          if (cch == 0) ga.ssq[(size_t)m * 16 + tn * 2 + ewn] = sq;
        }
      }
    } else if (MODE == M_MLP1) {
#pragma unroll
      for (int h = 0; h < 2; h++) {
#pragma unroll
        for (int mh = 0; mh < 2; mh++) {
          const int mt = 2 * h + mh;
#pragma unroll
          for (int nt = 0; nt < 2; nt++)
#pragma unroll
            for (int q4 = 0; q4 < 4; q4++) {
              const float v0 = fmaxf(acc[nt][mt][4 * q4 + 0] * rstd[mt], 0.f), v1 = fmaxf(acc[nt][mt][4 * q4 + 1] * rstd[mt], 0.f);
              const float v2 = fmaxf(acc[nt][mt][4 * q4 + 2] * rstd[mt], 0.f), v3 = fmaxf(acc[nt][mt][4 * q4 + 3] * rstd[mt], 0.f);
              { u32x2 pv; pv.x = pack2(v0 * v0, v1 * v1); pv.y = pack2(v2 * v2, v3 * v3); wave_put_bf16(wbuf, mh * 32 + el31, nt, q4, elh, pv); }
            }
        }
        wave_flush_bf16(wbuf, (bf16_t*)ga.o0 + (size_t)(mw0 + h * 64) * 4096 + n0 + ewn * 64, 4096, elane);
      }
    }
    __syncthreads();
  }
}

DEVI void grp_barrier(volatile __attribute__((address_space(3))) unsigned* ctr, unsigned& target, const int lane) {
  asm volatile("s_waitcnt vmcnt(0) lgkmcnt(0)" ::: "memory");
  target += 4u;
  if (lane == 0) __hip_atomic_fetch_add((__attribute__((address_space(3))) unsigned*)ctr, 1u, __ATOMIC_RELAXED, __HIP_MEMORY_SCOPE_WORKGROUP);
  while (__hip_atomic_load((__attribute__((address_space(3))) unsigned*)ctr, __ATOMIC_RELAXED, __HIP_MEMORY_SCOPE_WORKGROUP) < target) __builtin_amdgcn_s_sleep(1);
  asm volatile("" ::: "memory");
}

template <int DQK, bool MASKED>
DEVI void flash_qtile(const bf16_t* __restrict__ qrow, const bf16_t* __restrict__ Kb, const int kstride,
                      const bf16_t* __restrict__ Vt, const u64* __restrict__ mrow, const int qt,
                      char* smem, f32x16 (&O)[4], const float negc0,
                      volatile __attribute__((address_space(3))) unsigned* gctr, unsigned& gtarget) {
  constexpr int KROWB = DQK * 2;
  constexpr int KS = DQK / 16;
  constexpr int KBYTES = 64 * KROWB;
  constexpr int STAGE = KBYTES + 16384;
  constexpr int KI = KBYTES / 4096;
  const int tid = otid(), lane = tid & 63, w = tid >> 6;
  const int l31 = lane & 31, lh = lane >> 5;
  unsigned kgo[KI], vgo[4];
#pragma unroll
  for (int i = 0; i < KI; i++) {
    const int blk = i * 4 + w;
    int row, kc;
    if (DQK == 64) { row = blk * 8 + (lane >> 3); kc = (lane & 7) ^ ((row >> 1) & 7); }
    else { row = blk * 4 + (lane >> 4); kc = (lane & 15) ^ (row & 15); }
    kgo[i] = (unsigned)(row * kstride + kc * 8) * 2u;
  }
#pragma unroll
  for (int i = 0; i < 4; i++) {
    const int blk = i * 4 + w;
    const int row = blk * 8 + (lane >> 3);
    const int kc = (lane & 7) ^ ((row >> 1) & 7);
    vgo[i] = (unsigned)(row * 4096 + kc * 8) * 2u;
  }
  bf16x8 qf[KS];
#pragma unroll
  for (int ks = 0; ks < KS; ks++) qf[ks] = *(const bf16x8*)(qrow + 16 * ks + 8 * lh);
#pragma unroll
  for (int eb = 0; eb < 4; eb++)
#pragma unroll
    for (int r = 0; r < 16; r++) O[eb][r] = 0.f;
  float lsum = 0.f;
  const int ntile = 2 * qt + 2;
  const int mylast = 2 * qt + (w >> 1);
  u64 mw_next = 0ull;
  if (MASKED) mw_next = mrow[0];
  grp_barrier(gctr, gtarget, lane);
  {
    const char* kt = (const char*)Kb;
    const char* vtp = (const char*)Vt;
#pragma unroll
    for (int i = 0; i < KI; i++)
      __builtin_amdgcn_global_load_lds((const unsigned*)(kt + kgo[i]), (__attribute__((address_space(3))) unsigned*)(smem + (i * 4 + w) * 1024), 16, 0, 0);
#pragma unroll
    for (int i = 0; i < 4; i++)
      __builtin_amdgcn_global_load_lds((const unsigned*)(vtp + vgo[i]), (__attribute__((address_space(3))) unsigned*)(smem + KBYTES + (i * 4 + w) * 1024), 16, 0, 0);
  }
  grp_barrier(gctr, gtarget, lane);
  for (int j = 0; j < ntile; j++) {
    const char* st = smem + (j & 1) * STAGE;
    const bool more = (j + 1 < ntile);
    if (more) {
      const char* kt = (const char*)Kb + (size_t)(j + 1) * 64 * kstride * 2;
      const char* vtp = (const char*)Vt + (size_t)(j + 1) * 64 * 2;
      char* sn = smem + ((j + 1) & 1) * STAGE;
#pragma unroll
      for (int i = 0; i < KI; i++) {
        unsigned off = kgo[i];
        asm volatile("" : "+v"(off));
        __builtin_amdgcn_global_load_lds((const unsigned*)(kt + off), (__attribute__((address_space(3))) unsigned*)(sn + (i * 4 + w) * 1024), 16, 0, 0);
      }
#pragma unroll
      for (int i = 0; i < 4; i++) {
        unsigned off = vgo[i];
        asm volatile("" : "+v"(off));
        __builtin_amdgcn_global_load_lds((const unsigned*)(vtp + off), (__attribute__((address_space(3))) unsigned*)(sn + KBYTES + (i * 4 + w) * 1024), 16, 0, 0);
      }
    }
    const u64 mw = mw_next;
    if (MASKED && more) mw_next = mrow[j + 1];
    if (j <= mylast) {
      f32x16 S[2];
#pragma unroll
      for (int mt = 0; mt < 2; mt++)
#pragma unroll
        for (int r = 0; r < 16; r++) S[mt][r] = negc0;
#pragma unroll
      for (int ks = 0; ks < KS; ks++)
#pragma unroll
        for (int mt = 0; mt < 2; mt++) {
          bf16x8 kf = *(const bf16x8*)(st + lds_off<KROWB>(mt * 32 + l31, 2 * ks + lh));
          S[mt] = mfma32(kf, qf[ks], S[mt]);
        }
      unsigned wlo = 0xffffffffu, whi = 0xffffffffu;
      if (MASKED) {
        wlo = ((unsigned)mw) >> (4 * lh);
        whi = ((unsigned)(mw >> 32)) >> (4 * lh);
      }
      float ps = 0.f;
#pragma unroll
      for (int mt = 0; mt < 2; mt++)
#pragma unroll
        for (int r = 0; r < 16; r++) {
          float pv = fexp2(S[mt][r]);
          if (MASKED) {
            const unsigned wd = mt ? whi : wlo;
            pv = ((wd >> ((r & 3) + 8 * (r >> 2))) & 1u) ? pv : 0.f;
          }
          S[mt][r] = pv;
          ps += pv;
        }
      lsum += ps;
#pragma unroll
      for (int kb = 0; kb < 2; kb++)
#pragma unroll
        for (int s = 0; s < 2; s++) {
          u32x4 pfu;
          pfu.x = pack2(S[kb][8 * s + 0], S[kb][8 * s + 1]);
          pfu.y = pack2(S[kb][8 * s + 2], S[kb][8 * s + 3]);
          pfu.z = pack2(S[kb][8 * s + 4], S[kb][8 * s + 5]);
          pfu.w = pack2(S[kb][8 * s + 6], S[kb][8 * s + 7]);
          const bf16x8 pfv = __builtin_bit_cast(bf16x8, pfu);
#pragma unroll
          for (int eb = 0; eb < 4; eb++) {
            const int row = eb * 32 + l31;
            const u32x2 h0 = *(const u32x2*)(st + KBYTES + lds_off<128>(row, 4 * kb + 2 * s) + 8 * lh);
            const u32x2 h1 = *(const u32x2*)(st + KBYTES + lds_off<128>(row, 4 * kb + 2 * s + 1) + 8 * lh);
            const u32x4 vfu = u32x4{h0.x, h0.y, h1.x, h1.y};
            O[eb] = mfma32(__builtin_bit_cast(bf16x8, vfu), pfv, O[eb]);
          }
        }
    }
    grp_barrier(gctr, gtarget, lane);
  }
  float lt = lsum + __shfl_xor(lsum, 32);
  const float inv = 1.f / lt;
#pragma unroll
  for (int eb = 0; eb < 4; eb++)
#pragma unroll
    for (int r = 0; r < 16; r++) O[eb][r] *= inv;
}

DEVI void flash_qtile_pipe(const bf16_t* __restrict__ qrow, const bf16_t* __restrict__ Kb, const int kstride,
                           const bf16_t* __restrict__ Vt, const int qt,
                           char* smem, f32x16 (&O)[4], const float negc0,
                           volatile __attribute__((address_space(3))) unsigned* gctr, unsigned& gtarget) {
  constexpr int KBYTES = 64 * 128;
  constexpr int STAGE = KBYTES + 16384;
  const int tid = otid(), lane = tid & 63, w = tid >> 6;
  const int l31 = lane & 31, lh = lane >> 5;
  unsigned kgo[2], vgo[4];
#pragma unroll
  for (int i = 0; i < 2; i++) {
    const int blk = i * 4 + w;
    const int row = blk * 8 + (lane >> 3);
    const int kc = (lane & 7) ^ ((row >> 1) & 7);
    kgo[i] = (unsigned)(row * kstride + kc * 8) * 2u;
  }
#pragma unroll
  for (int i = 0; i < 4; i++) {
    const int blk = i * 4 + w;
    const int row = blk * 8 + (lane >> 3);
    const int kc = (lane & 7) ^ ((row >> 1) & 7);
    vgo[i] = (unsigned)(row * 4096 + kc * 8) * 2u;
  }
  bf16x8 qf[4];
#pragma unroll
  for (int ks = 0; ks < 4; ks++) qf[ks] = *(const bf16x8*)(qrow + 16 * ks + 8 * lh);
#pragma unroll
  for (int eb = 0; eb < 4; eb++)
#pragma unroll
    for (int r = 0; r < 16; r++) O[eb][r] = 0.f;
  float lsum = 0.f;
  const int ntile = 2 * qt + 2;
  const int mylast = 2 * qt + (w >> 1);
#define FP_DMA_K(T, STG)                                                                              \
  { const char* kt = (const char*)Kb + (size_t)(T) * 64 * kstride * 2;                                \
    _Pragma("unroll") for (int i = 0; i < 2; i++) {                                                   \
      unsigned off = kgo[i]; asm volatile("" : "+v"(off));                                            \
      __builtin_amdgcn_global_load_lds((const unsigned*)(kt + off), (__attribute__((address_space(3))) unsigned*)(smem + (STG) * STAGE + (i * 4 + w) * 1024), 16, 0, 0); } }
#define FP_DMA_V(T, STG)                                                                              \
  { const char* vtp = (const char*)Vt + (size_t)(T) * 64 * 2;                                         \
    _Pragma("unroll") for (int i = 0; i < 4; i++) {                                                   \
      unsigned off = vgo[i]; asm volatile("" : "+v"(off));                                            \
      __builtin_amdgcn_global_load_lds((const unsigned*)(vtp + off), (__attribute__((address_space(3))) unsigned*)(smem + (STG) * STAGE + KBYTES + (i * 4 + w) * 1024), 16, 0, 0); } }
#define FP_QK(SX, STG)                                                                                \
  { _Pragma("unroll") for (int mt = 0; mt < 2; mt++)                                                  \
      _Pragma("unroll") for (int r = 0; r < 16; r++) SX[mt][r] = negc0;                               \
    _Pragma("unroll") for (int ks = 0; ks < 4; ks++)                                                  \
      _Pragma("unroll") for (int mt = 0; mt < 2; mt++) {                                              \
        bf16x8 kf = *(const bf16x8*)(smem + (STG) * STAGE + lds_off<128>(mt * 32 + l31, 2 * ks + lh)); \
        SX[mt] = mfma32(kf, qf[ks], SX[mt]); } }
#define FP_SMPV(SX, STG)                                                                              \
  { float ps = 0.f;                                                                                   \
    _Pragma("unroll") for (int mt = 0; mt < 2; mt++)                                                  \
      _Pragma("unroll") for (int r = 0; r < 16; r++) { const float pv = fexp2(SX[mt][r]); SX[mt][r] = pv; ps += pv; } \
    lsum += ps;                                                                                       \
    _Pragma("unroll") for (int kb = 0; kb < 2; kb++)                                                  \
      _Pragma("unroll") for (int s = 0; s < 2; s++) {                                                 \
        u32x4 pfu;                                                                                    \
        pfu.x = pack2(SX[kb][8 * s + 0], SX[kb][8 * s + 1]);                                          \
        pfu.y = pack2(SX[kb][8 * s + 2], SX[kb][8 * s + 3]);                                          \
        pfu.z = pack2(SX[kb][8 * s + 4], SX[kb][8 * s + 5]);                                          \
        pfu.w = pack2(SX[kb][8 * s + 6], SX[kb][8 * s + 7]);                                          \
        const bf16x8 pfv = __builtin_bit_cast(bf16x8, pfu);                                           \
        _Pragma("unroll") for (int eb = 0; eb < 4; eb++) {                                            \
          const int row = eb * 32 + l31;                                                              \
          const u32x2 h0 = *(const u32x2*)(smem + (STG) * STAGE + KBYTES + lds_off<128>(row, 4 * kb + 2 * s) + 8 * lh);     \
          const u32x2 h1 = *(const u32x2*)(smem + (STG) * STAGE + KBYTES + lds_off<128>(row, 4 * kb + 2 * s + 1) + 8 * lh); \
          const u32x4 vfu = u32x4{h0.x, h0.y, h1.x, h1.y};                                            \
          O[eb] = mfma32(__builtin_bit_cast(bf16x8, vfu), pfv, O[eb]); } } }
#define FP_STEP(J, SCUR, SNEXT, STG)                                                                  \
  { if ((J) + 2 < ntile) FP_DMA_K((J) + 2, STG)                                                       \
    if ((J) + 1 < ntile) FP_DMA_V((J) + 1, (STG) ^ 1)                                                 \
    if ((J) + 1 <= mylast) FP_QK(SNEXT, (STG) ^ 1)                                                    \
    if ((J) <= mylast) FP_SMPV(SCUR, STG)                                                             \
    grp_barrier(gctr, gtarget, lane); }
  f32x16 SA[2], SB[2];
  grp_barrier(gctr, gtarget, lane);
  FP_DMA_K(0, 0)
  FP_DMA_V(0, 0)
  FP_DMA_K(1, 1)
  grp_barrier(gctr, gtarget, lane);
  FP_QK(SA, 0)
  grp_barrier(gctr, gtarget, lane);
#pragma unroll
  for (int mt = 0; mt < 2; mt++)
#pragma unroll
    for (int r = 0; r < 16; r++) SB[mt][r] = 0.f;
  for (int j = 0; j < ntile; j += 2) {
    FP_STEP(j, SA, SB, 0)
    FP_STEP(j + 1, SB, SA, 1)
  }
#undef FP_DMA_K
#undef FP_DMA_V
#undef FP_QK
#undef FP_SMPV
#undef FP_STEP
  float lt = lsum + __shfl_xor(lsum, 32);
  const float inv = 1.f / lt;
#pragma unroll
  for (int eb = 0; eb < 4; eb++)
#pragma unroll
    for (int r = 0; r < 16; r++) O[eb][r] *= inv;
}

DEVI void attnA_phase(const Params& p, int jl, float lambda_init, char* smem,
                        volatile __attribute__((address_space(3))) unsigned* gctr, unsigned& gtarget) {
  const int tid = otid(), lane = tid & 63, w = tid >> 6;
  const int l31 = lane & 31, lh = lane >> 5;
  const bf16_t* qk = (const bf16_t*)(p.ws + R_QK);
  const bf16_t* vt = (const bf16_t*)(p.ws + R_VT);
  bf16_t* ao = (bf16_t*)(p.ws + R_AO);
  float s1 = p.a_lq1[jl * 64 + lane] * p.a_lk1[jl * 64 + lane];
  float s2 = p.a_lq2[jl * 64 + lane] * p.a_lk2[jl * 64 + lane];
#pragma unroll
  for (int o = 32; o >= 1; o >>= 1) { s1 += __shfl_xor(s1, o); s2 += __shfl_xor(s2, o); }
  const float lam = expf(s1) - expf(s2) + lambda_init;
  float gq = fabsf(p.a_q_g[jl * 64 + lane]), gk = fabsf(p.a_k_g[jl * 64 + lane]);
#pragma unroll
  for (int o = 32; o >= 1; o >>= 1) { gq = fmaxf(gq, __shfl_xor(gq, o)); gk = fmaxf(gk, __shfl_xor(gk, o)); }
  const float negc0 = -(8.0f * gq * gk * LOG2E * 1.01f);
  const float* subg = p.a_sub_g + jl * 128;
  for (int item = vblk(); item < 512; item += nvblk()) {
    const int pr = item & 15, h = (item >> 4) & 7, b = item >> 7;
    for (int qi = 0; qi < 2; qi++) {
      const int qt = qi ? pr : (31 - pr);
      const int t = b * SEQ + qt * 128 + w * 32 + l31;
      f32x16 O[4];
      flash_qtile_pipe(qk + (size_t)t * 2048 + h * 128, qk + (size_t)b * SEQ * 2048 + 1024 + h * 128, 2048,
                             vt + (size_t)(b * 8 + h) * 128 * 4096, qt, smem, O, negc0, gctr, gtarget);
#pragma unroll
      for (int eb = 0; eb < 4; eb++)
#pragma unroll
        for (int q4 = 0; q4 < 4; q4++) {
          const int e = eb * 32 + 8 * q4 + 4 * lh;
          u32x2 o;
          o.x = pack2(O[eb][4 * q4 + 0], O[eb][4 * q4 + 1]);
          o.y = pack2(O[eb][4 * q4 + 2], O[eb][4 * q4 + 3]);
          *(u32x2*)(ao + (size_t)t * 1024 + h * 128 + e) = o;
        }
      flash_qtile_pipe(qk + (size_t)t * 2048 + h * 128 + 64, qk + (size_t)b * SEQ * 2048 + 1024 + h * 128 + 64, 2048,
                             vt + (size_t)(b * 8 + h) * 128 * 4096, qt, smem, O, negc0, gctr, gtarget);
      float ssq = 0.f;
#pragma unroll
      for (int eb = 0; eb < 4; eb++)
#pragma unroll
        for (int q4 = 0; q4 < 4; q4++) {
          const int e = eb * 32 + 8 * q4 + 4 * lh;
          const u32x2 o1 = *(const u32x2*)(ao + (size_t)t * 1024 + h * 128 + e);
          const float a0 = bf_lo(o1.x) - lam * O[eb][4 * q4 + 0];
          const float a1 = bf_hi(o1.x) - lam * O[eb][4 * q4 + 1];
          const float a2 = bf_lo(o1.y) - lam * O[eb][4 * q4 + 2];
          const float a3 = bf_hi(o1.y) - lam * O[eb][4 * q4 + 3];
          O[eb][4 * q4 + 0] = a0; O[eb][4 * q4 + 1] = a1; O[eb][4 * q4 + 2] = a2; O[eb][4 * q4 + 3] = a3;
          ssq += a0 * a0 + a1 * a1 + a2 * a2 + a3 * a3;
        }
      ssq += __shfl_xor(ssq, 32);
      const float rn = rsqrtf(ssq * (1.f / 128.f) + EPS) * (1.f - lambda_init);
#pragma unroll
      for (int eb = 0; eb < 4; eb++)
#pragma unroll
        for (int q4 = 0; q4 < 4; q4++) {
          const int e = eb * 32 + 8 * q4 + 4 * lh;
          const f32x4 gv = *(const f32x4*)(subg + e);
          u32x2 o;
          o.x = pack2(O[eb][4 * q4 + 0] * rn * gv.x, O[eb][4 * q4 + 1] * rn * gv.y);
          o.y = pack2(O[eb][4 * q4 + 2] * rn * gv.z, O[eb][4 * q4 + 3] * rn * gv.w);
          *(u32x2*)(ao + (size_t)t * 1024 + h * 128 + e) = o;
        }
    }
  }
}

DEVI void attnC_phase(const Params& p, char* smem, volatile __attribute__((address_space(3))) unsigned* gctr, unsigned& gtarget) {
  const int tid = otid(), lane = tid & 63, w = tid >> 6;
  const int l31 = lane & 31, lh = lane >> 5;
  const bf16_t* cq = (const bf16_t*)(p.ws + R_CQ);
  const bf16_t* ck = (const bf16_t*)(p.ws + R_CK);
  const bf16_t* cvt = (const bf16_t*)(p.ws + R_CVT);
  const u64* mask = (const u64*)(p.ws + R_MASK);
  bf16_t* ao = (bf16_t*)(p.ws + R_AO);
  float gq = fmaxf(fabsf(p.c_q_g[lane]), fabsf(p.c_q_g[64 + lane])), gk = fmaxf(fabsf(p.c_k_g[lane]), fabsf(p.c_k_g[64 + lane]));
#pragma unroll
  for (int o = 32; o >= 1; o >>= 1) { gq = fmaxf(gq, __shfl_xor(gq, o)); gk = fmaxf(gk, __shfl_xor(gk, o)); }
  const float negc0 = -(11.313708498984761f * gq * gk * LOG2E * 1.01f);
  for (int item = vblk(); item < 512; item += nvblk()) {
    const int pr = item & 15, hh = (item >> 4) & 7, b = item >> 7;
    const int g = hh >> 2;
    for (int qi = 0; qi < 2; qi++) {
      const int qt = qi ? pr : (31 - pr);
      const int t = b * SEQ + qt * 128 + w * 32 + l31;
      f32x16 O[4];
      flash_qtile<128, true>(cq + (size_t)t * 1024 + hh * 128, ck + (size_t)b * SEQ * 256 + g * 128, 256,
                             cvt + (size_t)(b * 2 + g) * 128 * 4096, mask + (size_t)t * 64, qt, smem, O, negc0, gctr, gtarget);
#pragma unroll
      for (int eb = 0; eb < 4; eb++)
#pragma unroll
        for (int q4 = 0; q4 < 4; q4++) {
          const int e = eb * 32 + 8 * q4 + 4 * lh;
          u32x2 o;
          o.x = pack2(O[eb][4 * q4 + 0], O[eb][4 * q4 + 1]);
          o.y = pack2(O[eb][4 * q4 + 2], O[eb][4 * q4 + 3]);
          *(u32x2*)(ao + (size_t)t * 1024 + hh * 128 + e) = o;
        }
    }
  }
}

DEVI void pool_phase(const Params& p, char* smem) {
  const int tid = otid(), lane = tid & 63, w = tid >> 6;
  float* rs = (float*)smem;
  const float* h = p.out;
  bf16_t* pooled = (bf16_t*)(p.ws + R_POOL);
  for (int tile = vblk(); tile < T_TOK / 32; tile += nvblk()) {
    const int t0 = tile * 32;
    const int pos0 = t0 & (SEQ - 1);
    __syncthreads();
    for (int r = w; r < 47; r += 4) {
      const int pos = pos0 - 15 + r;
      if (pos >= 0) {
        const float* row = h + (size_t)(t0 - 15 + r) * 1024;
        float s = 0.f;
#pragma unroll
        for (int i = 0; i < 4; i++) {
          f32x4 v = *(const f32x4*)(row + i * 256 + lane * 4);
          s += v.x * v.x + v.y * v.y + v.z * v.z + v.w * v.w;
        }
#pragma unroll
        for (int o = 32; o >= 1; o >>= 1) s += __shfl_xor(s, o);
        if (lane == 0) rs[r] = rsqrtf(s * (1.f / 1024.f) + EPS);
      }
    }
    __syncthreads();
    const int c = tid * 4;
    const int grp = c >> 8;
    const int win = 2 << grp;
    f32x4 sum = f32x4{0.f, 0.f, 0.f, 0.f};
    for (int r = -(win - 1); r < 0; r++) {
      if (pos0 + r >= 0) {
        f32x4 v = *(const f32x4*)(h + (size_t)(t0 + r) * 1024 + c);
        const float s = rs[r + 15];
        sum.x += v.x * s; sum.y += v.y * s; sum.z += v.z * s; sum.w += v.w * s;
      }
    }
    for (int r = 0; r < 32; r++) {
      f32x4 v = *(const f32x4*)(h + (size_t)(t0 + r) * 1024 + c);
      const float s = rs[r + 15];
      v.x *= s; v.y *= s; v.z *= s; v.w *= s;
      sum.x += v.x; sum.y += v.y; sum.z += v.z; sum.w += v.w;
      const int pos = pos0 + r;
      const float ic = 1.f / (float)min(pos + 1, win);
      u32x2 o;
      o.x = pack2(sum.x * ic - v.x, sum.y * ic - v.y);
      o.y = pack2(sum.z * ic - v.z, sum.w * ic - v.w);
      *(u32x2*)(pooled + (size_t)(t0 + r) * 1024 + c) = o;
      const int ro = r - win + 1;
      if (pos0 + ro >= 0) {
        f32x4 u = *(const f32x4*)(h + (size_t)(t0 + ro) * 1024 + c);
        const float so = rs[ro + 15];
        sum.x -= u.x * so; sum.y -= u.y * so; sum.z -= u.z * so; sum.w -= u.w * so;
      }
    }
  }
}

DEVI unsigned fkey(float f) {
  unsigned u = __float_as_uint(f);
  return (u & 0x80000000u) ? ~u : (u | 0x80000000u);
}

template <int NR>
DEVI void select_topk(const float* srow, const int c, const int lane, u64* mrow) {
  unsigned kreg[NR];
#pragma unroll
  for (int j = 0; j < NR; j++) {
    const unsigned k = fkey(srow[j * 64 + lane]);
    kreg[j] = (j <= c) ? k : 0u;
  }
  unsigned T = 0u;
  bool exact = false;
#pragma unroll 1
  for (int bit = 31; bit >= 0; bit--) {
    const unsigned cand = T | (1u << bit);
    int cnt = 0;
#pragma unroll
    for (int j = 0; j < NR; j++) cnt += __popcll(__ballot(kreg[j] >= cand));
    if (cnt >= 256) T = cand;
    if (cnt == 256) { exact = true; break; }
  }
  asm volatile("" : "+v"(T));
  if (exact) {
#pragma unroll
    for (int j = 0; j < NR; j++) {
      const u64 bm = __ballot(kreg[j] >= T);
      if (lane == 0) mrow[j] = bm;
    }
  } else {
    int cgt = 0;
#pragma unroll
    for (int j = 0; j < NR; j++) cgt += __popcll(__ballot(kreg[j] > T));
    int need = 256 - cgt;
#pragma unroll
    for (int j = 0; j < NR; j++) {
      const u64 gt = __ballot(kreg[j] > T);
      const u64 eq = __ballot(kreg[j] == T);
      const int rank = __popcll(eq & ((1ull << lane) - 1ull));
      const u64 tk = __ballot((kreg[j] == T) && (rank < need));
      need -= __popcll(eq);
      const u64 bm = gt | tk;
      if (lane == 0) mrow[j] = bm;
    }
  }
}

DEVI void index_unit(const Params& p, int unit, char* smem, volatile __attribute__((address_space(3))) unsigned* gctr, unsigned& gtarget) {
  const int tid = otid(), lane = tid & 63, w = tid >> 6;
  const int l31 = lane & 31, lh = lane >> 5;
  const int c = unit >> 4, b = (unit >> 2) & 3, qr = unit & 3;
  const int t0 = b * SEQ + c * 64 + qr * 16;
  u64* mask = (u64*)(p.ws + R_MASK);
  if (c < 4) {
    if (tid < 16 * (c + 1)) {
      const int q = tid / (c + 1), j = tid % (c + 1);
      u64 ones = ~0ull;
      asm volatile("" : "+v"(ones));
      mask[(size_t)(t0 + q) * 64 + j] = ones;
    }
    return;
  }
  const bf16_t* ciq = (const bf16_t*)(p.ws + R_CIQ);
  const bf16_t* cik = (const bf16_t*)(p.ws + R_CIK);
  const float* ciw = (const float*)(p.ws + R_CIW);
  float* sc = (float*)smem;
  const int nkb = 2 * (c + 1);
  for (int grp = 0; grp < 4; grp++) {
    const int tq = t0 + grp * 4;
    {
      const int a = l31 >> 3, gg = (l31 >> 2) & 1, bq = l31 & 3;
      const int qloc = 2 * gg + (a >> 1), head = (a & 1) * 4 + bq;
      bf16x8 af[4];
#pragma unroll
      for (int ks = 0; ks < 4; ks++) af[ks] = *(const bf16x8*)(ciq + (size_t)(tq + qloc) * 512 + head * 64 + 16 * ks + 8 * lh);
      float wq0[8], wq1[8];
      {
        const f32x4 a0 = *(const f32x4*)(ciw + (size_t)(tq + 2 * lh) * 8), a1 = *(const f32x4*)(ciw + (size_t)(tq + 2 * lh) * 8 + 4);
        const f32x4 b0 = *(const f32x4*)(ciw + (size_t)(tq + 2 * lh + 1) * 8), b1 = *(const f32x4*)(ciw + (size_t)(tq + 2 * lh + 1) * 8 + 4);
        wq0[0] = a0.x; wq0[1] = a0.y; wq0[2] = a0.z; wq0[3] = a0.w; wq0[4] = a1.x; wq0[5] = a1.y; wq0[6] = a1.z; wq0[7] = a1.w;
        wq1[0] = b0.x; wq1[1] = b0.y; wq1[2] = b0.z; wq1[3] = b0.w; wq1[4] = b1.x; wq1[5] = b1.y; wq1[6] = b1.z; wq1[7] = b1.w;
      }
      const int nit = (nkb - w + 3) >> 2;
      const bf16_t* ikb = cik + (size_t)b * SEQ * 64 + 8 * lh;
      bf16x8 nb[4][4];
#pragma unroll
      for (int u = 0; u < 4; u++) {
        const int kb = min(w + 4 * u, nkb - 1);
#pragma unroll
        for (int ks = 0; ks < 4; ks++) nb[u][ks] = *(const bf16x8*)(ikb + (size_t)(kb * 32 + l31) * 64 + 16 * ks);
      }
      for (int it0 = 0; it0 < nit; it0 += 4) {
        bf16x8 cb[4][4];
#pragma unroll
        for (int u = 0; u < 4; u++)
#pragma unroll
          for (int ks = 0; ks < 4; ks++) cb[u][ks] = nb[u][ks];
        if (it0 + 4 < nit) {
#pragma unroll
          for (int u = 0; u < 4; u++) {
            const int kb = min(w + 4 * (it0 + 4 + u), nkb - 1);
#pragma unroll
            for (int ks = 0; ks < 4; ks++) nb[u][ks] = *(const bf16x8*)(ikb + (size_t)(kb * 32 + l31) * 64 + 16 * ks);
          }
        }
#pragma unroll
        for (int u = 0; u < 4; u++) {
          const int kb = w + 4 * (it0 + u);
          f32x16 acc;
#pragma unroll
          for (int r = 0; r < 16; r++) acc[r] = 0.f;
#pragma unroll
          for (int ks = 0; ks < 4; ks++) acc = mfma32(af[ks], cb[u][ks], acc);
          float s0 = 0.f, s1 = 0.f;
#pragma unroll
          for (int r = 0; r < 8; r++) s0 += wq0[r] * fmaxf(acc[r], 0.f);
#pragma unroll
          for (int r = 0; r < 8; r++) s1 += wq1[r] * fmaxf(acc[8 + r], 0.f);
          if (s0 == 0.f) s0 = 0.f;
          if (s1 == 0.f) s1 = 0.f;
          if (kb < nkb) {
            const int key = kb * 32 + l31;
            sc[(2 * lh) * 4096 + key] = s0;
            sc[(2 * lh + 1) * 4096 + key] = s1;
          }
        }
      }
    }
    grp_barrier(gctr, gtarget, lane);
    {
      u64* mrow = mask + (size_t)(tq + w) * 64;
      const float* srow = sc + w * 4096;
      if (c < 16) select_topk<16>(srow, c, lane, mrow);
      else if (c < 32) select_topk<32>(srow, c, lane, mrow);
      else if (c < 48) select_topk<48>(srow, c, lane, mrow);
      else select_topk<64>(srow, c, lane, mrow);
    }
    grp_barrier(gctr, gtarget, lane);
  }
}

DEVI void index_phase(const Params& p, char* smem, volatile __attribute__((address_space(3))) unsigned* gctr, unsigned& gtarget) {
  for (int it2 = vblk() * 2; it2 < 1024; it2 += nvblk() * 2) {
    for (int k = 0; k < 2; k++) {
      const int item = it2 >> 1;
      index_unit(p, k ? item : (1023 - item), smem, gctr, gtarget);
    }
  }
}


#define XB_TMO      128
#define XB_XCNT(j)  (256  + 64 * (j))
#define XB_XSUB(j)  (1280 + 64 * (j))
#define XB_XGEN(j)  (2304 + 64 * (j))
#define XB_TOP      3328
#define XB_TOPGEN   3392
#define XCD_BAR_WORDS 3456
#define XB_SPIN_CAP (1u << 22)
#define LAS __attribute__((address_space(3)))
constexpr size_t OFF_BAR = 250 * MB;

DEVI unsigned xb_ld(unsigned* p)              { return __hip_atomic_load(p, __ATOMIC_RELAXED, __HIP_MEMORY_SCOPE_AGENT); }
DEVI unsigned xb_add(unsigned* p, unsigned v) { return __hip_atomic_fetch_add(p, v, __ATOMIC_RELAXED, __HIP_MEMORY_SCOPE_AGENT); }
DEVI unsigned xb_xcc_id() { return (unsigned)__builtin_amdgcn_s_getreg((3 << 11) | 20) & 0xFu; }
#define XB_SPIN(cond, bar) do { unsigned _sp = 0; while (cond) { __builtin_amdgcn_s_sleep(1); \
    if ((++_sp & 255u) == 0u) { if (xb_ld(&(bar)[XB_TMO])) break; if (_sp > XB_SPIN_CAP) { atomicAdd(&(bar)[XB_TMO], 1u); break; } } } } while (0)

struct XcdBarrier { unsigned* bar; volatile LAS unsigned* st; };

DEVI XcdBarrier xcd_barrier_post(unsigned* bar, volatile LAS unsigned* st) {
  XcdBarrier b; b.bar = bar; b.st = st;
  if (threadIdx.x == 0) (void)xb_add(&bar[XB_XCNT(xb_xcc_id())], 1u);
  return b;
}
DEVI void xcd_barrier_complete(unsigned* bar, unsigned x, unsigned& nloc, unsigned& nx) {
  const unsigned G = gridDim.x * gridDim.y * gridDim.z;
  unsigned sum, cnt, mine, sp = 0u;
  for (;;) {
    sum = 0u; cnt = 0u; mine = 0u;
#pragma unroll
    for (unsigned j = 0; j < 16; ++j) { const unsigned c = xb_ld(&bar[XB_XCNT(j)]); sum += c; cnt += (c > 0u) ? 1u : 0u; mine = (j == x) ? c : mine; }
    if (sum == G) break;
    __builtin_amdgcn_s_sleep(1);
    if ((++sp & 255u) == 0u) { if (xb_ld(&bar[XB_TMO])) break; if (sp > XB_SPIN_CAP) { atomicAdd(&bar[XB_TMO], 1u); break; } }
  }
  nloc = mine > 0u ? mine : 1u; nx = cnt > 0u ? cnt : 1u;
}
DEVI void xcd_barrier(const XcdBarrier& b) {
  asm volatile("s_waitcnt vmcnt(0)" ::: "memory");
  __syncthreads();
  if (threadIdx.x == 0) {
    unsigned* bar = b.bar;
    const unsigned bx = xb_xcc_id();
    __builtin_amdgcn_s_waitcnt(0);
    unsigned nloc = b.st[0], nx = b.st[1];
    if (nloc == 0u) { xcd_barrier_complete(bar, bx, nloc, nx); b.st[0] = nloc; b.st[1] = nx; }
    const unsigned old = xb_add(&bar[XB_XSUB(bx)], 1u);
    const unsigned gen = old / nloc;
    if (old + 1u == (gen + 1u) * nloc) {
      __builtin_amdgcn_fence(__ATOMIC_RELEASE, "agent");
      asm volatile("s_waitcnt vmcnt(0)" ::: "memory");
      const unsigned og = xb_add(&bar[XB_TOP], 1u);
      const unsigned tg = og / nx;
      if (og + 1u == (tg + 1u) * nx) xb_add(&bar[XB_TOPGEN], 1u);
      else XB_SPIN(xb_ld(&bar[XB_TOPGEN]) == tg, bar);
      __builtin_amdgcn_fence(__ATOMIC_ACQUIRE, "agent");
      xb_add(&bar[XB_XGEN(bx)], 1u);
      asm volatile("s_waitcnt vmcnt(0)" ::: "memory");
    } else {
      XB_SPIN(xb_ld(&bar[XB_XGEN(bx)]) == gen, bar);
      __builtin_amdgcn_fence(__ATOMIC_ACQUIRE, "agent");
      asm volatile("s_waitcnt vmcnt(0)" ::: "memory");
    }
  }
  __syncthreads();
}

__global__ void __launch_bounds__(512, 2) fwd_megakernel(Params p) {
  __shared__ __attribute__((aligned(16))) char smem[SMEM_BYTES];
  cg::grid_group grid = cg::this_grid();
  char* gs = smem + grp_id() * 65536;
  char* ws = p.ws;
  __shared__ __attribute__((aligned(16))) unsigned xb_words[4];
  if (threadIdx.x == 0) { xb_words[0] = 0u; xb_words[1] = 0u; xb_words[2] = 0u; xb_words[3] = 0u; }
  __syncthreads();
  volatile LAS unsigned* gctr = (volatile LAS unsigned*)&xb_words[2 + grp_id()];
  unsigned gtarget = 0u;
  const XcdBarrier xb = xcd_barrier_post((unsigned*)(ws + OFF_BAR), (volatile LAS unsigned*)xb_words);
  if (gridDim.y == 0x7fffffffu) grid.sync();
  bf16_t* hb = (bf16_t*)(ws + OFF_HB);

  for (int rep = 0; rep <= DUP_CONV; rep++) convert_phase(p, gs);
  xcd_barrier(xb);

  for (int layer = 0; layer < 4; layer++) {
    const int mixer = layer % 3, jl = layer / 3;
    const float* resid_src = (layer == 0) ? p.x : p.out;
    if (mixer == 0) {
      const float lambda_init = (layer == 0) ? 0.2f : 0.5560582041564594f;
      {
        GemmArgs ga{};
      ga.ssq = (float*)(ws + OFF_SSQ);
        ga.ssq = (float*)(ws + OFF_SSQ);
        ga.A = hb; ga.lda = 1024; ga.Bt = (const bf16_t*)(ws + OFF_AIN + (size_t)jl * 6 * MB); ga.K = 1024; ga.NT = 12;
        ga.o0 = ws + R_QK; ga.o1 = ws + R_VT; ga.g0 = p.a_q_g + jl * 64; ga.g1 = p.a_k_g + jl * 64;
        for (int rep = 0; rep <= DUP_GEMM; rep++) gemm_phase<M_AQKV, 1024>(ga, smem);
      }
      xcd_barrier(xb);
      for (int rep = 0; rep <= DUP_ATTNA; rep++) attnA_phase(p, jl, lambda_init, gs, gctr, gtarget);
      xcd_barrier(xb);
      {
        GemmArgs ga{};
      ga.ssq = (float*)(ws + OFF_SSQ);
        ga.ssq = (float*)(ws + OFF_SSQ);
        ga.A = (const bf16_t*)(ws + R_AO); ga.lda = 1024; ga.Bt = (const bf16_t*)(ws + OFF_AOUT + (size_t)jl * 2 * MB); ga.K = 1024; ga.NT = 4;
        ga.o0 = p.out; ga.o1 = hb; ga.resid = resid_src;
        gemm_phase<M_RESID, 1024>(ga, smem);
      }
      xcd_barrier(xb);
    } else if (mixer == 1) {
      pool_phase(p, gs);
      xcd_barrier(xb);
      {
        GemmArgs ga{};
      ga.ssq = (float*)(ws + OFF_SSQ);
        ga.ssq = (float*)(ws + OFF_SSQ);
        ga.A = (const bf16_t*)(ws + R_POOL); ga.lda = 1024; ga.Bt = (const bf16_t*)(ws + OFF_BW); ga.K = 256; ga.NT = 4;
        ga.o0 = p.out; ga.o1 = hb; ga.resid = resid_src; ga.g0 = p.b_scale;
        gemm_phase<M_POOL, 256>(ga, smem);
      }
      xcd_barrier(xb);
    } else {
      {
        GemmArgs ga{};
      ga.ssq = (float*)(ws + OFF_SSQ);
        ga.ssq = (float*)(ws + OFF_SSQ);
        ga.A = hb; ga.lda = 1024; ga.Bt = (const bf16_t*)(ws + OFF_CIN); ga.K = 1024; ga.NT = 9;
        ga.o0 = ws + R_CQ; ga.o1 = ws + R_CK; ga.o2 = ws + R_CVT; ga.o3 = ws + R_CIQ; ga.o4 = ws + R_CIK; ga.o5 = ws + R_CIW;
        ga.g0 = p.c_q_g; ga.g1 = p.c_k_g;
        for (int rep = 0; rep <= DUP_GEMM; rep++) gemm_phase<M_CIN, 1024>(ga, smem);
      }
      xcd_barrier(xb);
      for (int rep = 0; rep <= DUP_IDX; rep++) index_phase(p, gs, gctr, gtarget);
      xcd_barrier(xb);
      for (int rep = 0; rep <= DUP_ATTNC; rep++) attnC_phase(p, gs, gctr, gtarget);
      xcd_barrier(xb);
      {
        GemmArgs ga{};
      ga.ssq = (float*)(ws + OFF_SSQ);
        ga.ssq = (float*)(ws + OFF_SSQ);
        ga.A = (const bf16_t*)(ws + R_AO); ga.lda = 1024; ga.Bt = (const bf16_t*)(ws + OFF_COUT); ga.K = 1024; ga.NT = 4;
        ga.o0 = p.out; ga.o1 = hb; ga.resid = resid_src;
        gemm_phase<M_RESID, 1024>(ga, smem);
      }
      xcd_barrier(xb);
    }
    {
      GemmArgs ga{};
      ga.ssq = (float*)(ws + OFF_SSQ);
      ga.A = hb; ga.lda = 1024; ga.Bt = (const bf16_t*)(ws + OFF_W1 + (size_t)layer * 8 * MB); ga.K = 1024; ga.NT = 16;
      ga.o0 = ws + R_HID;
      for (int rep = 0; rep <= DUP_GEMM; rep++) gemm_phase<M_MLP1, 1024>(ga, smem);
    }
    xcd_barrier(xb);
    {
      GemmArgs ga{};
      ga.ssq = (float*)(ws + OFF_SSQ);
      ga.A = (const bf16_t*)(ws + R_HID); ga.lda = 4096; ga.Bt = (const bf16_t*)(ws + OFF_W2 + (size_t)layer * 8 * MB); ga.K = 4096; ga.NT = 4;
      ga.o0 = p.out; ga.o1 = hb; ga.resid = p.out;
      gemm_phase<M_RESID, 4096>(ga, smem);
    }
    if (layer < 3) xcd_barrier(xb);
  }
}

extern "C" void kernel_launch(void* const* d_in, const int* in_sizes, int n_in, void* d_out, int out_size,
                              void* d_ws, size_t ws_size, hipStream_t stream) {
  static int grid_blocks = 0;
  if (!grid_blocks) {
    int dev = 0, cus = 0, per_cu = 0;
    hipGetDevice(&dev);
    hipDeviceGetAttribute(&cus, hipDeviceAttributeMultiprocessorCount, dev);
    hipOccupancyMaxActiveBlocksPerMultiprocessor(&per_cu, fwd_megakernel, 512, 0);
    if (per_cu > 1) per_cu = 1;
    if (per_cu < 1) per_cu = 1;
    grid_blocks = cus * per_cu;
  }
  if (ws_size < WS_NEED) { fprintf(stderr, "workspace too small: %zu < %zu\n", ws_size, (size_t)WS_NEED); return; }
  Params p{};
  p.x = (const float*)d_in[0]; p.norm1_g = (const float*)d_in[1]; p.norm2_g = (const float*)d_in[2];
  p.a_w_in = (const float*)d_in[3]; p.a_q_g = (const float*)d_in[4]; p.a_k_g = (const float*)d_in[5];
  p.a_lq1 = (const float*)d_in[6]; p.a_lk1 = (const float*)d_in[7]; p.a_lq2 = (const float*)d_in[8]; p.a_lk2 = (const float*)d_in[9];
  p.a_sub_g = (const float*)d_in[10]; p.a_w_out = (const float*)d_in[11];
  p.b_w = (const float*)d_in[12]; p.b_scale = (const float*)d_in[13];
  p.c_w_in = (const float*)d_in[14]; p.c_q_g = (const float*)d_in[15]; p.c_k_g = (const float*)d_in[16]; p.c_w_out = (const float*)d_in[17];
  p.w1 = (const float*)d_in[18]; p.w2 = (const float*)d_in[19];
  p.out = (float*)d_out; p.ws = (char*)d_ws;
  hipMemsetAsync((char*)d_ws + OFF_BAR, 0, XCD_BAR_WORDS * sizeof(unsigned), stream);
  void* args[] = {&p};
  hipError_t e = hipLaunchCooperativeKernel((void*)fwd_megakernel, dim3(grid_blocks), dim3(512), args, 0, stream);
  if (e != hipSuccess) fprintf(stderr, "cooperative launch failed: %s (grid %d)\n", hipGetErrorString(e), grid_blocks);
}
```

```cpp
#include <hip/hip_runtime.h>
#include <hip/hip_cooperative_groups.h>
#include <cstdio>
namespace cg = cooperative_groups;

typedef unsigned short bf16_t;
typedef __attribute__((ext_vector_type(8))) short bf16x8;
typedef __attribute__((ext_vector_type(16))) float f32x16;
typedef unsigned long long u64;
typedef unsigned __attribute__((ext_vector_type(4))) u32x4;
typedef unsigned __attribute__((ext_vector_type(2))) u32x2;
typedef float __attribute__((ext_vector_type(4))) f32x4;

#define DEVI __device__ __forceinline__
#define DUP_GEMM 0
#define DUP_ATTNA 0
#define DUP_IDX 0
#define DUP_ATTNC 0
#define DUP_CONV 0

constexpr int T_TOK = 16384;
constexpr int DM = 1024;
constexpr int SEQ = 4096;
constexpr float EPS = 1e-6f;
constexpr float LOG2E = 1.4426950408889634f;
constexpr size_t MB = 1ull << 20;

constexpr size_t OFF_W1 = 0;
constexpr size_t OFF_W2 = 32 * MB;
constexpr size_t OFF_AIN = 64 * MB;
constexpr size_t OFF_AOUT = 76 * MB;
constexpr size_t OFF_BW = 80 * MB;
constexpr size_t OFF_CIN = 81 * MB;
constexpr size_t OFF_COUT = 86 * MB;
constexpr size_t OFF_HB = 88 * MB;
constexpr size_t OFF_R = 120 * MB;
constexpr size_t OFF_SSQ = 249 * MB;
constexpr size_t WS_NEED = 251 * MB;
constexpr size_t R_QK = OFF_R;
constexpr size_t R_VT = OFF_R + 64 * MB;
constexpr size_t R_AO = OFF_R + 96 * MB;
constexpr size_t R_HID = OFF_R;
constexpr size_t R_POOL = OFF_R;
constexpr size_t R_CQ = OFF_R;
constexpr size_t R_CK = OFF_R + 32 * MB;
constexpr size_t R_CVT = OFF_R + 40 * MB;
constexpr size_t R_CIQ = OFF_R + 48 * MB;
constexpr size_t R_CIK = OFF_R + 64 * MB;
constexpr size_t R_CIW = OFF_R + 66 * MB;
constexpr size_t R_MASK = OFF_R + 67 * MB;

struct Params {
  const float* x; const float* norm1_g; const float* norm2_g;
  const float* a_w_in; const float* a_q_g; const float* a_k_g;
  const float* a_lq1; const float* a_lk1; const float* a_lq2; const float* a_lk2;
  const float* a_sub_g; const float* a_w_out;
  const float* b_w; const float* b_scale;
  const float* c_w_in; const float* c_q_g; const float* c_k_g; const float* c_w_out;
  const float* w1; const float* w2;
  float* out; char* ws;
};

DEVI bf16_t f2bf(float f) {
  return __builtin_bit_cast(bf16_t, (__bf16)f);
}
typedef __bf16 bf16x2_t __attribute__((ext_vector_type(2)));
DEVI unsigned pack2(float a, float b) {
  bf16x2_t v;
  v.x = (__bf16)a; v.y = (__bf16)b;
  return __builtin_bit_cast(unsigned, v);
}
DEVI float bf_lo(unsigned p) { return __uint_as_float(p << 16); }
DEVI float bf_hi(unsigned p) { return __uint_as_float(p & 0xffff0000u); }
DEVI float fexp2(float x) { return __builtin_amdgcn_exp2f(x); }

template <int ROWB>
DEVI int lds_off(int row, int chunk) {
  if (ROWB == 128) return row * 128 + ((chunk ^ ((row >> 1) & 7)) << 4);
  else return row * 256 + ((chunk ^ (row & 15)) << 4);
}

DEVI f32x16 mfma32(bf16x8 a, bf16x8 b, f32x16 c) {
  return __builtin_amdgcn_mfma_f32_32x32x16_bf16(a, b, c, 0, 0, 0);
}

constexpr int SMEM_BYTES = 131072 + 1024 + 4096;

DEVI int otid() { int t = threadIdx.x & 255; asm volatile("" : "+v"(t)); return t; }
DEVI int otid512() { int t = threadIdx.x; asm volatile("" : "+v"(t)); return t; }
DEVI int grp_id() { return __builtin_amdgcn_readfirstlane((int)(threadIdx.x >> 8)); }
DEVI int vblk() { return (int)blockIdx.x * 2 + grp_id(); }
DEVI int nvblk() { return (int)gridDim.x * 2; }

struct Job { const float* src; bf16_t* dst; const float* gain; int K, N, NP; };

DEVI Job get_job(const Params& p, int j) {
  Job jb;
  char* ws = p.ws;
  if (j < 4) {
    jb.src = p.w1 + (size_t)j * 1024 * 4096; jb.dst = (bf16_t*)(ws + OFF_W1 + (size_t)j * 8 * MB);
    jb.gain = p.norm2_g + j * 1024; jb.K = 1024; jb.N = 4096; jb.NP = 4096;
  } else if (j < 8) {
    int i = j - 4;
    jb.src = p.w2 + (size_t)i * 1024 * 4096; jb.dst = (bf16_t*)(ws + OFF_W2 + (size_t)i * 8 * MB);
    jb.gain = nullptr; jb.K = 4096; jb.N = 1024; jb.NP = 1024;
  } else if (j < 10) {
    int i = j - 8;
    jb.src = p.a_w_in + (size_t)i * 1024 * 3072; jb.dst = (bf16_t*)(ws + OFF_AIN + (size_t)i * 6 * MB);
    jb.gain = p.norm1_g + (i == 0 ? 0 : 3) * 1024; jb.K = 1024; jb.N = 3072; jb.NP = 3072;
  } else if (j < 12) {
    int i = j - 10;
    jb.src = p.a_w_out + (size_t)i * 1024 * 1024; jb.dst = (bf16_t*)(ws + OFF_AOUT + (size_t)i * 2 * MB);
    jb.gain = nullptr; jb.K = 1024; jb.N = 1024; jb.NP = 1024;
  } else if (j < 16) {
    int g = j - 12;
    jb.src = p.b_w + (size_t)g * 65536; jb.dst = (bf16_t*)(ws + OFF_BW) + (size_t)g * 65536;
    jb.gain = p.norm1_g + 1024 + g * 256; jb.K = 256; jb.N = 256; jb.NP = 256;
  } else if (j == 16) {
    jb.src = p.c_w_in; jb.dst = (bf16_t*)(ws + OFF_CIN);
    jb.gain = p.norm1_g + 2 * 1024; jb.K = 1024; jb.N = 2120; jb.NP = 2304;
  } else {
    jb.src = p.c_w_out; jb.dst = (bf16_t*)(ws + OFF_COUT);
    jb.gain = nullptr; jb.K = 1024; jb.N = 1024; jb.NP = 1024;
  }
  return jb;
}
constexpr int NJOBS = 18;

DEVI void convert_phase(const Params& p, char* smem) {
  const int tid = otid();
  float* t = (float*)smem;
  int total = 0;
  for (int j = 0; j < NJOBS; j++) { Job jb = get_job(p, j); total += (jb.K / 64) * (jb.NP / 64); }
  const int vb = vblk(), nvb = nvblk();
  Job jb; int k0 = 0, n0 = 0; bool act;
  f32x4 vc[4], vn[4];
#define CV_LOCATE(TILE, JB, K0, N0, ACT)                                                 \
  { ACT = (TILE) < total;                                              \
    int rem = ACT ? (TILE) : 0, j = 0;                                                   \
    JB = get_job(p, 0);                                                                  \
    for (;;) { int nt = (JB.K / 64) * (JB.NP / 64); if (rem < nt) break; rem -= nt; j++; JB = get_job(p, j); } \
    const int ntn = JB.NP / 64;                                                          \
    K0 = (rem / ntn) * 64; N0 = (rem % ntn) * 64; }
#define CV_LOAD(V, JB, K0, N0, ACT)                                                      \
  _Pragma("unroll") for (int i = 0; i < 4; i++) {                                        \
    const int kk = (tid >> 4) + 16 * i, n = (N0) + (tid & 15) * 4;                       \
    V[i] = f32x4{0.f, 0.f, 0.f, 0.f};                                                    \
    if ((ACT) && n < JB.N) V[i] = *(const f32x4*)(JB.src + (size_t)((K0) + kk) * JB.N + n); }
  CV_LOCATE(vb, jb, k0, n0, act)
  CV_LOAD(vc, jb, k0, n0, act)
  for (int base = 0; base < total; base += nvb) {
    if (act) {
#pragma unroll
      for (int i = 0; i < 4; i++) {
        const int kk = (tid >> 4) + 16 * i, nn = (tid & 15) * 4;
        t[kk * 65 + nn + 0] = vc[i].x; t[kk * 65 + nn + 1] = vc[i].y; t[kk * 65 + nn + 2] = vc[i].z; t[kk * 65 + nn + 3] = vc[i].w;
      }
    }
    Job jbn; int k0n = 0, n0n = 0; bool actn;
    CV_LOCATE(base + nvb + vb, jbn, k0n, n0n, actn)
    CV_LOAD(vn, jbn, k0n, n0n, actn)
    __syncthreads();
    if (act) {
      const int nl = tid >> 2, kq = tid & 3;
      unsigned pk[8];
#pragma unroll
      for (int i = 0; i < 8; i++) {
        int k = kq * 16 + 2 * i;
        float a = t[k * 65 + nl], b = t[(k + 1) * 65 + nl];
        if (jb.gain) { a *= jb.gain[k0 + k]; b *= jb.gain[k0 + k + 1]; }
        pk[i] = pack2(a, b);
      }
      u32x4* d = (u32x4*)(jb.dst + (size_t)(n0 + nl) * jb.K + k0 + kq * 16);
      d[0] = u32x4{pk[0], pk[1], pk[2], pk[3]};
      d[1] = u32x4{pk[4], pk[5], pk[6], pk[7]};
    }
    __syncthreads();
    jb = jbn; k0 = k0n; n0 = n0n; act = actn;
#pragma unroll
    for (int i = 0; i < 4; i++) vc[i] = vn[i];
  }
#undef CV_LOCATE
#undef CV_LOAD
  bf16_t* hb = (bf16_t*)(p.ws + OFF_HB);
  float* ssqp = (float*)(p.ws + OFF_SSQ);
  {
    const int lane = tid & 63, wv = tid >> 6;
    for (int row = vb * 4 + wv; row < T_TOK; row += nvb * 4) {
      const float* xr = p.x + (size_t)row * DM;
      float ssum = 0.f;
#pragma unroll
      for (int i = 0; i < 2; i++) {
        const int c = i * 512 + lane * 8;
        f32x4 a = *(const f32x4*)(xr + c), b = *(const f32x4*)(xr + c + 4);
        ssum += a.x * a.x + a.y * a.y + a.z * a.z + a.w * a.w + b.x * b.x + b.y * b.y + b.z * b.z + b.w * b.w;
        *(u32x4*)(hb + (size_t)row * DM + c) = u32x4{pack2(a.x, a.y), pack2(a.z, a.w), pack2(b.x, b.y), pack2(b.z, b.w)};
      }
#pragma unroll
      for (int o = 32; o >= 1; o >>= 1) ssum += __shfl_xor(ssum, o);
      if (lane < 16) ssqp[(size_t)row * 16 + lane] = (lane == 0) ? ssum : 0.f;
    }
  }
}

DEVI void wave_put_bf16(char* wbuf, const int ml, const int nt, const int q4, const int lh, const u32x2 v) {
  const int chunk = nt * 4 + q4;
  *(u32x2*)(wbuf + ml * 128 + ((chunk ^ (ml & 7)) << 4) + 8 * lh) = v;
}
DEVI void wave_flush_bf16(char* wbuf, bf16_t* dst, const int stride, const int lane) {
  const int c = lane & 7;
#pragma unroll
  for (int i = 0; i < 8; i++) {
    const int row = i * 8 + (lane >> 3);
    const u32x4 v = *(const u32x4*)(wbuf + row * 128 + ((c ^ (row & 7)) << 4));
    *(u32x4*)(dst + (size_t)row * stride + c * 8) = v;
  }
}

enum { M_AQKV = 0, M_CIN = 1, M_RESID = 2, M_MLP1 = 3, M_POOL = 4 };

struct GemmArgs {
  const bf16_t* A; int lda; const bf16_t* Bt; int K; int NT;
  void* o0; void* o1; void* o2; void* o3; void* o4; void* o5;
  const float* g0; const float* g1; const float* resid; float* ssq;
};

template <int MODE, int KC>
DEVI void gemm_phase(const GemmArgs& ga, char* smem) {
  constexpr bool NORM = (MODE == M_AQKV || MODE == M_CIN || MODE == M_MLP1);
  const int tid = otid512(), lane = tid & 63, w = tid >> 6;
  const int wn = w & 3, wm = w >> 2;
  const int l31 = lane & 31, lh = lane >> 5;
  float* rs_lds = (float*)(smem + 131072);
  float* xch = (float*)(smem + 131072 + 1024);
  constexpr int K = KC;
  constexpr int KT = K / 64;
  const int NT256 = ga.NT;
  const int ntiles = (T_TOK / 256) * NT256;
  for (int tile = blockIdx.x; tile < ntiles; tile += gridDim.x) {
    const int tn256 = tile % NT256, tm = tile / NT256;
    const int m0 = tm * 256;
    const bf16_t* Ab = ga.A + (size_t)m0 * ga.lda + (MODE == M_POOL ? tn256 * 256 : 0);
    const bf16_t* Bb = ga.Bt + (size_t)tn256 * 256 * K;
    f32x16 acc[2][4];
#pragma unroll
    for (int a = 0; a < 2; a++)
#pragma unroll
      for (int b = 0; b < 4; b++)
#pragma unroll
        for (int r = 0; r < 16; r++) acc[a][b][r] = 0.f;
    u32x4 rw0[4], rx0[4];
    int ttid = tid;
    asm volatile("" : "+v"(ttid));
    const int ldsb = lds_off<128>(ttid >> 3, ttid & 7);
    const unsigned woff0 = (unsigned)((ttid >> 3) * K + (ttid & 7) * 8) * 2u;
    const unsigned xoff0 = (unsigned)((ttid >> 3) * ga.lda + (ttid & 7) * 8) * 2u;
#define G_LOAD(RW, RX, KTI)                                                              \
  _Pragma("unroll") for (int j = 0; j < 4; j++) {                                        \
    RW[j] = *(const u32x4*)((const char*)Bb + (size_t)(KTI) * 128 + (size_t)j * 64 * K * 2 + woff0);            \
    RX[j] = *(const u32x4*)((const char*)Ab + (size_t)(KTI) * 128 + (size_t)j * 64 * ga.lda * 2 + xoff0);      \
  }
#define G_STORE(RW, RX, S)                                                               \
  _Pragma("unroll") for (int j = 0; j < 4; j++) {                                        \
    *(u32x4*)(smem + (S) * 32768 + ldsb + j * 8192) = RW[j];            \
    *(u32x4*)(smem + 65536 + (S) * 32768 + ldsb + j * 8192) = RX[j];                     \
  }
#define G_COMPUTE_KS(S, KS0, KS1)                                                        \
  _Pragma("unroll") for (int ks = KS0; ks < KS1; ks++) {                                 \
    bf16x8 wf[2], xf[4];                                                                 \
    _Pragma("unroll") for (int nt = 0; nt < 2; nt++)                                     \
      wf[nt] = *(const bf16x8*)(smem + (S) * 32768 + lds_off<128>(wn * 64 + nt * 32 + l31, 2 * ks + lh)); \
    _Pragma("unroll") for (int mt = 0; mt < 4; mt++)                                     \
      xf[mt] = *(const bf16x8*)(smem + 65536 + (S) * 32768 + lds_off<128>(wm * 128 + mt * 32 + l31, 2 * ks + lh)); \
    _Pragma("unroll") for (int nt = 0; nt < 2; nt++)                                     \
      _Pragma("unroll") for (int mt = 0; mt < 4; mt++) acc[nt][mt] = mfma32(wf[nt], xf[mt], acc[nt][mt]); \
  }
#define G_KS_SPLIT(S, KSI, MID, END)                                                     \
  { bf16x8 wf[2], xf[2];                                                                 \
    _Pragma("unroll") for (int nt = 0; nt < 2; nt++)                                     \
      wf[nt] = *(const bf16x8*)(smem + (S) * 32768 + lds_off<128>(wn * 64 + nt * 32 + l31, 2 * (KSI) + lh)); \
    _Pragma("unroll") for (int mt = 0; mt < 2; mt++)                                     \
      xf[mt] = *(const bf16x8*)(smem + 65536 + (S) * 32768 + lds_off<128>(wm * 128 + mt * 32 + l31, 2 * (KSI) + lh)); \
    _Pragma("unroll") for (int nt = 0; nt < 2; nt++)                                     \
      _Pragma("unroll") for (int mt = 0; mt < 2; mt++) acc[nt][mt] = mfma32(wf[nt], xf[mt], acc[nt][mt]); \
    MID                                                                                  \
    _Pragma("unroll") for (int mt = 0; mt < 2; mt++)                                     \
      xf[mt] = *(const bf16x8*)(smem + 65536 + (S) * 32768 + lds_off<128>(wm * 128 + (2 + mt) * 32 + l31, 2 * (KSI) + lh)); \
    _Pragma("unroll") for (int nt = 0; nt < 2; nt++)                                     \
      _Pragma("unroll") for (int mt = 0; mt < 2; mt++) acc[nt][2 + mt] = mfma32(wf[nt], xf[mt], acc[nt][2 + mt]); \
    END }
#define G_LD2(RW, RX, KTI, A)                                                            \
  { RW[A] = *(const u32x4*)((const char*)Bb + (size_t)(KTI) * 128 + (size_t)(A) * 64 * K * 2 + woff0);          \
    RX[A] = *(const u32x4*)((const char*)Ab + (size_t)(KTI) * 128 + (size_t)(A) * 64 * ga.lda * 2 + xoff0); }
#define G_ST2(RW, RX, S, A)                                                              \
  { *(u32x4*)(smem + (S) * 32768 + ldsb + (A) * 8192) = RW[A];                           \
    *(u32x4*)(smem + 65536 + (S) * 32768 + ldsb + (A) * 8192) = RX[A]; }
    G_LOAD(rw0, rx0, 0)
    G_STORE(rw0, rx0, 0)
    __syncthreads();
    if (NORM) {
      if (tid < 256) {
        const f32x4* sp = (const f32x4*)(ga.ssq + (size_t)(m0 + tid) * 16);
        const f32x4 a = sp[0], b = sp[1], c = sp[2], d = sp[3];
        const float tot = (a.x + a.y + a.z + a.w) + (b.x + b.y + b.z + b.w) + (c.x + c.y + c.z + c.w) + (d.x + d.y + d.z + d.w);
        rs_lds[tid] = rsqrtf(tot * (1.f / 1024.f) + EPS);
      }
    }
#pragma unroll 1
    for (int kt = 0; kt < KT; kt += 2) {
      const bool more = (kt + 2 < KT);
      G_LD2(rw0, rx0, kt + 1, 0)
      asm volatile("" ::: "memory");
      G_KS_SPLIT(0, 0, G_LD2(rw0, rx0, kt + 1, 1) asm volatile("" ::: "memory");, G_LD2(rw0, rx0, kt + 1, 2) asm volatile("" ::: "memory");)
      G_KS_SPLIT(0, 1, G_LD2(rw0, rx0, kt + 1, 3) asm volatile("" ::: "memory");, )
      G_KS_SPLIT(0, 2, G_ST2(rw0, rx0, 1, 0), G_ST2(rw0, rx0, 1, 1))
      G_KS_SPLIT(0, 3, G_ST2(rw0, rx0, 1, 2), G_ST2(rw0, rx0, 1, 3))
      __syncthreads();
      if (more) { G_LD2(rw0, rx0, kt + 2, 0) }
      asm volatile("" ::: "memory");
      G_KS_SPLIT(1, 0, if (more) { G_LD2(rw0, rx0, kt + 2, 1) } asm volatile("" ::: "memory");, if (more) { G_LD2(rw0, rx0, kt + 2, 2) } asm volatile("" ::: "memory");)
      G_KS_SPLIT(1, 1, if (more) { G_LD2(rw0, rx0, kt + 2, 3) } asm volatile("" ::: "memory");, )
      G_KS_SPLIT(1, 2, if (more) { G_ST2(rw0, rx0, 0, 0) }, if (more) { G_ST2(rw0, rx0, 0, 1) })
      G_KS_SPLIT(1, 3, if (more) { G_ST2(rw0, rx0, 0, 2) }, if (more) { G_ST2(rw0, rx0, 0, 3) })
      __syncthreads();
    }
#undef G_LOAD
#undef G_STORE
#undef G_COMPUTE_KS
#undef G_KS_SPLIT
#undef G_LD2
#undef G_ST2
    float rstd[4] = {1.f, 1.f, 1.f, 1.f};
    if (NORM) {
#pragma unroll
      for (int mt = 0; mt < 4; mt++) rstd[mt] = rs_lds[wm * 128 + mt * 32 + l31];
    }
    int el31 = l31, elh = lh, ewn = wn & 1, ewm = wm, elane = lane, ewq = wn >> 1, eww = w;
    asm volatile("" : "+v"(el31), "+v"(elh), "+v"(ewn), "+v"(ewm), "+v"(elane), "+v"(ewq), "+v"(eww));
    const int tn = tn256 * 2 + __builtin_amdgcn_readfirstlane(ewq);
    const int n0 = tn * 128;
    char* wbuf = smem + eww * 16384;
    const int mw0 = m0 + ewm * 128;
    if (MODE == M_AQKV) {
      const int nw = n0 + ewn * 64;
      if (n0 < 2048) {
        const float* g = (n0 < 1024) ? ga.g0 : ga.g1;
        const float post = (n0 < 1024) ? (0.125f * LOG2E) : 1.f;
#pragma unroll
        for (int h = 0; h < 2; h++) {
#pragma unroll
          for (int mh = 0; mh < 2; mh++) {
            const int mt = 2 * h + mh;
            float s = 0.f;
#pragma unroll
            for (int nt = 0; nt < 2; nt++)
#pragma unroll
              for (int r = 0; r < 16; r++) { float v = acc[nt][mt][r] * rstd[mt]; acc[nt][mt][r] = v; s += v * v; }
            s += __shfl_xor(s, 32);
            const float hn = rsqrtf(s * (1.f / 64.f) + EPS) * post;
#pragma unroll
            for (int nt = 0; nt < 2; nt++)
#pragma unroll
              for (int q4 = 0; q4 < 4; q4++) {
                const int d = nt * 32 + 8 * q4 + 4 * elh;
                const f32x4 gv = *(const f32x4*)(g + d);
                { u32x2 pv; pv.x = pack2(acc[nt][mt][4 * q4 + 0] * hn * gv.x, acc[nt][mt][4 * q4 + 1] * hn * gv.y); pv.y = pack2(acc[nt][mt][4 * q4 + 2] * hn * gv.z, acc[nt][mt][4 * q4 + 3] * hn * gv.w); wave_put_bf16(wbuf, mh * 32 + el31, nt, q4, elh, pv); }
              }
          }
          wave_flush_bf16(wbuf, (bf16_t*)ga.o0 + (size_t)(mw0 + h * 64) * 2048 + nw, 2048, elane);
        }
      } else {
        bf16_t* vt = (bf16_t*)ga.o1;
        const int nn = nw - 2048, head = nn >> 7, e0 = nn & 127;
#pragma unroll
        for (int mt = 0; mt < 4; mt++) {
          const int m = mw0 + mt * 32 + el31;
          const int b = m >> 12, s = m & 4095;
          bf16_t* vp = vt + ((size_t)(b * 8 + head) * 128 + e0 + 4 * elh) * 4096 + s;
          asm volatile("" : "+v"(vp));
#pragma unroll
          for (int nt = 0; nt < 2; nt++)
#pragma unroll
            for (int r = 0; r < 16; r++)
              vp[(size_t)(nt * 32 + (r & 3) + 8 * (r >> 2)) * 4096] = f2bf(acc[nt][mt][r] * rstd[mt]);
        }
      }
    } else if (MODE == M_CIN) {
      if (tn < 10) {
#pragma unroll
        for (int mt = 0; mt < 4; mt++) {
          float s = 0.f;
#pragma unroll
          for (int nt = 0; nt < 2; nt++)
#pragma unroll
            for (int r = 0; r < 16; r++) { float v = acc[nt][mt][r] * rstd[mt]; acc[nt][mt][r] = v; s += v * v; }
          s += __shfl_xor(s, 32);
          if (elh == 0) xch[(ewq * 2 + ewn) * 256 + ewm * 128 + mt * 32 + el31] = s;
        }
        __syncthreads();
        const float* g = (tn < 8) ? ga.g0 : ga.g1;
        const float post = (tn < 8) ? (0.08838834764831845f * LOG2E) : 1.f;
#pragma unroll
        for (int h = 0; h < 2; h++) {
#pragma unroll
          for (int mh = 0; mh < 2; mh++) {
            const int mt = 2 * h + mh;
            const int ml = ewm * 128 + mt * 32 + el31;
            const float tot = xch[(ewq * 2) * 256 + ml] + xch[(ewq * 2 + 1) * 256 + ml];
            const float hn = rsqrtf(tot * (1.f / 128.f) + EPS) * post;
#pragma unroll
            for (int nt = 0; nt < 2; nt++)
#pragma unroll
              for (int q4 = 0; q4 < 4; q4++) {
                const int d = ewn * 64 + nt * 32 + 8 * q4 + 4 * elh;
                const f32x4 gv = *(const f32x4*)(g + d);
                { u32x2 pv; pv.x = pack2(acc[nt][mt][4 * q4 + 0] * hn * gv.x, acc[nt][mt][4 * q4 + 1] * hn * gv.y); pv.y = pack2(acc[nt][mt][4 * q4 + 2] * hn * gv.z, acc[nt][mt][4 * q4 + 3] * hn * gv.w); wave_put_bf16(wbuf, mh * 32 + el31, nt, q4, elh, pv); }
              }
          }
          if (tn < 8) wave_flush_bf16(wbuf, (bf16_t*)ga.o0 + (size_t)(mw0 + h * 64) * 1024 + tn * 128 + ewn * 64, 1024, elane);
          else wave_flush_bf16(wbuf, (bf16_t*)ga.o1 + (size_t)(mw0 + h * 64) * 256 + (tn - 8) * 128 + ewn * 64, 256, elane);
        }
      } else if (tn < 12) {
        bf16_t* vt = (bf16_t*)ga.o2;
        const int g = tn - 10;
#pragma unroll
        for (int mt = 0; mt < 4; mt++) {
          const int m = mw0 + mt * 32 + el31;
          const int b = m >> 12, s = m & 4095;
          bf16_t* vp = vt + ((size_t)(b * 2 + g) * 128 + ewn * 64 + 4 * elh) * 4096 + s;
          asm volatile("" : "+v"(vp));
#pragma unroll
          for (int nt = 0; nt < 2; nt++)
#pragma unroll
            for (int r = 0; r < 16; r++)
              vp[(size_t)(nt * 32 + (r & 3) + 8 * (r >> 2)) * 4096] = f2bf(acc[nt][mt][r] * rstd[mt]);
        }
      } else {
        if (tn < 16 || (tn == 16 && ewn == 0)) {
#pragma unroll
          for (int h = 0; h < 2; h++) {
  #pragma unroll
            for (int mh = 0; mh < 2; mh++) {
              const int mt = 2 * h + mh;
#pragma unroll
              for (int nt = 0; nt < 2; nt++)
#pragma unroll
                for (int q4 = 0; q4 < 4; q4++) {
                  { u32x2 pv; pv.x = pack2(acc[nt][mt][4 * q4 + 0] * rstd[mt], acc[nt][mt][4 * q4 + 1] * rstd[mt]); pv.y = pack2(acc[nt][mt][4 * q4 + 2] * rstd[mt], acc[nt][mt][4 * q4 + 3] * rstd[mt]); wave_put_bf16(wbuf, mh * 32 + el31, nt, q4, elh, pv); }
                }
            }
            if (tn < 16) wave_flush_bf16(wbuf, (bf16_t*)ga.o3 + (size_t)(mw0 + h * 64) * 512 + (tn - 12) * 128 + ewn * 64, 512, elane);
            else wave_flush_bf16(wbuf, (bf16_t*)ga.o4 + (size_t)(mw0 + h * 64) * 64, 64, elane);
          }
        } else if (tn == 16) {
          float* iw = (float*)ga.o5;
          const float sc = 0.35355339059327373f * 0.125f;
#pragma unroll
          for (int mt = 0; mt < 4; mt++) {
            const int m = mw0 + mt * 32 + el31;
            f32x4 o;
            o.x = acc[0][mt][0] * rstd[mt] * sc; o.y = acc[0][mt][1] * rstd[mt] * sc;
            o.z = acc[0][mt][2] * rstd[mt] * sc; o.w = acc[0][mt][3] * rstd[mt] * sc;
            *(f32x4*)(iw + (size_t)m * 8 + 4 * elh) = o;
          }
        }
      }
    } else if (MODE == M_RESID || MODE == M_POOL) {
      float* ho = (float*)ga.o0;
      bf16_t* hb = (bf16_t*)ga.o1;
      const int cch = elane & 15;
      const int n = n0 + ewn * 64 + cch * 4;
      f32x4 cs = f32x4{1.f, 1.f, 1.f, 1.f};
      if (MODE == M_POOL) cs = *(const f32x4*)(ga.g0 + n);
#pragma unroll
      for (int h = 0; h < 2; h++) {
#pragma unroll
        for (int mh = 0; mh < 2; mh++) {
          const int mt = 2 * h + mh;
          const int ml = mh * 32 + el31;
#pragma unroll
          for (int nt = 0; nt < 2; nt++)
#pragma unroll
            for (int q4 = 0; q4 < 4; q4++) {
              const int chunk = nt * 8 + 2 * q4 + elh;
              f32x4 v; v.x = acc[nt][mt][4 * q4 + 0]; v.y = acc[nt][mt][4 * q4 + 1]; v.z = acc[nt][mt][4 * q4 + 2]; v.w = acc[nt][mt][4 * q4 + 3];
              *(f32x4*)(wbuf + ml * 256 + ((chunk ^ (ml & 15)) << 4)) = v;
            }
        }
#pragma unroll 4
        for (int i = 0; i < 16; i++) {
          const int row = i * 4 + (elane >> 4);
          const int m = mw0 + h * 64 + row;
          const f32x4 a = *(const f32x4*)(wbuf + row * 256 + ((cch ^ (row & 15)) << 4));
          const f32x4 rv = *(const f32x4*)(ga.resid + (size_t)m * 1024 + n);
          f32x4 o;
          o.x = rv.x + a.x * cs.x; o.y = rv.y + a.y * cs.y; o.z = rv.z + a.z * cs.z; o.w = rv.w + a.w * cs.w;
          *(f32x4*)(ho + (size_t)m * 1024 + n) = o;
          u32x2 ob; ob.x = pack2(o.x, o.y); ob.y = pack2(o.z, o.w);
          *(u32x2*)(hb + (size_t)m * 1024 + n) = ob;
          float sq = o.x * o.x + o.y * o.y + o.z * o.z + o.w * o.w;
          sq += __shfl_xor(sq, 1); sq += __shfl_xor(sq, 2); sq += __shfl_xor(sq, 4); sq += __shfl_xor(sq, 8);
          if (cch == 0) ga.ssq[(size_t)m * 16 + tn * 2 + ewn] = sq;
        }
      }
    } else if (MODE == M_MLP1) {
#pragma unroll
      for (int h = 0; h < 2; h++) {
#pragma unroll
        for (int mh = 0; mh < 2; mh++) {
          const int mt = 2 * h + mh;
#pragma unroll
          for (int nt = 0; nt < 2; nt++)
#pragma unroll
            for (int q4 = 0; q4 < 4; q4++) {
              const float v0 = fmaxf(acc[nt][mt][4 * q4 + 0] * rstd[mt], 0.f), v1 = fmaxf(acc[nt][mt][4 * q4 + 1] * rstd[mt], 0.f);
              const float v2 = fmaxf(acc[nt][mt][4 * q4 + 2] * rstd[mt], 0.f), v3 = fmaxf(acc[nt][mt][4 * q4 + 3] * rstd[mt], 0.f);
              { u32x2 pv; pv.x = pack2(v0 * v0, v1 * v1); pv.y = pack2(v2 * v2, v3 * v3); wave_put_bf16(wbuf, mh * 32 + el31, nt, q4, elh, pv); }
            }
        }
        wave_flush_bf16(wbuf, (bf16_t*)ga.o0 + (size_t)(mw0 + h * 64) * 4096 + n0 + ewn * 64, 4096, elane);
      }
    }
    __syncthreads();
  }
}

DEVI void grp_barrier(volatile __attribute__((address_space(3))) unsigned* ctr, unsigned& target, const int lane) {
  asm volatile("s_waitcnt vmcnt(0) lgkmcnt(0)" ::: "memory");
  target += 4u;
  if (lane == 0) __hip_atomic_fetch_add((__attribute__((address_space(3))) unsigned*)ctr, 1u, __ATOMIC_RELAXED, __HIP_MEMORY_SCOPE_WORKGROUP);
  while (__hip_atomic_load((__attribute__((address_space(3))) unsigned*)ctr, __ATOMIC_RELAXED, __HIP_MEMORY_SCOPE_WORKGROUP) < target) __builtin_amdgcn_s_sleep(1);
  asm volatile("" ::: "memory");
}

template <int DQK, bool MASKED>
DEVI void flash_qtile(const bf16_t* __restrict__ qrow, const bf16_t* __restrict__ Kb, const int kstride,
                      const bf16_t* __restrict__ Vt, const u64* __restrict__ mrow, const int qt,
                      char* smem, f32x16 (&O)[4], const float negc0,
                      volatile __attribute__((address_space(3))) unsigned* gctr, unsigned& gtarget) {
  constexpr int KROWB = DQK * 2;
  constexpr int KS = DQK / 16;
  constexpr int KBYTES = 64 * KROWB;
  constexpr int STAGE = KBYTES + 16384;
  constexpr int KI = KBYTES / 4096;
  const int tid = otid(), lane = tid & 63, w = tid >> 6;
  const int l31 = lane & 31, lh = lane >> 5;
  unsigned kgo[KI], vgo[4];
#pragma unroll
  for (int i = 0; i < KI; i++) {
    const int blk = i * 4 + w;
    int row, kc;
    if (DQK == 64) { row = blk * 8 + (lane >> 3); kc = (lane & 7) ^ ((row >> 1) & 7); }
    else { row = blk * 4 + (lane >> 4); kc = (lane & 15) ^ (row & 15); }
    kgo[i] = (unsigned)(row * kstride + kc * 8) * 2u;
  }
#pragma unroll
  for (int i = 0; i < 4; i++) {
    const int blk = i * 4 + w;
    const int row = blk * 8 + (lane >> 3);
    const int kc = (lane & 7) ^ ((row >> 1) & 7);
    vgo[i] = (unsigned)(row * 4096 + kc * 8) * 2u;
  }
  bf16x8 qf[KS];
#pragma unroll
  for (int ks = 0; ks < KS; ks++) qf[ks] = *(const bf16x8*)(qrow + 16 * ks + 8 * lh);
#pragma unroll
  for (int eb = 0; eb < 4; eb++)
#pragma unroll
    for (int r = 0; r < 16; r++) O[eb][r] = 0.f;
  float lsum = 0.f;
  const int ntile = 2 * qt + 2;
  const int mylast = 2 * qt + (w >> 1);
  u64 mw_next = 0ull;
  if (MASKED) mw_next = mrow[0];
  grp_barrier(gctr, gtarget, lane);
  {
    const char* kt = (const char*)Kb;
    const char* vtp = (const char*)Vt;
#pragma unroll
    for (int i = 0; i < KI; i++)
      __builtin_amdgcn_global_load_lds((const unsigned*)(kt + kgo[i]), (__attribute__((address_space(3))) unsigned*)(smem + (i * 4 + w) * 1024), 16, 0, 0);
#pragma unroll
    for (int i = 0; i < 4; i++)
      __builtin_amdgcn_global_load_lds((const unsigned*)(vtp + vgo[i]), (__attribute__((address_space(3))) unsigned*)(smem + KBYTES + (i * 4 + w) * 1024), 16, 0, 0);
  }
  grp_barrier(gctr, gtarget, lane);
  for (int j = 0; j < ntile; j++) {
    const char* st = smem + (j & 1) * STAGE;
    const bool more = (j + 1 < ntile);
    if (more) {
      const char* kt = (const char*)Kb + (size_t)(j + 1) * 64 * kstride * 2;
      const char* vtp = (const char*)Vt + (size_t)(j + 1) * 64 * 2;
      char* sn = smem + ((j + 1) & 1) * STAGE;
#pragma unroll
      for (int i = 0; i < KI; i++) {
        unsigned off = kgo[i];
        asm volatile("" : "+v"(off));
        __builtin_amdgcn_global_load_lds((const unsigned*)(kt + off), (__attribute__((address_space(3))) unsigned*)(sn + (i * 4 + w) * 1024), 16, 0, 0);
      }
#pragma unroll
      for (int i = 0; i < 4; i++) {
        unsigned off = vgo[i];
        asm volatile("" : "+v"(off));
        __builtin_amdgcn_global_load_lds((const unsigned*)(vtp + off), (__attribute__((address_space(3))) unsigned*)(sn + KBYTES + (i * 4 + w) * 1024), 16, 0, 0);
      }
    }
    const u64 mw = mw_next;
    if (MASKED && more) mw_next = mrow[j + 1];
    if (j <= mylast) {
      f32x16 S[2];
#pragma unroll
      for (int mt = 0; mt < 2; mt++)
#pragma unroll
        for (int r = 0; r < 16; r++) S[mt][r] = negc0;
#pragma unroll
      for (int ks = 0; ks < KS; ks++)
#pragma unroll
        for (int mt = 0; mt < 2; mt++) {
          bf16x8 kf = *(const bf16x8*)(st + lds_off<KROWB>(mt * 32 + l31, 2 * ks + lh));
          S[mt] = mfma32(kf, qf[ks], S[mt]);
        }
      unsigned wlo = 0xffffffffu, whi = 0xffffffffu;
      if (MASKED) {
        wlo = ((unsigned)mw) >> (4 * lh);
        whi = ((unsigned)(mw >> 32)) >> (4 * lh);
      }
      float ps = 0.f;
#pragma unroll
      for (int mt = 0; mt < 2; mt++)
#pragma unroll
        for (int r = 0; r < 16; r++) {
          float pv = fexp2(S[mt][r]);
          if (MASKED) {
            const unsigned wd = mt ? whi : wlo;
            pv = ((wd >> ((r & 3) + 8 * (r >> 2))) & 1u) ? pv : 0.f;
          }
          S[mt][r] = pv;
          ps += pv;
        }
      lsum += ps;
#pragma unroll
      for (int kb = 0; kb < 2; kb++)
#pragma unroll
        for (int s = 0; s < 2; s++) {
          u32x4 pfu;
          pfu.x = pack2(S[kb][8 * s + 0], S[kb][8 * s + 1]);
          pfu.y = pack2(S[kb][8 * s + 2], S[kb][8 * s + 3]);
          pfu.z = pack2(S[kb][8 * s + 4], S[kb][8 * s + 5]);
          pfu.w = pack2(S[kb][8 * s + 6], S[kb][8 * s + 7]);
          const bf16x8 pfv = __builtin_bit_cast(bf16x8, pfu);
#pragma unroll
          for (int eb = 0; eb < 4; eb++) {
            const int row = eb * 32 + l31;
            const u32x2 h0 = *(const u32x2*)(st + KBYTES + lds_off<128>(row, 4 * kb + 2 * s) + 8 * lh);
            const u32x2 h1 = *(const u32x2*)(st + KBYTES + lds_off<128>(row, 4 * kb + 2 * s + 1) + 8 * lh);
            const u32x4 vfu = u32x4{h0.x, h0.y, h1.x, h1.y};
            O[eb] = mfma32(__builtin_bit_cast(bf16x8, vfu), pfv, O[eb]);
          }
        }
    }
    grp_barrier(gctr, gtarget, lane);
  }
  float lt = lsum + __shfl_xor(lsum, 32);
  const float inv = 1.f / lt;
#pragma unroll
  for (int eb = 0; eb < 4; eb++)
#pragma unroll
    for (int r = 0; r < 16; r++) O[eb][r] *= inv;
}

DEVI void flash_qtile_pipe(const bf16_t* __restrict__ qrow, const bf16_t* __restrict__ Kb, const int kstride,
                           const bf16_t* __restrict__ Vt, const int qt,
                           char* smem, f32x16 (&O)[4], const float negc0,
                           volatile __attribute__((address_space(3))) unsigned* gctr, unsigned& gtarget) {
  constexpr int KBYTES = 64 * 128;
  constexpr int STAGE = KBYTES + 16384;
  const int tid = otid(), lane = tid & 63, w = tid >> 6;
  const int l31 = lane & 31, lh = lane >> 5;
  unsigned kgo[2], vgo[4];
#pragma unroll
  for (int i = 0; i < 2; i++) {
    const int blk = i * 4 + w;
    const int row = blk * 8 + (lane >> 3);
    const int kc = (lane & 7) ^ ((row >> 1) & 7);
    kgo[i] = (unsigned)(row * kstride + kc * 8) * 2u;
  }
#pragma unroll
  for (int i = 0; i < 4; i++) {
    const int blk = i * 4 + w;
    const int row = blk * 8 + (lane >> 3);
    const int kc = (lane & 7) ^ ((row >> 1) & 7);
    vgo[i] = (unsigned)(row * 4096 + kc * 8) * 2u;
  }
  bf16x8 qf[4];
#pragma unroll
  for (int ks = 0; ks < 4; ks++) qf[ks] = *(const bf16x8*)(qrow + 16 * ks + 8 * lh);
#pragma unroll
  for (int eb = 0; eb < 4; eb++)
#pragma unroll
    for (int r = 0; r < 16; r++) O[eb][r] = 0.f;
  float lsum = 0.f;
  const int ntile = 2 * qt + 2;
  const int mylast = 2 * qt + (w >> 1);
#define FP_DMA_K(T, STG)                                                                              \
  { const char* kt = (const char*)Kb + (size_t)(T) * 64 * kstride * 2;                                \
    _Pragma("unroll") for (int i = 0; i < 2; i++) {                                                   \
      unsigned off = kgo[i]; asm volatile("" : "+v"(off));                                            \
      __builtin_amdgcn_global_load_lds((const unsigned*)(kt + off), (__attribute__((address_space(3))) unsigned*)(smem + (STG) * STAGE + (i * 4 + w) * 1024), 16, 0, 0); } }
#define FP_DMA_V(T, STG)                                                                              \
  { const char* vtp = (const char*)Vt + (size_t)(T) * 64 * 2;                                         \
    _Pragma("unroll") for (int i = 0; i < 4; i++) {                                                   \
      unsigned off = vgo[i]; asm volatile("" : "+v"(off));                                            \
      __builtin_amdgcn_global_load_lds((const unsigned*)(vtp + off), (__attribute__((address_space(3))) unsigned*)(smem + (STG) * STAGE + KBYTES + (i * 4 + w) * 1024), 16, 0, 0); } }
#define FP_QK(SX, STG)                                                                                \
  { _Pragma("unroll") for (int mt = 0; mt < 2; mt++)                                                  \
      _Pragma("unroll") for (int r = 0; r < 16; r++) SX[mt][r] = negc0;                               \
    _Pragma("unroll") for (int ks = 0; ks < 4; ks++)                                                  \
      _Pragma("unroll") for (int mt = 0; mt < 2; mt++) {                                              \
        bf16x8 kf = *(const bf16x8*)(smem + (STG) * STAGE + lds_off<128>(mt * 32 + l31, 2 * ks + lh)); \
        SX[mt] = mfma32(kf, qf[ks], SX[mt]); } }
#define FP_SMPV(SX, STG)                                                                              \
  { float ps = 0.f;                                                                                   \
    _Pragma("unroll") for (int mt = 0; mt < 2; mt++)                                                  \
      _Pragma("unroll") for (int r = 0; r < 16; r++) { const float pv = fexp2(SX[mt][r]); SX[mt][r] = pv; ps += pv; } \
    lsum += ps;                                                                                       \
    _Pragma("unroll") for (int kb = 0; kb < 2; kb++)                                                  \
      _Pragma("unroll") for (int s = 0; s < 2; s++) {                                                 \
        u32x4 pfu;                                                                                    \
        pfu.x = pack2(SX[kb][8 * s + 0], SX[kb][8 * s + 1]);                                          \
        pfu.y = pack2(SX[kb][8 * s + 2], SX[kb][8 * s + 3]);                                          \
        pfu.z = pack2(SX[kb][8 * s + 4], SX[kb][8 * s + 5]);                                          \
        pfu.w = pack2(SX[kb][8 * s + 6], SX[kb][8 * s + 7]);                                          \
        const bf16x8 pfv = __builtin_bit_cast(bf16x8, pfu);                                           \
        _Pragma("unroll") for (int eb = 0; eb < 4; eb++) {                                            \
          const int row = eb * 32 + l31;                                                              \
          const u32x2 h0 = *(const u32x2*)(smem + (STG) * STAGE + KBYTES + lds_off<128>(row, 4 * kb + 2 * s) + 8 * lh);     \
          const u32x2 h1 = *(const u32x2*)(smem + (STG) * STAGE + KBYTES + lds_off<128>(row, 4 * kb + 2 * s + 1) + 8 * lh); \
          const u32x4 vfu = u32x4{h0.x, h0.y, h1.x, h1.y};                                            \
          O[eb] = mfma32(__builtin_bit_cast(bf16x8, vfu), pfv, O[eb]); } } }
#define FP_STEP(J, SCUR, SNEXT, STG)                                                                  \
  { if ((J) + 2 < ntile) FP_DMA_K((J) + 2, STG)                                                       \
    if ((J) + 1 < ntile) FP_DMA_V((J) + 1, (STG) ^ 1)                                                 \
    if ((J) + 1 <= mylast) FP_QK(SNEXT, (STG) ^ 1)                                                    \
    if ((J) <= mylast) FP_SMPV(SCUR, STG)                                                             \
    grp_barrier(gctr, gtarget, lane); }
  f32x16 SA[2], SB[2];
  grp_barrier(gctr, gtarget, lane);
  FP_DMA_K(0, 0)
  FP_DMA_V(0, 0)
  FP_DMA_K(1, 1)
  grp_barrier(gctr, gtarget, lane);
  FP_QK(SA, 0)
  grp_barrier(gctr, gtarget, lane);
#pragma unroll
  for (int mt = 0; mt < 2; mt++)
#pragma unroll
    for (int r = 0; r < 16; r++) SB[mt][r] = 0.f;
  for (int j = 0; j < ntile; j += 2) {
    FP_STEP(j, SA, SB, 0)
    FP_STEP(j + 1, SB, SA, 1)
  }
#undef FP_DMA_K
#undef FP_DMA_V
#undef FP_QK
#undef FP_SMPV
#undef FP_STEP
  float lt = lsum + __shfl_xor(lsum, 32);
  const float inv = 1.f / lt;
#pragma unroll
  for (int eb = 0; eb < 4; eb++)
#pragma unroll
    for (int r = 0; r < 16; r++) O[eb][r] *= inv;
}

DEVI void attnA_phase(const Params& p, int jl, float lambda_init, char* smem,
                        volatile __attribute__((address_space(3))) unsigned* gctr, unsigned& gtarget) {
  const int tid = otid(), lane = tid & 63, w = tid >> 6;
  const int l31 = lane & 31, lh = lane >> 5;
  const bf16_t* qk = (const bf16_t*)(p.ws + R_QK);
  const bf16_t* vt = (const bf16_t*)(p.ws + R_VT);
  bf16_t* ao = (bf16_t*)(p.ws + R_AO);
  float s1 = p.a_lq1[jl * 64 + lane] * p.a_lk1[jl * 64 + lane];
  float s2 = p.a_lq2[jl * 64 + lane] * p.a_lk2[jl * 64 + lane];
#pragma unroll
  for (int o = 32; o >= 1; o >>= 1) { s1 += __shfl_xor(s1, o); s2 += __shfl_xor(s2, o); }
  const float lam = expf(s1) - expf(s2) + lambda_init;
  float gq = fabsf(p.a_q_g[jl * 64 + lane]), gk = fabsf(p.a_k_g[jl * 64 + lane]);
#pragma unroll
  for (int o = 32; o >= 1; o >>= 1) { gq = fmaxf(gq, __shfl_xor(gq, o)); gk = fmaxf(gk, __shfl_xor(gk, o)); }
  const float negc0 = -(8.0f * gq * gk * LOG2E * 1.01f);
  const float* subg = p.a_sub_g + jl * 128;
  for (int item = vblk(); item < 512; item += nvblk()) {
    const int pr = item & 15, h = (item >> 4) & 7, b = item >> 7;
    for (int qi = 0; qi < 2; qi++) {
      const int qt = qi ? pr : (31 - pr);
      const int t = b * SEQ + qt * 128 + w * 32 + l31;
      f32x16 O[4];
      flash_qtile_pipe(qk + (size_t)t * 2048 + h * 128, qk + (size_t)b * SEQ * 2048 + 1024 + h * 128, 2048,
                             vt + (size_t)(b * 8 + h) * 128 * 4096, qt, smem, O, negc0, gctr, gtarget);
#pragma unroll
      for (int eb = 0; eb < 4; eb++)
#pragma unroll
        for (int q4 = 0; q4 < 4; q4++) {
          const int e = eb * 32 + 8 * q4 + 4 * lh;
          u32x2 o;
          o.x = pack2(O[eb][4 * q4 + 0], O[eb][4 * q4 + 1]);
          o.y = pack2(O[eb][4 * q4 + 2], O[eb][4 * q4 + 3]);
          *(u32x2*)(ao + (size_t)t * 1024 + h * 128 + e) = o;
        }
      flash_qtile_pipe(qk + (size_t)t * 2048 + h * 128 + 64, qk + (size_t)b * SEQ * 2048 + 1024 + h * 128 + 64, 2048,
                             vt + (size_t)(b * 8 + h) * 128 * 4096, qt, smem, O, negc0, gctr, gtarget);
      float ssq = 0.f;
#pragma unroll
      for (int eb = 0; eb < 4; eb++)
#pragma unroll
        for (int q4 = 0; q4 < 4; q4++) {
          const int e = eb * 32 + 8 * q4 + 4 * lh;
          const u32x2 o1 = *(const u32x2*)(ao + (size_t)t * 1024 + h * 128 + e);
          const float a0 = bf_lo(o1.x) - lam * O[eb][4 * q4 + 0];
          const float a1 = bf_hi(o1.x) - lam * O[eb][4 * q4 + 1];
          const float a2 = bf_lo(o1.y) - lam * O[eb][4 * q4 + 2];
          const float a3 = bf_hi(o1.y) - lam * O[eb][4 * q4 + 3];
          O[eb][4 * q4 + 0] = a0; O[eb][4 * q4 + 1] = a1; O[eb][4 * q4 + 2] = a2; O[eb][4 * q4 + 3] = a3;
          ssq += a0 * a0 + a1 * a1 + a2 * a2 + a3 * a3;
        }
      ssq += __shfl_xor(ssq, 32);
      const float rn = rsqrtf(ssq * (1.f / 128.f) + EPS) * (1.f - lambda_init);
#pragma unroll
      for (int eb = 0; eb < 4; eb++)
#pragma unroll
        for (int q4 = 0; q4 < 4; q4++) {
          const int e = eb * 32 + 8 * q4 + 4 * lh;
          const f32x4 gv = *(const f32x4*)(subg + e);
          u32x2 o;
          o.x = pack2(O[eb][4 * q4 + 0] * rn * gv.x, O[eb][4 * q4 + 1] * rn * gv.y);
          o.y = pack2(O[eb][4 * q4 + 2] * rn * gv.z, O[eb][4 * q4 + 3] * rn * gv.w);
          *(u32x2*)(ao + (size_t)t * 1024 + h * 128 + e) = o;
        }
    }
  }
}

DEVI void attnC_phase(const Params& p, char* smem, volatile __attribute__((address_space(3))) unsigned* gctr, unsigned& gtarget) {
  const int tid = otid(), lane = tid & 63, w = tid >> 6;
  const int l31 = lane & 31, lh = lane >> 5;
  const bf16_t* cq = (const bf16_t*)(p.ws + R_CQ);
  const bf16_t* ck = (const bf16_t*)(p.ws + R_CK);
  const bf16_t* cvt = (const bf16_t*)(p.ws + R_CVT);
  const u64* mask = (const u64*)(p.ws + R_MASK);
  bf16_t* ao = (bf16_t*)(p.ws + R_AO);
  float gq = fmaxf(fabsf(p.c_q_g[lane]), fabsf(p.c_q_g[64 + lane])), gk = fmaxf(fabsf(p.c_k_g[lane]), fabsf(p.c_k_g[64 + lane]));
#pragma unroll
  for (int o = 32; o >= 1; o >>= 1) { gq = fmaxf(gq, __shfl_xor(gq, o)); gk = fmaxf(gk, __shfl_xor(gk, o)); }
  const float negc0 = -(11.313708498984761f * gq * gk * LOG2E * 1.01f);
  for (int item = vblk(); item < 512; item += nvblk()) {
    const int pr = item & 15, hh = (item >> 4) & 7, b = item >> 7;
    const int g = hh >> 2;
    for (int qi = 0; qi < 2; qi++) {
      const int qt = qi ? pr : (31 - pr);
      const int t = b * SEQ + qt * 128 + w * 32 + l31;
      f32x16 O[4];
      flash_qtile<128, true>(cq + (size_t)t * 1024 + hh * 128, ck + (size_t)b * SEQ * 256 + g * 128, 256,
                             cvt + (size_t)(b * 2 + g) * 128 * 4096, mask + (size_t)t * 64, qt, smem, O, negc0, gctr, gtarget);
#pragma unroll
      for (int eb = 0; eb < 4; eb++)
#pragma unroll
        for (int q4 = 0; q4 < 4; q4++) {
          const int e = eb * 32 + 8 * q4 + 4 * lh;
          u32x2 o;
          o.x = pack2(O[eb][4 * q4 + 0], O[eb][4 * q4 + 1]);
          o.y = pack2(O[eb][4 * q4 + 2], O[eb][4 * q4 + 3]);
          *(u32x2*)(ao + (size_t)t * 1024 + hh * 128 + e) = o;
        }
    }
  }
}

DEVI void pool_phase(const Params& p, char* smem) {
  const int tid = otid(), lane = tid & 63, w = tid >> 6;
  float* rs = (float*)smem;
  const float* h = p.out;
  bf16_t* pooled = (bf16_t*)(p.ws + R_POOL);
  for (int tile = vblk(); tile < T_TOK / 32; tile += nvblk()) {
    const int t0 = tile * 32;
    const int pos0 = t0 & (SEQ - 1);
    __syncthreads();
    for (int r = w; r < 47; r += 4) {
      const int pos = pos0 - 15 + r;
      if (pos >= 0) {
        const float* row = h + (size_t)(t0 - 15 + r) * 1024;
        float s = 0.f;
#pragma unroll
        for (int i = 0; i < 4; i++) {
          f32x4 v = *(const f32x4*)(row + i * 256 + lane * 4);
          s += v.x * v.x + v.y * v.y + v.z * v.z + v.w * v.w;
        }
#pragma unroll
        for (int o = 32; o >= 1; o >>= 1) s += __shfl_xor(s, o);
        if (lane == 0) rs[r] = rsqrtf(s * (1.f / 1024.f) + EPS);
      }
    }
    __syncthreads();
    const int c = tid * 4;
    const int grp = c >> 8;
    const int win = 2 << grp;
    f32x4 sum = f32x4{0.f, 0.f, 0.f, 0.f};
    for (int r = -(win - 1); r < 0; r++) {
      if (pos0 + r >= 0) {
        f32x4 v = *(const f32x4*)(h + (size_t)(t0 + r) * 1024 + c);
        const float s = rs[r + 15];
        sum.x += v.x * s; sum.y += v.y * s; sum.z += v.z * s; sum.w += v.w * s;
      }
    }
    for (int r = 0; r < 32; r++) {
      f32x4 v = *(const f32x4*)(h + (size_t)(t0 + r) * 1024 + c);
      const float s = rs[r + 15];
      v.x *= s; v.y *= s; v.z *= s; v.w *= s;
      sum.x += v.x; sum.y += v.y; sum.z += v.z; sum.w += v.w;
      const int pos = pos0 + r;
      const float ic = 1.f / (float)min(pos + 1, win);
      u32x2 o;
      o.x = pack2(sum.x * ic - v.x, sum.y * ic - v.y);
      o.y = pack2(sum.z * ic - v.z, sum.w * ic - v.w);
      *(u32x2*)(pooled + (size_t)(t0 + r) * 1024 + c) = o;
      const int ro = r - win + 1;
      if (pos0 + ro >= 0) {
        f32x4 u = *(const f32x4*)(h + (size_t)(t0 + ro) * 1024 + c);
        const float so = rs[ro + 15];
        sum.x -= u.x * so; sum.y -= u.y * so; sum.z -= u.z * so; sum.w -= u.w * so;
      }
    }
  }
}

DEVI unsigned fkey(float f) {
  unsigned u = __float_as_uint(f);
  return (u & 0x80000000u) ? ~u : (u | 0x80000000u);
}

template <int NR>
DEVI void select_topk(const float* srow, const int c, const int lane, u64* mrow) {
  unsigned kreg[NR];
#pragma unroll
  for (int j = 0; j < NR; j++) {
    const unsigned k = fkey(srow[j * 64 + lane]);
    kreg[j] = (j <= c) ? k : 0u;
  }
  unsigned T = 0u;
  bool exact = false;
#pragma unroll 1
  for (int bit = 31; bit >= 0; bit--) {
    const unsigned cand = T | (1u << bit);
    int cnt = 0;
#pragma unroll
    for (int j = 0; j < NR; j++) cnt += __popcll(__ballot(kreg[j] >= cand));
    if (cnt >= 256) T = cand;
    if (cnt == 256) { exact = true; break; }
  }
  asm volatile("" : "+v"(T));
  if (exact) {
#pragma unroll
    for (int j = 0; j < NR; j++) {
      const u64 bm = __ballot(kreg[j] >= T);
      if (lane == 0) mrow[j] = bm;
    }
  } else {
    int cgt = 0;
#pragma unroll
    for (int j = 0; j < NR; j++) cgt += __popcll(__ballot(kreg[j] > T));
    int need = 256 - cgt;
#pragma unroll
    for (int j = 0; j < NR; j++) {
      const u64 gt = __ballot(kreg[j] > T);
      const u64 eq = __ballot(kreg[j] == T);
      const int rank = __popcll(eq & ((1ull << lane) - 1ull));
      const u64 tk = __ballot((kreg[j] == T) && (rank < need));
      need -= __popcll(eq);
      const u64 bm = gt | tk;
      if (lane == 0) mrow[j] = bm;
    }
  }
}

DEVI void index_unit(const Params& p, int unit, char* smem, volatile __attribute__((address_space(3))) unsigned* gctr, unsigned& gtarget) {
  const int tid = otid(), lane = tid & 63, w = tid >> 6;
  const int l31 = lane & 31, lh = lane >> 5;
  const int c = unit >> 4, b = (unit >> 2) & 3, qr = unit & 3;
  const int t0 = b * SEQ + c * 64 + qr * 16;
  u64* mask = (u64*)(p.ws + R_MASK);
  if (c < 4) {
    if (tid < 16 * (c + 1)) {
      const int q = tid / (c + 1), j = tid % (c + 1);
      u64 ones = ~0ull;
      asm volatile("" : "+v"(ones));
      mask[(size_t)(t0 + q) * 64 + j] = ones;
    }
    return;
  }
  const bf16_t* ciq = (const bf16_t*)(p.ws + R_CIQ);
  const bf16_t* cik = (const bf16_t*)(p.ws + R_CIK);
  const float* ciw = (const float*)(p.ws + R_CIW);
  float* sc = (float*)smem;
  const int nkb = 2 * (c + 1);
  for (int grp = 0; grp < 4; grp++) {
    const int tq = t0 + grp * 4;
    {
      const int a = l31 >> 3, gg = (l31 >> 2) & 1, bq = l31 & 3;
      const int qloc = 2 * gg + (a >> 1), head = (a & 1) * 4 + bq;
      bf16x8 af[4];
#pragma unroll
      for (int ks = 0; ks < 4; ks++) af[ks] = *(const bf16x8*)(ciq + (size_t)(tq + qloc) * 512 + head * 64 + 16 * ks + 8 * lh);
      float wq0[8], wq1[8];
      {
        const f32x4 a0 = *(const f32x4*)(ciw + (size_t)(tq + 2 * lh) * 8), a1 = *(const f32x4*)(ciw + (size_t)(tq + 2 * lh) * 8 + 4);
        const f32x4 b0 = *(const f32x4*)(ciw + (size_t)(tq + 2 * lh + 1) * 8), b1 = *(const f32x4*)(ciw + (size_t)(tq + 2 * lh + 1) * 8 + 4);
        wq0[0] = a0.x; wq0[1] = a0.y; wq0[2] = a0.z; wq0[3] = a0.w; wq0[4] = a1.x; wq0[5] = a1.y; wq0[6] = a1.z; wq0[7] = a1.w;
        wq1[0] = b0.x; wq1[1] = b0.y; wq1[2] = b0.z; wq1[3] = b0.w; wq1[4] = b1.x; wq1[5] = b1.y; wq1[6] = b1.z; wq1[7] = b1.w;
      }
      const int nit = (nkb - w + 3) >> 2;
      const bf16_t* ikb = cik + (size_t)b * SEQ * 64 + 8 * lh;
      bf16x8 nb[4][4];
#pragma unroll
      for (int u = 0; u < 4; u++) {
        const int kb = min(w + 4 * u, nkb - 1);
#pragma unroll
        for (int ks = 0; ks < 4; ks++) nb[u][ks] = *(const bf16x8*)(ikb + (size_t)(kb * 32 + l31) * 64 + 16 * ks);
      }
      for (int it0 = 0; it0 < nit; it0 += 4) {
        bf16x8 cb[4][4];
#pragma unroll
        for (int u = 0; u < 4; u++)
#pragma unroll
          for (int ks = 0; ks < 4; ks++) cb[u][ks] = nb[u][ks];
        if (it0 + 4 < nit) {
#pragma unroll
          for (int u = 0; u < 4; u++) {
            const int kb = min(w + 4 * (it0 + 4 + u), nkb - 1);
#pragma unroll
            for (int ks = 0; ks < 4; ks++) nb[u][ks] = *(const bf16x8*)(ikb + (size_t)(kb * 32 + l31) * 64 + 16 * ks);
          }
        }
#pragma unroll
        for (int u = 0; u < 4; u++) {
          const int kb = w + 4 * (it0 + u);
          f32x16 acc;
#pragma unroll
          for (int r = 0; r < 16; r++) acc[r] = 0.f;
#pragma unroll
          for (int ks = 0; ks < 4; ks++) acc = mfma32(af[ks], cb[u][ks], acc);
          float s0 = 0.f, s1 = 0.f;
#pragma unroll
          for (int r = 0; r < 8; r++) s0 += wq0[r] * fmaxf(acc[r], 0.f);
#pragma unroll
          for (int r = 0; r < 8; r++) s1 += wq1[r] * fmaxf(acc[8 + r], 0.f);
          if (s0 == 0.f) s0 = 0.f;
          if (s1 == 0.f) s1 = 0.f;
          if (kb < nkb) {
            const int key = kb * 32 + l31;
            sc[(2 * lh) * 4096 + key] = s0;
            sc[(2 * lh + 1) * 4096 + key] = s1;
          }
        }
      }
    }
    grp_barrier(gctr, gtarget, lane);
    {
      u64* mrow = mask + (size_t)(tq + w) * 64;
      const float* srow = sc + w * 4096;
      if (c < 16) select_topk<16>(srow, c, lane, mrow);
      else if (c < 32) select_topk<32>(srow, c, lane, mrow);
      else if (c < 48) select_topk<48>(srow, c, lane, mrow);
      else select_topk<64>(srow, c, lane, mrow);
    }
    grp_barrier(gctr, gtarget, lane);
  }
}

DEVI void index_phase(const Params& p, char* smem, volatile __attribute__((address_space(3))) unsigned* gctr, unsigned& gtarget) {
  for (int it2 = vblk() * 2; it2 < 1024; it2 += nvblk() * 2) {
    for (int k = 0; k < 2; k++) {
      const int item = it2 >> 1;
      index_unit(p, k ? item : (1023 - item), smem, gctr, gtarget);
    }
  }
}


#define XB_TMO      128
#define XB_XCNT(j)  (256  + 64 * (j))
#define XB_XSUB(j)  (1280 + 64 * (j))
#define XB_XGEN(j)  (2304 + 64 * (j))
#define XB_TOP      3328
#define XB_TOPGEN   3392
#define XCD_BAR_WORDS 3456
#define XB_SPIN_CAP (1u << 22)
#define LAS __attribute__((address_space(3)))
constexpr size_t OFF_BAR = 250 * MB;

DEVI unsigned xb_ld(unsigned* p)              { return __hip_atomic_load(p, __ATOMIC_RELAXED, __HIP_MEMORY_SCOPE_AGENT); }
DEVI unsigned xb_add(unsigned* p, unsigned v) { return __hip_atomic_fetch_add(p, v, __ATOMIC_RELAXED, __HIP_MEMORY_SCOPE_AGENT); }
DEVI unsigned xb_xcc_id() { return (unsigned)__builtin_amdgcn_s_getreg((3 << 11) | 20) & 0xFu; }
#define XB_SPIN(cond, bar) do { unsigned _sp = 0; while (cond) { __builtin_amdgcn_s_sleep(1); \
    if ((++_sp & 255u) == 0u) { if (xb_ld(&(bar)[XB_TMO])) break; if (_sp > XB_SPIN_CAP) { atomicAdd(&(bar)[XB_TMO], 1u); break; } } } } while (0)

struct XcdBarrier { unsigned* bar; volatile LAS unsigned* st; };

DEVI XcdBarrier xcd_barrier_post(unsigned* bar, volatile LAS unsigned* st) {
  XcdBarrier b; b.bar = bar; b.st = st;
  if (threadIdx.x == 0) (void)xb_add(&bar[XB_XCNT(xb_xcc_id())], 1u);
  return b;
}
DEVI void xcd_barrier_complete(unsigned* bar, unsigned x, unsigned& nloc, unsigned& nx) {
  const unsigned G = gridDim.x * gridDim.y * gridDim.z;
  unsigned sum, cnt, mine, sp = 0u;
  for (;;) {
    sum = 0u; cnt = 0u; mine = 0u;
#pragma unroll
    for (unsigned j = 0; j < 16; ++j) { const unsigned c = xb_ld(&bar[XB_XCNT(j)]); sum += c; cnt += (c > 0u) ? 1u : 0u; mine = (j == x) ? c : mine; }
    if (sum == G) break;
    __builtin_amdgcn_s_sleep(1);
    if ((++sp & 255u) == 0u) { if (xb_ld(&bar[XB_TMO])) break; if (sp > XB_SPIN_CAP) { atomicAdd(&bar[XB_TMO], 1u); break; } }
  }
  nloc = mine > 0u ? mine : 1u; nx = cnt > 0u ? cnt : 1u;
}
DEVI void xcd_barrier(const XcdBarrier& b) {
  asm volatile("s_waitcnt vmcnt(0)" ::: "memory");
  __syncthreads();
  if (threadIdx.x == 0) {
    unsigned* bar = b.bar;
    const unsigned bx = xb_xcc_id();
    __builtin_amdgcn_s_waitcnt(0);
    unsigned nloc = b.st[0], nx = b.st[1];
    if (nloc == 0u) { xcd_barrier_complete(bar, bx, nloc, nx); b.st[0] = nloc; b.st[1] = nx; }
    const unsigned old = xb_add(&bar[XB_XSUB(bx)], 1u);
    const unsigned gen = old / nloc;
    if (old + 1u == (gen + 1u) * nloc) {
      __builtin_amdgcn_fence(__ATOMIC_RELEASE, "agent");
      asm volatile("s_waitcnt vmcnt(0)" ::: "memory");
      const unsigned og = xb_add(&bar[XB_TOP], 1u);
      const unsigned tg = og / nx;
      if (og + 1u == (tg + 1u) * nx) xb_add(&bar[XB_TOPGEN], 1u);
      else XB_SPIN(xb_ld(&bar[XB_TOPGEN]) == tg, bar);
      __builtin_amdgcn_fence(__ATOMIC_ACQUIRE, "agent");
      xb_add(&bar[XB_XGEN(bx)], 1u);
      asm volatile("s_waitcnt vmcnt(0)" ::: "memory");
    } else {
      XB_SPIN(xb_ld(&bar[XB_XGEN(bx)]) == gen, bar);
      __builtin_amdgcn_fence(__ATOMIC_ACQUIRE, "agent");
      asm volatile("s_waitcnt vmcnt(0)" ::: "memory");
    }
  }
  __syncthreads();
}

__global__ void __launch_bounds__(512, 2) fwd_megakernel(Params p) {
  __shared__ __attribute__((aligned(16))) char smem[SMEM_BYTES];
  cg::grid_group grid = cg::this_grid();
  char* gs = smem + grp_id() * 65536;
  char* ws = p.ws;
  __shared__ __attribute__((aligned(16))) unsigned xb_words[4];
  if (threadIdx.x == 0) { xb_words[0] = 0u; xb_words[1] = 0u; xb_words[2] = 0u; xb_words[3] = 0u; }
  __syncthreads();
  volatile LAS unsigned* gctr = (volatile LAS unsigned*)&xb_words[2 + grp_id()];
  unsigned gtarget = 0u;
  const XcdBarrier xb = xcd_barrier_post((unsigned*)(ws + OFF_BAR), (volatile LAS unsigned*)xb_words);
  if (gridDim.y == 0x7fffffffu) grid.sync();
  bf16_t* hb = (bf16_t*)(ws + OFF_HB);

  for (int rep = 0; rep <= DUP_CONV; rep++) convert_phase(p, gs);
  xcd_barrier(xb);

  for (int layer = 0; layer < 4; layer++) {
    const int mixer = layer % 3, jl = layer / 3;
    const float* resid_src = (layer == 0) ? p.x : p.out;
    if (mixer == 0) {
      const float lambda_init = (layer == 0) ? 0.2f : 0.5560582041564594f;
      {
        GemmArgs ga{};
      ga.ssq = (float*)(ws + OFF_SSQ);
        ga.ssq = (float*)(ws + OFF_SSQ);
        ga.A = hb; ga.lda = 1024; ga.Bt = (const bf16_t*)(ws + OFF_AIN + (size_t)jl * 6 * MB); ga.K = 1024; ga.NT = 12;
        ga.o0 = ws + R_QK; ga.o1 = ws + R_VT; ga.g0 = p.a_q_g + jl * 64; ga.g1 = p.a_k_g + jl * 64;
        for (int rep = 0; rep <= DUP_GEMM; rep++) gemm_phase<M_AQKV, 1024>(ga, smem);
      }
      xcd_barrier(xb);
      for (int rep = 0; rep <= DUP_ATTNA; rep++) attnA_phase(p, jl, lambda_init, gs, gctr, gtarget);
      xcd_barrier(xb);
      {
        GemmArgs ga{};
      ga.ssq = (float*)(ws + OFF_SSQ);
        ga.ssq = (float*)(ws + OFF_SSQ);
        ga.A = (const bf16_t*)(ws + R_AO); ga.lda = 1024; ga.Bt = (const bf16_t*)(ws + OFF_AOUT + (size_t)jl * 2 * MB); ga.K = 1024; ga.NT = 4;
        ga.o0 = p.out; ga.o1 = hb; ga.resid = resid_src;
        gemm_phase<M_RESID, 1024>(ga, smem);
      }
      xcd_barrier(xb);
    } else if (mixer == 1) {
      pool_phase(p, gs);
      xcd_barrier(xb);
      {
        GemmArgs ga{};
      ga.ssq = (float*)(ws + OFF_SSQ);
        ga.ssq = (float*)(ws + OFF_SSQ);
        ga.A = (const bf16_t*)(ws + R_POOL); ga.lda = 1024; ga.Bt = (const bf16_t*)(ws + OFF_BW); ga.K = 256; ga.NT = 4;
        ga.o0 = p.out; ga.o1 = hb; ga.resid = resid_src; ga.g0 = p.b_scale;
        gemm_phase<M_POOL, 256>(ga, smem);
      }
      xcd_barrier(xb);
    } else {
      {
        GemmArgs ga{};
      ga.ssq = (float*)(ws + OFF_SSQ);
        ga.ssq = (float*)(ws + OFF_SSQ);
        ga.A = hb; ga.lda = 1024; ga.Bt = (const bf16_t*)(ws + OFF_CIN); ga.K = 1024; ga.NT = 9;
        ga.o0 = ws + R_CQ; ga.o1 = ws + R_CK; ga.o2 = ws + R_CVT; ga.o3 = ws + R_CIQ; ga.o4 = ws + R_CIK; ga.o5 = ws + R_CIW;
        ga.g0 = p.c_q_g; ga.g1 = p.c_k_g;
        for (int rep = 0; rep <= DUP_GEMM; rep++) gemm_phase<M_CIN, 1024>(ga, smem);
      }
      xcd_barrier(xb);
      for (int rep = 0; rep <= DUP_IDX; rep++) index_phase(p, gs, gctr, gtarget);
      xcd_barrier(xb);
      for (int rep = 0; rep <= DUP_ATTNC; rep++) attnC_phase(p, gs, gctr, gtarget);
      xcd_barrier(xb);
      {
        GemmArgs ga{};
      ga.ssq = (float*)(ws + OFF_SSQ);
        ga.ssq = (float*)(ws + OFF_SSQ);
        ga.A = (const bf16_t*)(ws + R_AO); ga.lda = 1024; ga.Bt = (const bf16_t*)(ws + OFF_COUT); ga.K = 1024; ga.NT = 4;
        ga.o0 = p.out; ga.o1 = hb; ga.resid = resid_src;
        gemm_phase<M_RESID, 1024>(ga, smem);
      }
      xcd_barrier(xb);
    }
    {
      GemmArgs ga{};
      ga.ssq = (float*)(ws + OFF_SSQ);
      ga.A = hb; ga.lda = 1024; ga.Bt = (const bf16_t*)(ws + OFF_W1 + (size_t)layer * 8 * MB); ga.K = 1024; ga.NT = 16;
      ga.o0 = ws + R_HID;
      for (int rep = 0; rep <= DUP_GEMM; rep++) gemm_phase<M_MLP1, 1024>(ga, smem);
    }
    xcd_barrier(xb);
    {
      GemmArgs ga{};
      ga.ssq = (float*)(ws + OFF_SSQ);
      ga.A = (const bf16_t*)(ws + R_HID); ga.lda = 4096; ga.Bt = (const bf16_t*)(ws + OFF_W2 + (size_t)layer * 8 * MB); ga.K = 4096; ga.NT = 4;
      ga.o0 = p.out; ga.o1 = hb; ga.resid = p.out;
      gemm_phase<M_RESID, 4096>(ga, smem);
    }
    if (layer < 3) xcd_barrier(xb);
  }
}

extern "C" void kernel_launch(void* const* d_in, const int* in_sizes, int n_in, void* d_out, int out_size,
                              void* d_ws, size_t ws_size, hipStream_t stream) {
  static int grid_blocks = 0;
  if (!grid_blocks) {
    int dev = 0, cus = 0, per_cu = 0;
    hipGetDevice(&dev);
    hipDeviceGetAttribute(&cus, hipDeviceAttributeMultiprocessorCount, dev);
    hipOccupancyMaxActiveBlocksPerMultiprocessor(&per_cu, fwd_megakernel, 512, 0);
    if (per_cu > 1) per_cu = 1;
    if (per_cu < 1) per_cu = 1;
    grid_blocks = cus * per_cu;
  }
  if (ws_size < WS_NEED) { fprintf(stderr, "workspace too small: %zu < %zu\n", ws_size, (size_t)WS_NEED); return; }
  Params p{};
  p.x = (const float*)d_in[0]; p.norm1_g = (const float*)d_in[1]; p.norm2_g = (const float*)d_in[2];
  p.a_w_in = (const float*)d_in[3]; p.a_q_g = (const float*)d_in[4]; p.a_k_g = (const float*)d_in[5];
  p.a_lq1 = (const float*)d_in[6]; p.a_lk1 = (const float*)d_in[7]; p.a_lq2 = (const float*)d_in[8]; p.a_lk2 = (const float*)d_in[9];
  p.a_sub_g = (const float*)d_in[10]; p.a_w_out = (const float*)d_in[11];
  p.b_w = (const float*)d_in[12]; p.b_scale = (const float*)d_in[13];
  p.c_w_in = (const float*)d_in[14]; p.c_q_g = (const float*)d_in[15]; p.c_k_g = (const float*)d_in[16]; p.c_w_out = (const float*)d_in[17];
  p.w1 = (const float*)d_in[18]; p.w2 = (const float*)d_in[19];
  p.out = (float*)d_out; p.ws = (char*)d_ws;
  hipMemsetAsync((char*)d_ws + OFF_BAR, 0, XCD_BAR_WORDS * sizeof(unsigned), stream);
  void* args[] = {&p};
  hipError_t e = hipLaunchCooperativeKernel((void*)fwd_megakernel, dim3(grid_blocks), dim3(512), args, 0, stream);
  if (e != hipSuccess) fprintf(stderr, "cooperative launch failed: %s (grid %d)\n", hipGetErrorString(e), grid_blocks);
}
```
